# Optimizing an MI355X kernel written in HIP

```python
import math
import jax, jax.numpy as jnp
from jax import lax
import numpy as np

D_MODEL = 2048
BATCH = 4
SEQ = 8192
DEPTH = 4

CHUNK = 64
Q_BLOCK = 128
N_MIXERS = 3
N_HEADS = 16
HEAD_DIM = D_MODEL // N_HEADS
ROPE_DIM = HEAD_DIM // 4
ROPE_THETA = 500000.0
B_KV_HEADS = 4
IDX_HEADS = 16
IDX_DIM = 64
IDX_ROPE_DIM = IDX_DIM // 4
TOPK_MAX = 256
D_FF = 4 * D_MODEL
PLE_DIM = 256
RMS_EPS = 1e-6
N_A = (DEPTH + 2) // 3
N_B = (DEPTH + 1) // 3
N_C = DEPTH // 3
B_SPLITS = (N_HEADS * HEAD_DIM, B_KV_HEADS * HEAD_DIM, B_KV_HEADS * HEAD_DIM,
            IDX_HEADS * IDX_DIM, IDX_DIM, IDX_HEADS)
B_IN_WIDTH = sum(B_SPLITS)

kernel_name = 'hybrid_stickbreak_dsa_fox_trunk'


def rmsnorm(x, g):
    xf = x.astype(jnp.float32)
    y = xf * lax.rsqrt(jnp.mean(xf * xf, axis=-1, keepdims=True) + RMS_EPS)
    return (y * g.astype(jnp.float32)).astype(x.dtype)


def rope_partial(x, pos, rot_dim):
    half = rot_dim // 2
    inv = ROPE_THETA ** (-jnp.arange(half, dtype=jnp.float32) / half)
    ang = pos.astype(jnp.float32)[:, None] * inv[None, :]
    cos = jnp.cos(ang)[None, :, None, :]
    sin = jnp.sin(ang)[None, :, None, :]
    xr = x[..., :rot_dim].astype(jnp.float32)
    x1, x2 = xr[..., :half], xr[..., half:]
    rot = jnp.concatenate([x1 * cos - x2 * sin, x1 * sin + x2 * cos], axis=-1)
    return jnp.concatenate([rot.astype(x.dtype), x[..., rot_dim:]], axis=-1)


def heads(t, n):
    return t.reshape(t.shape[0], t.shape[1], n, -1)


def stick_breaking_attention(h, w_in, q_gain, k_gain):
    bsz, seq, _ = h.shape
    q, k, v = jnp.split(h @ w_in, 3, axis=-1)
    q = rmsnorm(heads(q, N_HEADS), q_gain) * (HEAD_DIM ** -0.5)
    k = rmsnorm(heads(k, N_HEADS), k_gain)
    v = heads(v, N_HEADS)
    outs = []
    for qb in range(seq // Q_BLOCK):
        q0, end = qb * Q_BLOCK, (qb + 1) * Q_BLOCK
        z = jnp.einsum('bthd,bshd->bhts', q[:, q0:end], k[:, :end]).astype(jnp.float32)
        strict = jnp.arange(end)[None, :] < jnp.arange(q0, end)[:, None]
        log_1mb = jnp.where(strict, jax.nn.log_sigmoid(-z), 0.0)
        after = lax.cumsum(log_1mb, axis=3, reverse=True) - log_1mb
        wts = jnp.where(strict, jnp.exp(jax.nn.log_sigmoid(z) + after), 0.0)
        outs.append(jnp.einsum('bhts,bshd->bthd', wts.astype(v.dtype), v[:, :end]))
    return jnp.concatenate(outs, axis=1).reshape(bsz, seq, N_HEADS * HEAD_DIM)


def dsa_sparse_attention(h, w_in, q_gain, k_gain, idx_k_gain):
    bsz, seq, _ = h.shape
    offs = [int(o) for o in np.cumsum(B_SPLITS)[:-1]]
    q, k, v, qi, ki, wi = jnp.split(h @ w_in, offs, axis=-1)
    pos = jnp.arange(seq)
    q = rope_partial(rmsnorm(heads(q, N_HEADS), q_gain), pos, ROPE_DIM) * (HEAD_DIM ** -0.5)
    k = rope_partial(rmsnorm(heads(k, B_KV_HEADS), k_gain), pos, ROPE_DIM)
    v = heads(v, B_KV_HEADS)
    qi = rope_partial(heads(qi, IDX_HEADS), pos, IDX_ROPE_DIM)
    ki = rope_partial(rmsnorm(ki, idx_k_gain)[:, :, None, :], pos, IDX_ROPE_DIM)[:, :, 0]
    wi = wi.astype(jnp.float32) * (IDX_HEADS ** -0.5) * (IDX_DIM ** -0.5)
    k_top = min(TOPK_MAX, seq // 4)
    group = N_HEADS // B_KV_HEADS
    b_idx = jnp.arange(bsz)[:, None, None]
    outs = []
    for qb in range(seq // Q_BLOCK):
        q0, end = qb * Q_BLOCK, (qb + 1) * Q_BLOCK
        width = min(seq, max(end, k_top))
        chunk_end = (jnp.arange(q0, end) // CHUNK + 1) * CHUNK
        admiss = jnp.arange(width)[None, :] < chunk_end[:, None]
        idx_logits = jnp.einsum('bthd,bsd->bths', qi[:, q0:end], ki[:, :width]).astype(jnp.float32)
        score = jnp.einsum('bth,bths->bts', wi[:, q0:end], jax.nn.relu(idx_logits))
        score = jnp.where(admiss[None], score, -jnp.inf)
        _, sel = lax.top_k(score, k_top)
        valid = sel < chunk_end[None, :, None]
        k_sel = k[b_idx, sel]
        v_sel = v[b_idx, sel]
        qg = q[:, q0:end].reshape(bsz, Q_BLOCK, B_KV_HEADS, group, HEAD_DIM)
        logits = jnp.einsum('btgrd,btkgd->btgrk', qg, k_sel).astype(jnp.float32)
        logits = jnp.where(valid[:, :, None, None, :], logits, -jnp.inf)
        probs = jax.nn.softmax(logits, axis=-1)
        o = jnp.einsum('btgrk,btkgd->btgrd', probs.astype(v.dtype), v_sel)
        outs.append(o.reshape(bsz, Q_BLOCK, N_HEADS * HEAD_DIM))
    return jnp.concatenate(outs, axis=1)


def forgetting_attention(h, w_in, b_f, q_gain, k_gain):
    bsz, seq, _ = h.shape
    dm = N_HEADS * HEAD_DIM
    proj = h @ w_in
    q = rmsnorm(heads(proj[..., :dm], N_HEADS), q_gain) * (HEAD_DIM ** -0.5)
    k = rmsnorm(heads(proj[..., dm:2 * dm], N_HEADS), k_gain)
    v = heads(proj[..., 2 * dm:3 * dm], N_HEADS)
    log_f = jax.nn.log_sigmoid(proj[..., 3 * dm:].astype(jnp.float32) + b_f.astype(jnp.float32))
    cum = jnp.cumsum(log_f, axis=1).transpose(0, 2, 1)
    outs = []
    for qb in range(seq // Q_BLOCK):
        q0, end = qb * Q_BLOCK, (qb + 1) * Q_BLOCK
        logits = jnp.einsum('bthd,bshd->bhts', q[:, q0:end], k[:, :end]).astype(jnp.float32)
        logits = logits + cum[:, :, q0:end, None] - cum[:, :, None, :end]
        causal = jnp.arange(end)[None, :] <= jnp.arange(q0, end)[:, None]
        probs = jax.nn.softmax(jnp.where(causal, logits, -jnp.inf), axis=-1)
        outs.append(jnp.einsum('bhts,bshd->bthd', probs.astype(v.dtype), v[:, :end]))
    return jnp.concatenate(outs, axis=1).reshape(bsz, seq, dm)


def setup_inputs(seed: int = 0) -> dict:
    key = jax.random.key(seed)
    ks = jax.random.split(key, 24)
    f32 = jnp.float32
    D = D_MODEL

    def nrm(k, shape, scale):
        return jax.random.normal(k, shape, f32) * scale

    def gain(k, shape):
        return 1.0 + 0.02 * jax.random.normal(k, shape, f32)

    return {
        'x': nrm(ks[0], (BATCH, SEQ, D), 1.0),
        'p': nrm(ks[1], (DEPTH, BATCH, SEQ, PLE_DIM), 1.0),
        'attn_norm': gain(ks[2], (DEPTH, D)),
        'w_o': nrm(ks[3], (DEPTH, D, D), D ** -0.5),
        'mlp_norm': gain(ks[4], (DEPTH, D)),
        'w_up': nrm(ks[5], (DEPTH, D, D_FF), D ** -0.5),
        'w_down': nrm(ks[6], (DEPTH, D_FF, D), 0.5 * D_FF ** -0.5),
        'ple_norm': gain(ks[7], (DEPTH, D)),
        'w_ple_gate': nrm(ks[8], (DEPTH, D, D), D ** -0.5),
        'w_ple_proj': nrm(ks[9], (DEPTH, PLE_DIM, D), PLE_DIM ** -0.5),
        'a_w_in': nrm(ks[10], (N_A, D, 3 * D), D ** -0.5),
        'a_q_norm': gain(ks[11], (N_A, HEAD_DIM)),
        'a_k_norm': gain(ks[12], (N_A, HEAD_DIM)),
        'b_w_in': nrm(ks[13], (N_B, D, B_IN_WIDTH), D ** -0.5),
        'b_q_norm': gain(ks[14], (N_B, HEAD_DIM)),
        'b_k_norm': gain(ks[15], (N_B, HEAD_DIM)),
        'b_idx_k_norm': gain(ks[16], (N_B, IDX_DIM)),
        'c_w_in': nrm(ks[17], (N_C, D, 3 * D + N_HEADS), D ** -0.5),
        'c_b_f': jax.random.uniform(ks[18], (N_C, N_HEADS), f32, 1.0, 5.0),
        'c_q_norm': gain(ks[19], (N_C, HEAD_DIM)),
        'c_k_norm': gain(ks[20], (N_C, HEAD_DIM)),
    }


def reference(x, p, attn_norm, w_o, mlp_norm, w_up, w_down, ple_norm, w_ple_gate,
              w_ple_proj, a_w_in, a_q_norm, a_k_norm, b_w_in, b_q_norm, b_k_norm,
              b_idx_k_norm, c_w_in, c_b_f, c_q_norm, c_k_norm):
    h = x
    for i in range(DEPTH):
        kind, j = i % N_MIXERS, i // N_MIXERS
        hn = rmsnorm(h, attn_norm[i])
        if kind == 0:
            mix = stick_breaking_attention(hn, a_w_in[j], a_q_norm[j], a_k_norm[j])
        elif kind == 1:
            mix = dsa_sparse_attention(hn, b_w_in[j], b_q_norm[j], b_k_norm[j], b_idx_k_norm[j])
        else:
            mix = forgetting_attention(hn, c_w_in[j], c_b_f[j], c_q_norm[j], c_k_norm[j])
        h = h + mix @ w_o[i]
        hn = rmsnorm(h, mlp_norm[i])
        h = h + jnp.square(jax.nn.relu(hn @ w_up[i])) @ w_down[i]
        gate = jax.nn.sigmoid(rmsnorm(h, ple_norm[i]) @ w_ple_gate[i])
        h = h + gate * (p[i] @ w_ple_proj[i])
    return h
```

```cpp
#include <hip/hip_runtime.h>
#include <cstdio>
#include <cstdint>
namespace pg8 {
#define PG8_LAS __attribute__((address_space(3)))
typedef unsigned short bf16_t;
typedef short bf16x8 __attribute__((ext_vector_type(8)));
typedef float f32x4 __attribute__((ext_vector_type(4)));
typedef unsigned u32x4 __attribute__((ext_vector_type(4)));
constexpr int BM = 256, BK = 64, HALF = 128, HTB = HALF * BK * 2  , STAGE_BYTES = 8 * HTB, NXCD = 8, WGM = 8;

__host__ __device__ __forceinline__ int lds_byte(int r, int c) { const int st = (r >> 4) * 2 + (c >> 5), rr = r & 15, cc = c & 31, ob = rr * 64 + cc * 2; return st * 1024 + (ob ^ (((ob >> 9) & 1) << 5)); }
__host__ __device__ __forceinline__ void stage_rc(int b, int& R, int& C) { const int st = b / 1024, sb = b % 1024, swz = sb ^ (((sb >> 9) & 1) << 5); R = (st >> 1) * 16 + swz / 64; C = (st & 1) * 32 + (swz % 64) / 2; }
__host__ __device__ __forceinline__ int perm32(int rho) { const int n = rho >> 4, i = rho & 15; return 8 * (i >> 2) + 4 * n + (i & 3); }

struct Unit { int pm, pn; };
struct Gemm { const bf16_t* A; const bf16_t* Bt; int M, N, K; };

struct StaticOrder {
    int nM, nN, nwg, G, c;
    __host__ __device__ void init(int M, int N, int G_, int c_) { nM = M / BM; nN = N / BM; nwg = nM * nN; G = G_; c = c_; }
    __host__ __device__ bool next(int i, Unit& u) const {
        const long L = (long)i * G + c; if (L >= nwg) return false;
        int wgid = (int)L; { const int q = nwg / NXCD, r = nwg % NXCD, xcd = wgid % NXCD, off = wgid / NXCD; wgid = (xcd < r ? xcd * (q + 1) : r * (q + 1) + (xcd - r) * q) + off; }
        const int nig = WGM * nN, gid = wgid / nig, fm = gid * WGM, gsz = (nM - fm) < WGM ? (nM - fm) : WGM;
        u.pm = fm + ((wgid % nig) % gsz); u.pn = (wgid % nig) / gsz; return true;
    }
    __device__ __forceinline__ void a_ready(const Unit&) const {}
    __device__ __forceinline__ void done(const Unit&) const {}
};

__device__ __forceinline__ unsigned cvt_pk_bf16(float lo, float hi) { unsigned r; asm volatile("v_cvt_pk_bf16_f32 %0, %1, %2" : "=v"(r) : "v"(lo), "v"(hi)); return r; }
typedef float f32x2 __attribute__((ext_vector_type(2)));
template <class Epi, class Sched, bool ALIGN_EPI = false, bool SP2 = false>
__device__ __forceinline__ void gemm_phase(PG8_LAS unsigned char* lds, const Gemm g, const Sched& S, const Epi& E) {
    int tid_l = threadIdx.x; asm volatile("" : "+v"(tid_l));
    const int tid = tid_l, wid = __builtin_amdgcn_readfirstlane(tid >> 6), lane = tid & 63, wr = wid >> 2, wc = wid & 3, fr = lane & 15, fq = lane >> 4;
    const int K = g.K, nt = K / BK;
    unsigned voffA[2], voffB[2];
#pragma unroll
    for (int i = 0; i < 2; ++i) { int R, C; stage_rc(tid * 16 + i * 8192, R, C); const int Rb = Epi::PERM ? ((R & ~31) + perm32(R & 31)) : R;
        voffA[i] = (unsigned)(R * K + C) * 2u; voffB[i] = (unsigned)(Rb * K + C) * 2u; }
    const size_t kstep = (size_t)(BK * 2);
    const size_t hstep = (size_t)HALF * K * 2;
    const size_t tstep = 2 * hstep;
    const unsigned ldsw = (unsigned)wid * 1024u;
    const int aoff = lds_byte(wr * 64 + fr, fq * 8), boff = lds_byte(wc * 32 + fr, fq * 8);
#define PG8_SA(b, h) (((b) * 2 + (h)) * HTB)
#define PG8_SB(b, h) ((4 + (b) * 2 + (h)) * HTB)
#define PG8_STAGE(bufoff, gbase, voff) do { _Pragma("unroll") for (int _i = 0; _i < 2; ++_i) \
        __builtin_amdgcn_global_load_lds((const unsigned*)((const char*)(gbase) + (voff)[_i]), (PG8_LAS unsigned*)(lds + (bufoff) + ldsw + _i * 8192), 16, 0, 0); } while (0)
#define PG8_LDA(dst, b, h) do { _Pragma("unroll") for (int m = 0; m < 4; ++m) _Pragma("unroll") for (int k = 0; k < 2; ++k) dst[m][k] = *(const PG8_LAS bf16x8*)(lds + PG8_SA(b, h) + aoff + m * 2048 + k * 1024); } while (0)
#define PG8_LDB(dst, b, h) do { _Pragma("unroll") for (int n = 0; n < 2; ++n) _Pragma("unroll") for (int k = 0; k < 2; ++k) dst[n][k] = *(const PG8_LAS bf16x8*)(lds + PG8_SB(b, h) + boff + n * 2048 + k * 1024); } while (0)
#define PG8_MMA(ai, bj, At, Bt) do { __builtin_amdgcn_s_setprio(1); _Pragma("unroll") for (int m = 0; m < 4; ++m) _Pragma("unroll") for (int n = 0; n < 2; ++n) _Pragma("unroll") for (int k = 0; k < 2; ++k) \
        acc[ai][bj][m][n] = __builtin_amdgcn_mfma_f32_16x16x32_bf16(Bt[n][k], At[m][k], acc[ai][bj][m][n], 0, 0, 0); __builtin_amdgcn_s_setprio(0); } while (0)
#define PG8_WAIT_V(n) asm volatile("s_waitcnt vmcnt(" #n ")" ::: "memory")
#define PG8_WAIT_L(n) asm volatile("s_waitcnt lgkmcnt(" #n ")" ::: "memory")
#define PG8_BAR __builtin_amdgcn_s_barrier()
#define PG8_SCHED __builtin_amdgcn_sched_barrier(0)
    Unit cur, nxt; int ui = 0;
    if (!S.next(0, cur)) return;
    f32x4 acc[2][2][4][2];
#pragma unroll
    for (int a = 0; a < 2; ++a)
#pragma unroll
        for (int b = 0; b < 2; ++b)
#pragma unroll
            for (int m = 0; m < 4; ++m)
#pragma unroll
                for (int n = 0; n < 2; ++n) acc[a][b][m][n] = (f32x4){0.f, 0.f, 0.f, 0.f};
    bf16x8 At[4][2], B0[2][2], B1[2][2];
    const char* cA = (const char*)g.A + (size_t)cur.pm * tstep; const char* cB = (const char*)g.Bt + (size_t)cur.pn * tstep;
    S.a_ready(cur);
    if constexpr (SP2) {
        PG8_STAGE(PG8_SB(0, 0), cB, voffB); PG8_STAGE(PG8_SB(0, 1), cB + hstep, voffB); PG8_STAGE(PG8_SA(0, 0), cA, voffA); PG8_STAGE(PG8_SA(0, 1), cA + hstep, voffA);
        if (wr == 1) PG8_BAR;
        PG8_WAIT_V(2); PG8_BAR;
        PG8_STAGE(PG8_SB(1, 0), cB + kstep, voffB); PG8_STAGE(PG8_SA(1, 0), cA + kstep, voffA); PG8_STAGE(PG8_SB(1, 1), cB + hstep + kstep, voffB);
        PG8_WAIT_V(6); PG8_BAR;
    } else {
        PG8_STAGE(PG8_SB(0, 0), cB, voffB); PG8_STAGE(PG8_SA(0, 0), cA, voffA); PG8_STAGE(PG8_SB(0, 1), cB + hstep, voffB); PG8_STAGE(PG8_SA(0, 1), cA + hstep, voffA);
        if (wr == 1) PG8_BAR;
        PG8_WAIT_V(4); PG8_BAR;
        PG8_STAGE(PG8_SB(1, 0), cB + kstep, voffB); PG8_STAGE(PG8_SA(1, 0), cA + kstep, voffA); PG8_STAGE(PG8_SB(1, 1), cB + hstep + kstep, voffB);
        PG8_WAIT_V(6); PG8_BAR;
    }
    for (;;) {
        const bool has_next = S.next(ui + 1, nxt);
        const char* nA = has_next ? (const char*)g.A + (size_t)nxt.pm * tstep : cA; const char* nB = has_next ? (const char*)g.Bt + (size_t)nxt.pn * tstep : cB;
        for (int t = 0; t < nt; t += 2) {
            const bool last = (t == nt - 2);
            const char* a1 = cA + (size_t)(t + 1) * kstep;
            const char* a2 = last ? nA : cA + (size_t)(t + 2) * kstep; const char* b2 = last ? nB : cB + (size_t)(t + 2) * kstep;
            const char* a3 = a2 + kstep; const char* b3 = b2 + kstep;
            if (last && has_next) S.a_ready(nxt);
            if constexpr (SP2) {
            PG8_LDB(B0, 0, 0); PG8_LDB(B1, 0, 1); PG8_SCHED; PG8_LDA(At, 0, 0); PG8_STAGE(PG8_SA(1, 1), a1 + hstep, voffA);
            PG8_WAIT_V(8); PG8_WAIT_L(0); PG8_BAR; PG8_MMA(0, 0, At, B0); PG8_MMA(0, 1, At, B1); PG8_BAR; PG8_SCHED;
            PG8_LDA(At, 0, 1); PG8_STAGE(PG8_SB(0, 0), b2, voffB); PG8_STAGE(PG8_SB(0, 1), b2 + hstep, voffB); PG8_STAGE(PG8_SA(0, 0), a2, voffA);
            PG8_WAIT_V(8); PG8_WAIT_L(0); PG8_BAR; PG8_MMA(1, 0, At, B0); PG8_MMA(1, 1, At, B1); PG8_BAR; PG8_SCHED;
            PG8_LDB(B0, 1, 0); PG8_LDB(B1, 1, 1); PG8_SCHED; PG8_LDA(At, 1, 0); PG8_STAGE(PG8_SA(0, 1), a2 + hstep, voffA);
            PG8_WAIT_V(8); PG8_WAIT_L(0); PG8_BAR; PG8_MMA(0, 0, At, B0); PG8_MMA(0, 1, At, B1); PG8_BAR; PG8_SCHED;
            PG8_LDA(At, 1, 1); PG8_STAGE(PG8_SB(1, 0), b3, voffB); PG8_STAGE(PG8_SB(1, 1), b3 + hstep, voffB); PG8_STAGE(PG8_SA(1, 0), a3, voffA);
            PG8_WAIT_V(8); PG8_WAIT_L(0); PG8_BAR; PG8_MMA(1, 0, At, B0); PG8_MMA(1, 1, At, B1); PG8_BAR; PG8_SCHED;
            } else {
            PG8_LDB(B0, 0, 0); PG8_SCHED; PG8_LDA(At, 0, 0); PG8_STAGE(PG8_SA(1, 1), a1 + hstep, voffA);
            PG8_WAIT_L(8); PG8_BAR; PG8_WAIT_L(0); PG8_MMA(0, 0, At, B0); PG8_BAR; PG8_SCHED;
            PG8_LDB(B1, 0, 1); PG8_STAGE(PG8_SB(0, 0), b2, voffB);
            PG8_BAR; PG8_WAIT_L(0); PG8_MMA(0, 1, At, B1); PG8_BAR;
            PG8_LDA(At, 0, 1); PG8_STAGE(PG8_SA(0, 0), a2, voffA);
            PG8_BAR; PG8_WAIT_L(0); PG8_MMA(1, 0, At, B0); PG8_BAR; PG8_SCHED;
            PG8_STAGE(PG8_SB(0, 1), b2 + hstep, voffB);
            PG8_WAIT_V(6); PG8_BAR; PG8_MMA(1, 1, At, B1); PG8_BAR;
            PG8_LDB(B0, 1, 0); PG8_SCHED; PG8_LDA(At, 1, 0); PG8_STAGE(PG8_SA(0, 1), a2 + hstep, voffA);
            PG8_WAIT_L(8); PG8_BAR; PG8_WAIT_L(0); PG8_MMA(0, 0, At, B0); PG8_BAR; PG8_SCHED;
            PG8_LDB(B1, 1, 1); PG8_STAGE(PG8_SB(1, 0), b3, voffB);
            PG8_BAR; PG8_WAIT_L(0); PG8_MMA(0, 1, At, B1); PG8_BAR;
            PG8_LDA(At, 1, 1); PG8_STAGE(PG8_SA(1, 0), a3, voffA);
            PG8_BAR; PG8_WAIT_L(0); PG8_MMA(1, 0, At, B0); PG8_BAR; PG8_SCHED;
            PG8_STAGE(PG8_SB(1, 1), b3 + hstep, voffB);
            PG8_WAIT_V(6); PG8_BAR; PG8_MMA(1, 1, At, B1); PG8_BAR;
            }
        }
        if constexpr (ALIGN_EPI) { if (wr == 0) PG8_BAR; }
        if constexpr (!Epi::AFTER_DRAIN) { E(acc, cur, wr, wc, fr, fq); S.done(cur); }
        if (!has_next) break;
#pragma unroll
        for (int a = 0; a < 2; ++a)
#pragma unroll
            for (int b = 0; b < 2; ++b)
#pragma unroll
                for (int m = 0; m < 4; ++m)
#pragma unroll
                    for (int n = 0; n < 2; ++n) acc[a][b][m][n] = (f32x4){0.f, 0.f, 0.f, 0.f};
        cur = nxt; cA = nA; cB = nB; ++ui;
        if constexpr (ALIGN_EPI) { if (wr == 1) PG8_BAR; }
    }
    PG8_WAIT_V(0);
    if constexpr (!ALIGN_EPI) { if (wr == 0) PG8_BAR; }
    PG8_BAR;
    if constexpr (Epi::AFTER_DRAIN) { E.fused(acc, cur, wr, wc, fr, fq, lds, wid, lane); S.done(cur); }
#undef PG8_SA
#undef PG8_SB
#undef PG8_STAGE
#undef PG8_LDA
#undef PG8_LDB
#undef PG8_MMA
#undef PG8_WAIT_V
#undef PG8_WAIT_L
#undef PG8_BAR
#undef PG8_SCHED
}
}
#define GAS __attribute__((address_space(1)))
#define LAS __attribute__((address_space(3)))
typedef unsigned short bf16;
typedef unsigned v4u __attribute__((ext_vector_type(4)));
typedef float f32x4 __attribute__((ext_vector_type(4)));
typedef short bf16x8 __attribute__((ext_vector_type(8)));
typedef GAS unsigned gu32;
typedef GAS unsigned long long gu64;
#define RLX_AGENT __ATOMIC_RELAXED, __HIP_MEMORY_SCOPE_AGENT
#define LDS_WAIT() asm volatile("s_waitcnt lgkmcnt(0)" ::: "memory")
#define VM_WAIT() asm volatile("s_waitcnt vmcnt(0)" ::: "memory")
__device__ __forceinline__ unsigned long long rt() { return __builtin_amdgcn_s_memrealtime(); }
__device__ __forceinline__ unsigned f2bf(float f) { unsigned u = __builtin_bit_cast(unsigned, f); return (u + 0x7fffu + ((u >> 16) & 1u)) >> 16; }
__device__ __forceinline__ unsigned pk2(float lo, float hi) { return f2bf(lo) | (f2bf(hi) << 16); }
typedef unsigned u32x4 __attribute__((ext_vector_type(4)));
#define XB_TMO      128
#define XB_XCNT(j)  (256  + 64 * (j))
#define XB_XSUB(j)  (1280 + 64 * (j))
#define XB_XGEN(j)  (2304 + 64 * (j))
#define XB_TOP      3328
#define XB_TOPGEN   3392
#define XCD_BAR_WORDS 3456
#define XB_SPIN_CAP (1u << 18)

__device__ __forceinline__ unsigned xb_ld(unsigned* p)              { return __hip_atomic_load(p, __ATOMIC_RELAXED, __HIP_MEMORY_SCOPE_AGENT); }
__device__ __forceinline__ unsigned xb_add(unsigned* p, unsigned v) { return __hip_atomic_fetch_add(p, v, __ATOMIC_RELAXED, __HIP_MEMORY_SCOPE_AGENT); }
__device__ __forceinline__ unsigned xb_xcc_id() { return (unsigned)__builtin_amdgcn_s_getreg((3 << 11) | 20) & 0xFu; }
#define XB_SPIN(cond, bar) do { unsigned _sp = 0; while (cond) { __builtin_amdgcn_s_sleep(1); \
    if ((++_sp & 255u) == 0u) { if (xb_ld(&(bar)[XB_TMO])) break; if (_sp > XB_SPIN_CAP) { atomicAdd(&(bar)[XB_TMO], 1u); break; } } } } while (0)

struct XcdBarrier {
    unsigned* bar; unsigned x;
    volatile LAS unsigned* st;
};

__device__ __forceinline__ XcdBarrier xcd_barrier_post(unsigned* bar, volatile LAS unsigned* st) {
    XcdBarrier b; b.bar = bar; b.x = xb_xcc_id(); b.st = st;
    if (threadIdx.x == 0) (void)xb_add(&bar[XB_XCNT(b.x)], 1u);
    return b;
}
__device__ __forceinline__ void xcd_barrier_complete(unsigned* bar, unsigned x, unsigned& nloc, unsigned& nx) {
    const unsigned G = gridDim.x * gridDim.y * gridDim.z;
    unsigned sum, cnt, mine, sp = 0u;
    for (;;) {
        sum = 0u; cnt = 0u; mine = 0u;
#pragma unroll
        for (unsigned j = 0; j < 16; ++j) { const unsigned c = xb_ld(&bar[XB_XCNT(j)]); sum += c; cnt += (c > 0u) ? 1u : 0u; mine = (j == x) ? c : mine; }
        if (sum == G) break;
        __builtin_amdgcn_s_sleep(1);
        if ((++sp & 255u) == 0u) { if (xb_ld(&bar[XB_TMO])) break; if (sp > XB_SPIN_CAP) { atomicAdd(&bar[XB_TMO], 1u); break; } }
    }
    nloc = mine > 0u ? mine : 1u; nx = cnt > 0u ? cnt : 1u;
}

__device__ __forceinline__ void xcd_barrier(const XcdBarrier& b) {
    asm volatile("s_waitcnt vmcnt(0)" ::: "memory");
    __syncthreads();
    if (threadIdx.x == 0) {
        unsigned* bar = b.bar;
        __builtin_amdgcn_s_waitcnt(0);
        unsigned nloc = b.st[0], nx = b.st[1];
        if (nloc == 0u) { xcd_barrier_complete(bar, b.x, nloc, nx); b.st[0] = nloc; b.st[1] = nx; }
        const unsigned old = xb_add(&bar[XB_XSUB(b.x)], 1u);
        const unsigned gen = old / nloc;
        if (old + 1u == (gen + 1u) * nloc) {
            __builtin_amdgcn_fence(__ATOMIC_RELEASE, "agent");
            asm volatile("s_waitcnt vmcnt(0)" ::: "memory");
            const unsigned og = xb_add(&bar[XB_TOP], 1u);
            const unsigned tg = og / nx;
            if (og + 1u == (tg + 1u) * nx) xb_add(&bar[XB_TOPGEN], 1u);
            else XB_SPIN(xb_ld(&bar[XB_TOPGEN]) == tg, bar);
            __builtin_amdgcn_fence(__ATOMIC_ACQUIRE, "agent");
            xb_add(&bar[XB_XGEN(b.x)], 1u);
            asm volatile("s_waitcnt vmcnt(0)" ::: "memory");
        } else {
            XB_SPIN(xb_ld(&bar[XB_XGEN(b.x)]) == gen, bar);
            __builtin_amdgcn_fence(__ATOMIC_ACQUIRE, "agent");
            asm volatile("s_waitcnt vmcnt(0)" ::: "memory");
        }
    }
    __syncthreads();
}

constexpr int NWAVES = 8, NTHR = 512;
constexpr int BATCH = 4, SEQ = 8192, M = BATCH * SEQ, D = 2048, NH = 16, HD = 128, FF = 8192, PLE = 256, DEPTH = 4;
constexpr int NA_IN = 6144, NB_IN = 4176, NB_PAD = 4352, NC_IN = 6160, NC_PAD = 6400;
constexpr int B_K = 2048, B_V = 2560, B_QI = 3072, B_KI = 4096, B_WI = 4160;
constexpr float RMS_EPS = 1e-6f, LOG2E = 1.4426950408889634f;
constexpr float QSCALE = 0.08838834764831845f * 1.4426950408889634f;
constexpr float ZERO_LOG2 = -160.f;

constexpr size_t MiB = 1u << 20;
constexpr size_t WS_CTL = 0, CTL_ZERO_BYTES = 1 * MiB;
constexpr size_t WS_ROPE32 = 1 * MiB, WS_ROPE16 = 2 * MiB, WS_CUM = 3 * MiB;
constexpr size_t WS_WIN = 8 * MiB, WS_WO = 33 * MiB, WS_WUP = 41 * MiB, WS_WDN = 73 * MiB, WS_WG = 105 * MiB, WS_WPL = 113 * MiB;
constexpr size_t WS_PB = 120 * MiB, WS_HN = 184 * MiB, WS_PROJ = 312 * MiB, WS_MIX = 712 * MiB, WS_VT = 840 * MiB, WS_END = 968 * MiB;
constexpr size_t WS_HID = WS_PROJ, WS_PP = WS_VT;
constexpr size_t WS_SCR_A = WS_PROJ + 272 * MiB, WS_SCR_B = WS_VT;
static_assert(WS_HID + (size_t)M * FF * 2 <= WS_VT, "hidden overlays proj|mix");
static_assert(WS_PROJ + (size_t)M * NB_PAD * 2 <= WS_SCR_A && WS_SCR_A + 128 * MiB <= WS_MIX, "scratch A");

constexpr int CW_BAR = 4096;
constexpr int CW_QUEUE = 16384;

constexpr int RING_OFF = 0, RING_BYTES = 131072;
constexpr int LDSCTL_OFF = RING_BYTES, MISC_OFF = LDSCTL_OFF + 320;
constexpr int LDS_BYTES = 147456;

typedef float f32x16 __attribute__((ext_vector_type(16)));
typedef unsigned u32x2 __attribute__((ext_vector_type(2)));
typedef __bf16 bf16x2_t __attribute__((ext_vector_type(2)));
typedef float f32x2_t __attribute__((ext_vector_type(2)));

__device__ __forceinline__ float bf2f(unsigned short b) { return __builtin_bit_cast(float, (unsigned)b << 16); }
__device__ __forceinline__ float bflo(unsigned u) { return __builtin_bit_cast(float, u << 16); }
__device__ __forceinline__ float bfhi(unsigned u) { return __builtin_bit_cast(float, u & 0xffff0000u); }
__device__ __forceinline__ unsigned cvtpk(float lo, float hi) { f32x2_t v = {lo, hi}; bf16x2_t b = __builtin_convertvector(v, bf16x2_t); return __builtin_bit_cast(unsigned, b); }
__device__ __forceinline__ float wave_sum(float v) {
#pragma unroll
    for (int o = 1; o < 64; o <<= 1) v += __shfl_xor(v, o);
    return v;
}
__device__ __forceinline__ float wave_max(float v) {
#pragma unroll
    for (int o = 1; o < 64; o <<= 1) v = fmaxf(v, __shfl_xor(v, o));
    return v;
}
__device__ __forceinline__ float wave_min(float v) {
#pragma unroll
    for (int o = 1; o < 64; o <<= 1) v = fminf(v, __shfl_xor(v, o));
    return v;
}
__device__ __forceinline__ float fexp2(float x) { return __builtin_amdgcn_exp2f(x); }
__device__ __forceinline__ float flog2(float x) { return __builtin_amdgcn_logf(x); }

namespace pg8 {
struct EpiStoreBf16 {
    static constexpr bool PERM = true, AFTER_DRAIN = false;
    bf16_t* O; int ldc;
    __device__ __forceinline__ void operator()(const f32x4 (&acc)[2][2][4][2], const Unit& u, int wr, int wc, int fr, int fq) const {
        const int row0 = u.pm * BM + wr * 64 + fr, col0 = u.pn * BM + wc * 32 + 8 * fq;
#pragma unroll
        for (int ai = 0; ai < 2; ++ai)
#pragma unroll
            for (int m = 0; m < 4; ++m) { bf16_t* rowp = O + (size_t)(row0 + ai * HALF + m * 16) * ldc + col0;
#pragma unroll
                for (int bj = 0; bj < 2; ++bj) { const f32x4 v0 = acc[ai][bj][m][0], v1 = acc[ai][bj][m][1];
                    u32x4 w; w.x = cvtpk(v0[0], v0[1]); w.y = cvtpk(v0[2], v0[3]); w.z = cvtpk(v1[0], v1[1]); w.w = cvtpk(v1[2], v1[3]);
                    *(u32x4*)(rowp + bj * HALF) = w; } }
    }
};
struct EpiRelu2 {
    static constexpr bool PERM = true, AFTER_DRAIN = false;
    bf16_t* O; int ldc;
    __device__ __forceinline__ void operator()(const f32x4 (&acc)[2][2][4][2], const Unit& u, int wr, int wc, int fr, int fq) const {
        const int row0 = u.pm * BM + wr * 64 + fr, col0 = u.pn * BM + wc * 32 + 8 * fq;
#pragma unroll
        for (int ai = 0; ai < 2; ++ai)
#pragma unroll
            for (int m = 0; m < 4; ++m) { bf16_t* rowp = O + (size_t)(row0 + ai * HALF + m * 16) * ldc + col0;
#pragma unroll
                for (int bj = 0; bj < 2; ++bj) { f32x4 v0 = acc[ai][bj][m][0], v1 = acc[ai][bj][m][1];
#pragma unroll
                    for (int e = 0; e < 4; ++e) { v0[e] = fmaxf(v0[e], 0.f); v0[e] *= v0[e]; v1[e] = fmaxf(v1[e], 0.f); v1[e] *= v1[e]; }
                    u32x4 w; w.x = cvtpk(v0[0], v0[1]); w.y = cvtpk(v0[2], v0[3]); w.z = cvtpk(v1[0], v1[1]); w.w = cvtpk(v1[2], v1[3]);
                    *(u32x4*)(rowp + bj * HALF) = w; } }
    }
};
struct EpiResid {
    static constexpr bool PERM = true, AFTER_DRAIN = false;
    const float* res; float* out; int ld;
    __device__ __forceinline__ void operator()(const f32x4 (&acc)[2][2][4][2], const Unit& u, int wr, int wc, int fr, int fq) const {
        const int row0 = u.pm * BM + wr * 64 + fr, col0 = u.pn * BM + wc * 32 + 8 * fq;
#pragma unroll
        for (int ai = 0; ai < 2; ++ai)
#pragma unroll
            for (int m = 0; m < 4; ++m) { const size_t off = (size_t)(row0 + ai * HALF + m * 16) * ld + col0;
#pragma unroll
                for (int bj = 0; bj < 2; ++bj) { const f32x4 a = *(const f32x4*)(res + off + bj * HALF), b = *(const f32x4*)(res + off + bj * HALF + 4);
                    *(f32x4*)(out + off + bj * HALF) = a + acc[ai][bj][m][0]; *(f32x4*)(out + off + bj * HALF + 4) = b + acc[ai][bj][m][1]; } }
    }
};
struct EpiGate {
    static constexpr bool PERM = true, AFTER_DRAIN = false;
    float* out; const bf16_t* pp; int ld;
    __device__ __forceinline__ void operator()(const f32x4 (&acc)[2][2][4][2], const Unit& u, int wr, int wc, int fr, int fq) const {
        const int row0 = u.pm * BM + wr * 64 + fr, col0 = u.pn * BM + wc * 32 + 8 * fq;
#pragma unroll
        for (int ai = 0; ai < 2; ++ai)
#pragma unroll
            for (int m = 0; m < 4; ++m) { const size_t off = (size_t)(row0 + ai * HALF + m * 16) * ld + col0;
#pragma unroll
                for (int bj = 0; bj < 2; ++bj) { f32x4 a = *(const f32x4*)(out + off + bj * HALF), b = *(const f32x4*)(out + off + bj * HALF + 4);
                    const u32x4 p = *(const u32x4*)(pp + off + bj * HALF);
                    const f32x4 p0 = {bflo(p.x), bfhi(p.x), bflo(p.y), bfhi(p.y)}, p1 = {bflo(p.z), bfhi(p.z), bflo(p.w), bfhi(p.w)};
                    const f32x4 v0 = acc[ai][bj][m][0], v1 = acc[ai][bj][m][1];
#pragma unroll
                    for (int e = 0; e < 4; ++e) { a[e] += __builtin_amdgcn_rcpf(1.f + fexp2(-LOG2E * v0[e])) * p0[e]; b[e] += __builtin_amdgcn_rcpf(1.f + fexp2(-LOG2E * v1[e])) * p1[e]; }
                    *(f32x4*)(out + off + bj * HALF) = a; *(f32x4*)(out + off + bj * HALF + 4) = b; } }
    }
};
}

struct Args { const float* in[21]; float* out; unsigned char* ws; };
enum { I_X = 0, I_P, I_ATTN_NORM, I_WO, I_MLP_NORM, I_WUP, I_WDOWN, I_PLE_NORM, I_WGATE, I_WPLE, I_A_WIN, I_A_QN, I_A_KN, I_B_WIN, I_B_QN, I_B_KN, I_B_IKN, I_C_WIN, I_C_BF, I_C_QN, I_C_KN };

__device__ __forceinline__ void transpose_item(const float* W, int K, int N, bf16* WT, LAS float* scr, int kb, int nb, int lane) {
    const int k0 = 64 * kb, n0 = 32 * nb; const int n = n0 + (lane & 31); const bool ok = n < N;
#pragma unroll 8
    for (int i = 0; i < 32; ++i) { const int kk = 2 * i + (lane >> 5); scr[kk * 33 + (lane & 31)] = ok ? W[(size_t)(k0 + kk) * N + n] : 0.f; }
    LDS_WAIT(); asm volatile("" ::: "memory");
    const int c = lane & 7;
#pragma unroll
    for (int j = 0; j < 4; ++j) { const int nn = (lane >> 3) + 8 * j; const LAS float* s = scr + (8 * c) * 33 + nn;
        v4u o; o.x = pk2(s[0 * 33], s[1 * 33]); o.y = pk2(s[2 * 33], s[3 * 33]); o.z = pk2(s[4 * 33], s[5 * 33]); o.w = pk2(s[6 * 33], s[7 * 33]);
        *(v4u*)(WT + (size_t)(n0 + nn) * K + k0 + 8 * c) = o; }
    LDS_WAIT(); asm volatile("" ::: "memory");
}
__device__ __forceinline__ void convert_weight(const float* W, int K, int N, int Npad, bf16* WT, LAS float* scr, int gw, int ngw, int lane) {
    const int nblk = Npad / 32, nitems = (K / 64) * nblk;
    for (int it = gw; it < nitems; it += ngw) transpose_item(W, K, N, WT, scr, it / nblk, it % nblk, lane);
}

__device__ __forceinline__ void rmsnorm_rows(const float* src, const float* g, bf16* dst, int gw, int ngw, int lane) {
    for (int m = gw; m < M; m += ngw) {
        const f32x4* xr = (const f32x4*)(src + (size_t)m * D) + lane;
        f32x4 v[8]; float ss = 0.f;
#pragma unroll
        for (int j = 0; j < 8; ++j) { v[j] = xr[64 * j]; ss += (v[j].x * v[j].x + v[j].y * v[j].y) + (v[j].z * v[j].z + v[j].w * v[j].w); }
        const float rstd = 1.f / sqrtf(wave_sum(ss) * (1.f / D) + RMS_EPS);
        unsigned long long* o8 = (unsigned long long*)(dst + (size_t)m * D) + lane;
#pragma unroll
        for (int j = 0; j < 8; ++j) { const f32x4 gg = ((const f32x4*)g)[lane + 64 * j];
            o8[64 * j] = (unsigned long long)cvtpk(v[j].x * rstd * gg.x, v[j].y * rstd * gg.y) | ((unsigned long long)cvtpk(v[j].z * rstd * gg.z, v[j].w * rstd * gg.w) << 32); }
    }
}

template <bool ROPE>
__device__ __forceinline__ void head128_norm(bf16* p, const float* gain, float scale, const float2* rope, int lane) {
    const u32x4 raw = *(const u32x4*)p;
    float x[8] = {bflo(raw.x), bfhi(raw.x), bflo(raw.y), bfhi(raw.y), bflo(raw.z), bfhi(raw.z), bflo(raw.w), bfhi(raw.w)};
    float ss = 0.f;
#pragma unroll
    for (int e = 0; e < 8; ++e) ss += x[e] * x[e];
    ss += __shfl_xor(ss, 1); ss += __shfl_xor(ss, 2); ss += __shfl_xor(ss, 4); ss += __shfl_xor(ss, 8);
    const float rstd = 1.f / sqrtf(ss * (1.f / 128.f) + RMS_EPS);
    const int lh = lane & 15;
    const f32x4 g0 = *(const f32x4*)(gain + 8 * lh), g1 = *(const f32x4*)(gain + 8 * lh + 4);
    const float gg[8] = {g0.x, g0.y, g0.z, g0.w, g1.x, g1.y, g1.z, g1.w};
#pragma unroll
    for (int e = 0; e < 8; ++e) x[e] = x[e] * rstd * gg[e];
    if (ROPE) {
        float px[8];
#pragma unroll
        for (int e = 0; e < 8; ++e) px[e] = __shfl_xor(x[e], 2);
        if (lh < 4) {
#pragma unroll
            for (int e = 0; e < 8; ++e) { const float2 cs = rope[8 * (lh & 1) + e];
                x[e] = (lh < 2) ? (x[e] * cs.x - px[e] * cs.y) : (px[e] * cs.y + x[e] * cs.x); }
        }
    }
    u32x4 w; w.x = cvtpk(x[0] * scale, x[1] * scale); w.y = cvtpk(x[2] * scale, x[3] * scale); w.z = cvtpk(x[4] * scale, x[5] * scale); w.w = cvtpk(x[6] * scale, x[7] * scale);
    *(u32x4*)p = w;
}
template <bool NORM>
__device__ __forceinline__ void head64_rope(bf16* p, const float* gain, const float2* rope, int lane, bool active) {
    const u32x4 raw = *(const u32x4*)p;
    float x[8] = {bflo(raw.x), bfhi(raw.x), bflo(raw.y), bfhi(raw.y), bflo(raw.z), bfhi(raw.z), bflo(raw.w), bfhi(raw.w)};
    const int li = lane & 7;
    if (NORM) {
        float ss = 0.f;
#pragma unroll
        for (int e = 0; e < 8; ++e) ss += x[e] * x[e];
        ss += __shfl_xor(ss, 1); ss += __shfl_xor(ss, 2); ss += __shfl_xor(ss, 4);
        const float rstd = 1.f / sqrtf(ss * (1.f / 64.f) + RMS_EPS);
        const f32x4 g0 = *(const f32x4*)(gain + 8 * li), g1 = *(const f32x4*)(gain + 8 * li + 4);
        const float gg[8] = {g0.x, g0.y, g0.z, g0.w, g1.x, g1.y, g1.z, g1.w};
#pragma unroll
        for (int e = 0; e < 8; ++e) x[e] = x[e] * rstd * gg[e];
    }
    float px[8];
#pragma unroll
    for (int e = 0; e < 8; ++e) px[e] = __shfl_xor(x[e], 1);
    if (li < 2) {
#pragma unroll
        for (int e = 0; e < 8; ++e) { const float2 cs = rope[e];
            x[e] = (li == 0) ? (x[e] * cs.x - px[e] * cs.y) : (px[e] * cs.y + x[e] * cs.x); }
    }
    if (active) { u32x4 w; w.x = cvtpk(x[0], x[1]); w.y = cvtpk(x[2], x[3]); w.z = cvtpk(x[4], x[5]); w.w = cvtpk(x[6], x[7]); *(u32x4*)p = w; }
}

__device__ __forceinline__ void vt_item(const bf16* proj, int ldp, int voff, bf16* VT, LAS unsigned char* tile, int item, int lane) {
    const int h = item & 15, tc = (item >> 4) & 255, b = item >> 12;
    const size_t row0 = (size_t)b * SEQ + 32 * tc;
#pragma unroll
    for (int i = 0; i < 8; ++i) { const int tok = 4 * i + (lane >> 4), ch = lane & 15;
        const u32x4 v = *(const u32x4*)(proj + (row0 + tok) * ldp + voff + h * 128 + ch * 8);
        LAS u32x2* d = (LAS u32x2*)(tile + tok * 264 + ch * 16); d[0] = (u32x2){v.x, v.y}; d[1] = (u32x2){v.z, v.w}; }
    LDS_WAIT(); asm volatile("" ::: "memory");
#pragma unroll
    for (int i = 0; i < 8; ++i) { const int d = 16 * i + (lane >> 2), tg = lane & 3;
        const LAS unsigned short* s = (const LAS unsigned short*)(tile + (8 * tg) * 264 + d * 2);
        u32x4 w; w.x = (unsigned)s[0] | ((unsigned)s[132] << 16); w.y = (unsigned)s[2 * 132] | ((unsigned)s[3 * 132] << 16);
        w.z = (unsigned)s[4 * 132] | ((unsigned)s[5 * 132] << 16); w.w = (unsigned)s[6 * 132] | ((unsigned)s[7 * 132] << 16);
        *(u32x4*)(VT + ((size_t)(b * 16 + h) * 128 + d) * SEQ + 32 * tc + 8 * tg) = w; }
    LDS_WAIT(); asm volatile("" ::: "memory");
}

__device__ __forceinline__ void cum_item(const bf16* proj, int ldp, const float* bfv, float* cum2, int bh, int lane) {
    const int b = bh >> 4, h = bh & 15; const float bias = bfv[h];
    float carry = 0.f;
    for (int it = 0; it < SEQ / 64; ++it) { const int t = 64 * it + lane;
        const float y = bf2f(proj[((size_t)b * SEQ + t) * ldp + 3 * D + h]) + bias;
        float lf = -(fmaxf(-y, 0.f) + log1pf(expf(-fabsf(y))));
#pragma unroll
        for (int o = 1; o < 64; o <<= 1) { const float u = __shfl_up(lf, o); if (lane >= o) lf += u; }
        const float c = carry + lf;
        cum2[(size_t)bh * SEQ + t] = c * LOG2E;
        carry = __shfl(c, 63);
    }
}

#define MFMA32(a, b, c) __builtin_amdgcn_mfma_f32_32x32x16_bf16((a), (b), (c), 0, 0, 0)
#define MFMA16(a, b, c) __builtin_amdgcn_mfma_f32_16x16x32_bf16((a), (b), (c), 0, 0, 0)
template <int MODE>
__device__ __forceinline__ void attn_dense_item(const bf16* proj, int ldp, const bf16* VT, const float* cum2, bf16* mix, float zb2, int item, int lane) {
    const int qt = 255 - (item >> 6), bh = item & 63, b = bh >> 4, h = bh & 15;
    const int n = lane & 31, hi = lane >> 5, q0 = 32 * qt;
    const size_t row0 = (size_t)b * SEQ;
    const int prow = (n & 0x13) | ((n & 4) << 1) | ((n & 8) >> 1);
    bf16x8 qf[8];
    { const bf16* qp = proj + (row0 + q0 + n) * ldp + h * 128 + hi * 8;
#pragma unroll
      for (int kk = 0; kk < 8; ++kk) qf[kk] = *(const bf16x8*)(qp + kk * 16); }
    f32x16 o[4];
#pragma unroll
    for (int d = 0; d < 4; ++d)
#pragma unroll
        for (int i = 0; i < 16; ++i) o[d][i] = 0.f;
    float R = 0.f, mrun = -1e30f, lrun = 0.f, cq = 0.f;
    const float* cb = cum2 + (size_t)bh * SEQ;
    if (MODE == 1) cq = cb[q0 + n];
    const int tq = q0 + n;
    for (int kb = q0; kb >= 0; kb -= 32) {
        if (MODE == 0) { if (__all(R + zb2 < ZERO_LOG2)) break; }
        else { const float dmax = cb[q0] - cb[kb + 31]; if (dmax + 2.f * zb2 < ZERO_LOG2) break; }
        const bf16* kp = proj + (row0 + kb + prow) * ldp + D + h * 128 + hi * 8;
        bf16x8 kf[8];
#pragma unroll
        for (int kk = 0; kk < 8; ++kk) kf[kk] = *(const bf16x8*)(kp + kk * 16);
        bf16x8 vf[4][2];
#pragma unroll
        for (int d = 0; d < 4; ++d)
#pragma unroll
            for (int s = 0; s < 2; ++s) vf[d][s] = *(const bf16x8*)(VT + ((size_t)bh * 128 + d * 32 + n) * SEQ + kb + 16 * s + 8 * hi);
        f32x16 sc;
#pragma unroll
        for (int i = 0; i < 16; ++i) sc[i] = 0.f;
#pragma unroll
        for (int kk = 0; kk < 8; ++kk) sc = MFMA32(kf[kk], qf[kk], sc);
        const bool diag = (kb == q0);
        float w[16];
        if (MODE == 0) {
            float L[16];
#pragma unroll
            for (int i = 0; i < 16; ++i) { const int key = kb + 16 * (i >> 3) + 8 * hi + (i & 7);
                const bool valid = !diag || (key < tq);
                L[i] = valid ? -flog2(1.f + fexp2(sc[i])) : 0.f; }
            float G0 = 0.f, G1 = 0.f;
#pragma unroll
            for (int j = 0; j < 8; ++j) { G0 += L[j]; G1 += L[8 + j]; }
            const float Gp0 = __shfl_xor(G0, 32), Gp1 = __shfl_xor(G1, 32);
            const float pre1 = hi ? R : (R + Gp1);
            const float pre0 = hi ? (R + G1 + Gp1) : (R + Gp1 + G1 + Gp0);
            float c = pre1;
#pragma unroll
            for (int j = 7; j >= 0; --j) { c += L[8 + j]; const int key = kb + 16 + 8 * hi + j; w[8 + j] = (!diag || key < tq) ? fexp2(sc[8 + j] + c) : 0.f; }
            c = pre0;
#pragma unroll
            for (int j = 7; j >= 0; --j) { c += L[j]; const int key = kb + 8 * hi + j; w[j] = (!diag || key < tq) ? fexp2(sc[j] + c) : 0.f; }
            R += (G0 + G1) + (Gp0 + Gp1);
        } else {
            float lg[16]; float bm = -3e38f;
#pragma unroll
            for (int s = 0; s < 2; ++s) { const f32x4 c0 = *(const f32x4*)(cb + kb + 16 * s + 8 * hi), c1 = *(const f32x4*)(cb + kb + 16 * s + 8 * hi + 4);
                const float ck[8] = {c0.x, c0.y, c0.z, c0.w, c1.x, c1.y, c1.z, c1.w};
#pragma unroll
                for (int j = 0; j < 8; ++j) { const int i = 8 * s + j, key = kb + 16 * s + 8 * hi + j;
                    const float v = sc[i] + (cq - ck[j]);
                    lg[i] = (!diag || key <= tq) ? v : -3e38f; bm = fmaxf(bm, lg[i]); } }
            bm = fmaxf(bm, __shfl_xor(bm, 32));
            const float mn = fmaxf(mrun, bm), alpha = fexp2(mrun - mn);
            mrun = mn;
            float ps = 0.f;
#pragma unroll
            for (int i = 0; i < 16; ++i) { w[i] = fexp2(lg[i] - mn); ps += w[i]; }
            lrun = lrun * alpha + ps;
#pragma unroll
            for (int d = 0; d < 4; ++d)
#pragma unroll
                for (int i = 0; i < 16; ++i) o[d][i] *= alpha;
        }
        bf16x8 pf[2];
#pragma unroll
        for (int s = 0; s < 2; ++s) { u32x4 t; t.x = cvtpk(w[8 * s + 0], w[8 * s + 1]); t.y = cvtpk(w[8 * s + 2], w[8 * s + 3]); t.z = cvtpk(w[8 * s + 4], w[8 * s + 5]); t.w = cvtpk(w[8 * s + 6], w[8 * s + 7]);
            pf[s] = __builtin_bit_cast(bf16x8, t); }
#pragma unroll
        for (int d = 0; d < 4; ++d)
#pragma unroll
            for (int s = 0; s < 2; ++s) o[d] = MFMA32(vf[d][s], pf[s], o[d]);
    }
    float inv = 1.f;
    if (MODE == 1) { const float lt = lrun + __shfl_xor(lrun, 32); inv = 1.f / lt; }
    bf16* op = mix + (row0 + q0 + n) * (size_t)D + h * 128 + 4 * hi;
#pragma unroll
    for (int d = 0; d < 4; ++d)
#pragma unroll
        for (int g = 0; g < 4; ++g) { u32x2 t; t.x = cvtpk(o[d][4 * g] * inv, o[d][4 * g + 1] * inv); t.y = cvtpk(o[d][4 * g + 2] * inv, o[d][4 * g + 3] * inv);
            *(u32x2*)(op + d * 32 + 8 * g) = t; }
}

constexpr int DL_SEL = 0, DL_MISC = 16384, DL_HIST = 17408, DL_CAND = DL_HIST + 8 * 8192, DL_P = DL_CAND + 8 * 512, DL_INVL = DL_P + 8 * 4096, DL_END = DL_INVL + 8 * 16;
static_assert(DL_END <= RING_BYTES, "DSA LDS map");
constexpr int NBIN = 2048;

__device__ __forceinline__ void topk_row(const float* S, int c, LAS unsigned short* sel, LAS unsigned* hist, LAS float* cval, LAS int* cidx, int lane) {
    const f32x4* S4 = (const f32x4*)S; const int c4 = c >> 2;
    float lo = 3e38f, hi = -3e38f;
    for (int i = lane; i < c4; i += 64) { const f32x4 v = S4[i]; lo = fminf(lo, fminf(fminf(v.x, v.y), fminf(v.z, v.w))); hi = fmaxf(hi, fmaxf(fmaxf(v.x, v.y), fmaxf(v.z, v.w))); }
    lo = wave_min(lo); hi = wave_max(hi);
    int kk = 256, mc = c;
    for (int level = 0; level < 48; ++level) {
        if (lo == hi || mc <= 64) break;
#pragma unroll
        for (int j = 0; j < NBIN / 64; ++j) hist[lane + 64 * j] = 0u;
        const float inv = (float)NBIN / (hi - lo);
        for (int i = lane; i < c4; i += 64) { const f32x4 v = S4[i];
#pragma unroll
            for (int e = 0; e < 4; ++e) { const float x = v[e]; if (x >= lo && x <= hi) { int bb = (int)((x - lo) * inv); bb = bb > NBIN - 1 ? NBIN - 1 : (bb < 0 ? 0 : bb); __hip_atomic_fetch_add(&hist[bb], 1u, __ATOMIC_RELAXED, __HIP_MEMORY_SCOPE_WORKGROUP); } } }
        LDS_WAIT(); asm volatile("" ::: "memory");
        unsigned own = 0u;
#pragma unroll
        for (int j = 0; j < 32; ++j) own += hist[32 * lane + j];
        unsigned suf = own;
#pragma unroll
        for (int o = 1; o < 64; o <<= 1) { const unsigned u = __shfl_down(suf, o); if (lane + o < 64) suf += u; }
        const unsigned long long pm = __ballot(suf >= (unsigned)kk);
        const int Ln = 63 - __builtin_clzll(pm);
        const unsigned above = __shfl(suf - own, Ln);
        const int k2 = kk - (int)above;
        int bsel = 0, kn = 1, mn = 1;
        { unsigned acc = 0u; bool found = false;
          for (int j = 31; j >= 0; --j) { const unsigned hc = hist[32 * Ln + j]; if (!found && acc + hc >= (unsigned)k2) { bsel = 32 * Ln + j; kn = k2 - (int)acc; mn = (int)hc; found = true; } if (!found) acc += hc; } }
        kk = kn; mc = mn;
        float nlo = 3e38f, nhi = -3e38f;
        for (int i = lane; i < c4; i += 64) { const f32x4 v = S4[i];
#pragma unroll
            for (int e = 0; e < 4; ++e) { const float x = v[e]; if (x >= lo && x <= hi) { int bb = (int)((x - lo) * inv); bb = bb > NBIN - 1 ? NBIN - 1 : (bb < 0 ? 0 : bb); if (bb == bsel) { nlo = fminf(nlo, x); nhi = fmaxf(nhi, x); } } } }
        lo = wave_min(nlo); hi = wave_max(nhi);
    }
    const bool tie = (lo == hi);
    const int base = 256 - kk;
    int nout = 0, ncand = 0;
    const unsigned long long ltmask = (1ull << lane) - 1ull;
    for (int i0 = 0; i0 < c; i0 += 64) { const float x = S[i0 + lane];
        const bool gt = x > hi; const unsigned long long gm = __ballot(gt);
        if (gt) { const int pos = nout + __builtin_popcountll(gm & ltmask); if (pos < 256) sel[pos] = (unsigned short)(i0 + lane); }
        nout += __builtin_popcountll(gm);
        const bool cd = (x >= lo) && (x <= hi); const unsigned long long cm = __ballot(cd);
        if (cd) { const int cp = ncand + __builtin_popcountll(cm & ltmask);
            if (tie) { if (cp < kk) sel[base + cp] = (unsigned short)(i0 + lane); }
            else if (cp < 64) { cval[cp] = x; cidx[cp] = i0 + lane; } }
        ncand += __builtin_popcountll(cm);
    }
    if (!tie) {
        LDS_WAIT(); asm volatile("" ::: "memory");
        const int nc = ncand < 64 ? ncand : 64;
        const float mv = lane < nc ? cval[lane] : 0.f; const int mi = lane < nc ? cidx[lane] : 0;
        int rank = 0;
        for (int i = 0; i < nc; ++i) { const float v = cval[i]; rank += (v > mv || (v == mv && i < lane)) ? 1 : 0; }
        if (lane < nc && rank < kk) sel[base + rank] = (unsigned short)mi;
    }
    LDS_WAIT(); asm volatile("" ::: "memory");
}

__device__ __forceinline__ void dsa_unit(const bf16* proj, bf16* mix, float* scr, LAS unsigned char* lds, int unit, int tid) {
    constexpr int ldp = NB_PAD;
    const int lane = tid & 63, wave = __builtin_amdgcn_readfirstlane(tid >> 6);
    const int tile = 255 - (unit >> 2), b = unit & 3, t0 = 32 * tile, c = ((t0 >> 6) + 1) << 6;
    const size_t row0 = (size_t)b * SEQ;
    LAS unsigned short* sel = (LAS unsigned short*)(lds + DL_SEL);
#ifndef DSA_NO_A
    if (c > 256) {
        const int qg = wave & 1, kpart = wave >> 1, ql = lane & 15, kq = lane >> 4;
        const bf16* qrow = proj + (row0 + t0 + 16 * qg + ql) * ldp;
#pragma unroll 1
        for (int hp = 0; hp < 2; ++hp) {
            bf16x8 qif[8][2];
#pragma unroll
            for (int hh = 0; hh < 8; ++hh)
#pragma unroll
                for (int kk = 0; kk < 2; ++kk) qif[hh][kk] = *(const bf16x8*)(qrow + B_QI + (8 * hp + hh) * 64 + kk * 32 + kq * 8);
            float wv[8];
            { const u32x4 w0 = *(const u32x4*)(qrow + B_WI + 8 * hp);
              wv[0] = bflo(w0.x); wv[1] = bfhi(w0.x); wv[2] = bflo(w0.y); wv[3] = bfhi(w0.y); wv[4] = bflo(w0.z); wv[5] = bfhi(w0.z); wv[6] = bflo(w0.w); wv[7] = bfhi(w0.w); }
#pragma unroll 1
            for (int kb = 16 * kpart; kb < c; kb += 64) {
                const bf16* kr = proj + (row0 + kb + ql) * ldp + B_KI + kq * 8;
                const bf16x8 k0 = *(const bf16x8*)kr, k1 = *(const bf16x8*)(kr + 32);
                float* sp = scr + (size_t)(16 * qg + ql) * c + kb + 4 * kq;
                f32x4 s = {0.f, 0.f, 0.f, 0.f};
                if (hp) s = *(const f32x4*)sp;
#pragma unroll
                for (int hh = 0; hh < 8; ++hh) { f32x4 d = {0.f, 0.f, 0.f, 0.f}; d = MFMA16(k0, qif[hh][0], d); d = MFMA16(k1, qif[hh][1], d);
#pragma unroll
                    for (int e = 0; e < 4; ++e) s[e] += wv[hh] * fmaxf(d[e], 0.f); }
                *(f32x4*)sp = s;
            }
        }
    }
#endif
    __syncthreads();
#ifndef DSA_NO_B
    LAS int* nselp = (LAS int*)(lds + DL_MISC);
    for (int qi = 0; qi < 4; ++qi) { const int ql = 4 * wave + qi;
        LAS unsigned short* s = sel + ql * 256;
        if (c > 256) { topk_row(scr + (size_t)ql * c, c, s, (LAS unsigned*)(lds + DL_HIST + wave * 8192), (LAS float*)(lds + DL_CAND + wave * 512), (LAS int*)(lds + DL_CAND + wave * 512 + 256), lane); }
        else { for (int i = lane; i < c; i += 64) s[i] = (unsigned short)i; }
    }
#endif
    const int nsel = c > 256 ? 256 : c;
    __syncthreads();
#ifndef DSA_NO_C
    LAS float* P = (LAS float*)(lds + DL_P + wave * 4096);
    LAS float* invl = (LAS float*)(lds + DL_INVL + wave * 16);
    for (int pi = 0; pi < 16; ++pi) { const int pr = 16 * wave + pi, ql = pr >> 2, g = pr & 3;
        const LAS unsigned short* s = sel + ql * 256;
        const size_t qrow = row0 + t0 + ql;
        const int r = lane & 15, kq = lane >> 4;
        bf16x8 qf[4];
#pragma unroll
        for (int kk = 0; kk < 4; ++kk) { if (r < 4) qf[kk] = *(const bf16x8*)(proj + qrow * ldp + (g * 4 + r) * 128 + kk * 32 + kq * 8); else qf[kk] = (bf16x8){0, 0, 0, 0, 0, 0, 0, 0}; }
        f32x4 lg[16]; float mx = -3e38f;
#pragma unroll
        for (int blk = 0; blk < 16; ++blk) {
            if (blk * 16 < nsel) { const int key = s[blk * 16 + r];
                const bf16* kr = proj + (row0 + key) * ldp + B_K + g * 128 + kq * 8;
                f32x4 d = {0.f, 0.f, 0.f, 0.f};
#pragma unroll
                for (int kk = 0; kk < 4; ++kk) d = MFMA16(*(const bf16x8*)(kr + kk * 32), qf[kk], d);
                lg[blk] = d; mx = fmaxf(mx, fmaxf(fmaxf(d[0], d[1]), fmaxf(d[2], d[3]))); }
            else lg[blk] = (f32x4){-3e38f, -3e38f, -3e38f, -3e38f};
        }
        mx = fmaxf(mx, __shfl_xor(mx, 16)); mx = fmaxf(mx, __shfl_xor(mx, 32));
        float ls = 0.f;
#pragma unroll
        for (int blk = 0; blk < 16; ++blk) {
            if (blk * 16 < nsel) {
#pragma unroll
                for (int e = 0; e < 4; ++e) { const float p = fexp2(lg[blk][e] - mx); ls += p; if (r < 4) P[(blk * 16 + 4 * kq + e) * 4 + r] = p; } }
        }
        ls += __shfl_xor(ls, 16); ls += __shfl_xor(ls, 32);
        if (lane < 4) invl[lane] = 1.f / ls;
        LDS_WAIT(); asm volatile("" ::: "memory");
        const int ks = lane >> 4, dc = lane & 15;
        float acc[4][8];
#pragma unroll
        for (int hd = 0; hd < 4; ++hd)
#pragma unroll
            for (int e = 0; e < 8; ++e) acc[hd][e] = 0.f;
        for (int i = 0; i < nsel / 4; ++i) { const int kp = 4 * i + ks; const int key = s[kp];
            const u32x4 v = *(const u32x4*)(proj + (row0 + key) * ldp + B_V + g * 128 + dc * 8);
            const f32x4 p4 = *(const LAS f32x4*)(P + kp * 4);
            const float vv[8] = {bflo(v.x), bfhi(v.x), bflo(v.y), bfhi(v.y), bflo(v.z), bfhi(v.z), bflo(v.w), bfhi(v.w)};
#pragma unroll
            for (int hd = 0; hd < 4; ++hd)
#pragma unroll
                for (int e = 0; e < 8; ++e) acc[hd][e] += p4[hd] * vv[e]; }
#pragma unroll
        for (int hd = 0; hd < 4; ++hd)
#pragma unroll
            for (int e = 0; e < 8; ++e) { float a = acc[hd][e]; a += __shfl_xor(a, 16); a += __shfl_xor(a, 32); acc[hd][e] = a; }
        if (ks == 0) {
#pragma unroll
            for (int hd = 0; hd < 4; ++hd) { const float il = invl[hd];
                u32x4 w; w.x = cvtpk(acc[hd][0] * il, acc[hd][1] * il); w.y = cvtpk(acc[hd][2] * il, acc[hd][3] * il); w.z = cvtpk(acc[hd][4] * il, acc[hd][5] * il); w.w = cvtpk(acc[hd][6] * il, acc[hd][7] * il);
                *(u32x4*)(mix + qrow * D + (g * 4 + hd) * 128 + dc * 8) = w; }
        }
        LDS_WAIT(); asm volatile("" ::: "memory");
    }
#endif
    __syncthreads();
}


typedef const __attribute__((address_space(4))) Args* KArgs;
__device__ __forceinline__ KArgs kargs() { auto p = __builtin_amdgcn_kernarg_segment_ptr(); asm volatile("" : "+s"(p)); return (KArgs)p; }
#define TID_VARS int tid_l = threadIdx.x; asm volatile("" : "+v"(tid_l)); const int tid = tid_l, lane = tid & 63, wave = __builtin_amdgcn_readfirstlane(tid >> 6); const int G = gridDim.x, bx = blockIdx.x; const int gw = bx * NWAVES + wave, ngw = G * NWAVES; (void)gw; (void)ngw; (void)lane; (void)G
#ifndef PHMASK
#define PHMASK 0xFFFF
#endif
#define PH(k) ((PHMASK >> (k)) & 1)

__device__ __forceinline__ void grid_bar(LAS unsigned char* lds) {
    KArgs A = kargs(); XcdBarrier b; b.bar = (unsigned*)(A->ws + WS_CTL) + CW_BAR; b.x = xb_xcc_id(); b.st = (volatile LAS unsigned*)(lds + MISC_OFF) + 8;
    xcd_barrier(b);
}
struct LayerCfg { int kind, jk, nin, npad; };
__device__ __forceinline__ LayerCfg layer_cfg(int layer) { LayerCfg c; c.kind = layer % 3; c.jk = layer / 3; c.nin = c.kind == 0 ? NA_IN : (c.kind == 1 ? NB_IN : NC_IN); c.npad = c.kind == 0 ? NA_IN : (c.kind == 1 ? NB_PAD : NC_PAD); return c; }

__device__ __forceinline__ void phase_prologue(LAS unsigned char* lds) {
    KArgs A = kargs(); TID_VARS; unsigned char* ws = A->ws;
    float2* rope32 = (float2*)(ws + WS_ROPE32); float2* rope16 = (float2*)(ws + WS_ROPE16);
    const int gt = bx * NTHR + tid, ngt = G * NTHR;
    for (int i = gt; i < SEQ * 16; i += ngt) { const int pos = i >> 4, k = i & 15; const float inv = exp2f(-(float)k * (1.f / 16.f) * 18.931568569324174f);
        const float ang = (float)pos * inv; float s, c; sincosf(ang, &s, &c); rope32[i] = make_float2(c, s); }
    for (int i = gt; i < SEQ * 8; i += ngt) { const int pos = i >> 3, k = i & 7; const float inv = exp2f(-(float)k * (1.f / 8.f) * 18.931568569324174f);
        const float ang = (float)pos * inv; float s, c; sincosf(ang, &s, &c); rope16[i] = make_float2(c, s); }
    const f32x4* p4 = (const f32x4*)A->in[I_P]; u32x2* pb2 = (u32x2*)(ws + WS_PB);
    for (size_t i = gt; i < (size_t)DEPTH * M * PLE / 4; i += ngt) { const f32x4 v = p4[i]; pb2[i] = (u32x2){cvtpk(v.x, v.y), cvtpk(v.z, v.w)}; }
}
__device__ __forceinline__ void phase_convert_norm1(LAS unsigned char* lds, int layer) {
    KArgs A = kargs(); TID_VARS; unsigned char* ws = A->ws; const LayerCfg L = layer_cfg(layer);
    LAS float* scrw = (LAS float*)(lds + RING_OFF + wave * 8448);
    const float* w_in = L.kind == 0 ? A->in[I_A_WIN] + (size_t)L.jk * D * NA_IN : (L.kind == 1 ? A->in[I_B_WIN] : A->in[I_C_WIN]);
    convert_weight(w_in, D, L.nin, L.npad, (bf16*)(ws + WS_WIN), scrw, gw, ngw, lane);
    convert_weight(A->in[I_WO] + (size_t)layer * D * D, D, D, D, (bf16*)(ws + WS_WO), scrw, gw, ngw, lane);
    convert_weight(A->in[I_WUP] + (size_t)layer * D * FF, D, FF, FF, (bf16*)(ws + WS_WUP), scrw, gw, ngw, lane);
    convert_weight(A->in[I_WDOWN] + (size_t)layer * FF * D, FF, D, D, (bf16*)(ws + WS_WDN), scrw, gw, ngw, lane);
    convert_weight(A->in[I_WGATE] + (size_t)layer * D * D, D, D, D, (bf16*)(ws + WS_WG), scrw, gw, ngw, lane);
    convert_weight(A->in[I_WPLE] + (size_t)layer * PLE * D, PLE, D, D, (bf16*)(ws + WS_WPL), scrw, gw, ngw, lane);
    const float* hsrc = layer == 0 ? A->in[I_X] : (const float*)A->out;
    rmsnorm_rows(hsrc, A->in[I_ATTN_NORM] + layer * D, (bf16*)(ws + WS_HN), gw, ngw, lane);
}
__device__ __forceinline__ void phase_norm(LAS unsigned char* lds, int layer, int which) {
    KArgs A = kargs(); TID_VARS; unsigned char* ws = A->ws;
    rmsnorm_rows(A->out, A->in[which] + layer * D, (bf16*)(ws + WS_HN), gw, ngw, lane);
}
__device__ __forceinline__ void phase_inproj(LAS unsigned char* lds, int layer) {
    KArgs A = kargs(); TID_VARS; unsigned char* ws = A->ws; const LayerCfg L = layer_cfg(layer);
    pg8::Gemm g{(const bf16*)(ws + WS_HN), (const bf16*)(ws + WS_WIN), M, L.npad, D}; pg8::StaticOrder S; S.init(M, L.npad, G, bx);
    pg8::EpiStoreBf16 E{(bf16*)(ws + WS_PROJ), L.npad};
    pg8::gemm_phase<pg8::EpiStoreBf16, pg8::StaticOrder, true, true>(lds + RING_OFF, g, S, E);
}
__device__ __forceinline__ float zbound2(const float* gq, const float* gk, int lane) {
    const float a = wave_max(fmaxf(fabsf(gq[lane]), fabsf(gq[lane + 64]))), bq = wave_max(fmaxf(fabsf(gk[lane]), fabsf(gk[lane + 64])));
    return a * bq * 11.313708498984761f * LOG2E * 1.02f;
}
__device__ __forceinline__ void phase_postproj_dense(LAS unsigned char* lds, int layer) {
    KArgs A = kargs(); TID_VARS; unsigned char* ws = A->ws; const LayerCfg L = layer_cfg(layer);
    bf16* PROJ = (bf16*)(ws + WS_PROJ); LAS float* scrw = (LAS float*)(lds + RING_OFF + wave * 8448);
    const float* gq = L.kind == 0 ? A->in[I_A_QN] + L.jk * HD : A->in[I_C_QN]; const float* gk = L.kind == 0 ? A->in[I_A_KN] + L.jk * HD : A->in[I_C_KN];
    const int npad = L.npad;
    const int nscan = L.kind == 2 ? 64 : 0, nvt = BATCH * 256 * 16, total = nscan + nvt + M;
    for (int it = gw; it < total; it += ngw) {
        if (it < nscan) { cum_item(PROJ, npad, A->in[I_C_BF], (float*)(ws + WS_CUM), it, lane); continue; }
        int r = it - nscan;
        if (r < nvt) { vt_item(PROJ, npad, 2 * D, (bf16*)(ws + WS_VT), (LAS unsigned char*)scrw, r, lane); continue; }
        r -= nvt;
        bf16* base = PROJ + (size_t)r * npad + 8 * lane;
#pragma unroll
        for (int j = 0; j < 4; ++j) head128_norm<false>(base + 512 * j, gq, QSCALE, nullptr, lane);
#pragma unroll
        for (int j = 0; j < 4; ++j) head128_norm<false>(base + D + 512 * j, gk, 1.f, nullptr, lane);
    }
}
__device__ __forceinline__ void phase_postproj_dsa(LAS unsigned char* lds) {
    KArgs A = kargs(); TID_VARS; unsigned char* ws = A->ws;
    bf16* PROJ = (bf16*)(ws + WS_PROJ); const float2* rope32 = (const float2*)(ws + WS_ROPE32); const float2* rope16 = (const float2*)(ws + WS_ROPE16);
    const float* gq = A->in[I_B_QN]; const float* gk = A->in[I_B_KN]; const float* gi = A->in[I_B_IKN];
    constexpr int npad = NB_PAD;
    for (int r = gw; r < M; r += ngw) { const int pos = r & (SEQ - 1);
        bf16* base = PROJ + (size_t)r * npad;
        const float2* r32 = rope32 + pos * 16; const float2* r16 = rope16 + pos * 8;
#pragma unroll
        for (int j = 0; j < 4; ++j) head128_norm<true>(base + 512 * j + 8 * lane, gq, QSCALE, r32, lane);
        head128_norm<true>(base + B_K + 8 * lane, gk, 1.f, r32, lane);
#pragma unroll
        for (int j = 0; j < 2; ++j) head64_rope<false>(base + B_QI + 512 * j + 8 * lane, nullptr, r16, lane, true);
        head64_rope<true>(base + B_KI + 8 * (lane & 7), gi, r16, lane, lane < 8);
        if (lane < 2) { bf16* wp = base + B_WI + 8 * lane; const u32x4 raw = *(const u32x4*)wp;
            u32x4 w; w.x = cvtpk(bflo(raw.x) * 0.03125f, bfhi(raw.x) * 0.03125f); w.y = cvtpk(bflo(raw.y) * 0.03125f, bfhi(raw.y) * 0.03125f);
            w.z = cvtpk(bflo(raw.z) * 0.03125f, bfhi(raw.z) * 0.03125f); w.w = cvtpk(bflo(raw.w) * 0.03125f, bfhi(raw.w) * 0.03125f); *(u32x4*)wp = w; }
    }
}
template <int MODE>
__device__ __forceinline__ void phase_attn_dense(LAS unsigned char* lds, int layer) {
    KArgs A = kargs(); TID_VARS; unsigned char* ws = A->ws; const LayerCfg L = layer_cfg(layer);
    const float* gq = L.kind == 0 ? A->in[I_A_QN] + L.jk * HD : A->in[I_C_QN]; const float* gk = L.kind == 0 ? A->in[I_A_KN] + L.jk * HD : A->in[I_C_KN];
    const float zb2 = zbound2(gq, gk, lane);
    gu32* qhead = (gu32*)(ws + WS_CTL) + CW_QUEUE + 64 * layer;
    for (;;) { unsigned it = 0; if (lane == 0) it = __hip_atomic_fetch_add(qhead, 1u, RLX_AGENT); it = __shfl(it, 0);
        if (it >= 256u * 64u) break;
        attn_dense_item<MODE>((const bf16*)(ws + WS_PROJ), L.npad, (const bf16*)(ws + WS_VT), (const float*)(ws + WS_CUM), (bf16*)(ws + WS_MIX), zb2, (int)it, lane); }
}
__device__ __forceinline__ void phase_attn_dsa(LAS unsigned char* lds, int layer) {
    KArgs A = kargs(); TID_VARS; unsigned char* ws = A->ws;
    gu32* qhead = (gu32*)(ws + WS_CTL) + CW_QUEUE + 64 * layer;
    float* scr = (float*)(ws + (bx < 128 ? WS_SCR_A + (size_t)bx * MiB : WS_SCR_B + (size_t)(bx - 128) * MiB));
    volatile LAS unsigned* uw = (volatile LAS unsigned*)(lds + RING_OFF + DL_MISC + 128);
    for (;;) { if (tid == 0) uw[0] = __hip_atomic_fetch_add(qhead, 1u, RLX_AGENT); __syncthreads(); const unsigned u = uw[0]; __syncthreads();
        if (u >= 1024u) break; dsa_unit((const bf16*)(ws + WS_PROJ), (bf16*)(ws + WS_MIX), scr, lds + RING_OFF, (int)u, tid); }
}
__device__ __forceinline__ void phase_wo(LAS unsigned char* lds, int layer) {
    KArgs A = kargs(); TID_VARS; unsigned char* ws = A->ws;
    pg8::Gemm g{(const bf16*)(ws + WS_MIX), (const bf16*)(ws + WS_WO), M, D, D}; pg8::StaticOrder S; S.init(M, D, G, bx);
    pg8::EpiResid E{layer == 0 ? A->in[I_X] : (const float*)A->out, A->out, D};
    pg8::gemm_phase<pg8::EpiResid, pg8::StaticOrder, true, true>(lds + RING_OFF, g, S, E);
}
__device__ __forceinline__ void phase_up(LAS unsigned char* lds) {
    KArgs A = kargs(); TID_VARS; unsigned char* ws = A->ws;
    pg8::Gemm g{(const bf16*)(ws + WS_HN), (const bf16*)(ws + WS_WUP), M, FF, D}; pg8::StaticOrder S; S.init(M, FF, G, bx);
    pg8::EpiRelu2 E{(bf16*)(ws + WS_HID), FF};
    pg8::gemm_phase<pg8::EpiRelu2, pg8::StaticOrder, true, true>(lds + RING_OFF, g, S, E);
}
__device__ __forceinline__ void phase_down(LAS unsigned char* lds) {
    KArgs A = kargs(); TID_VARS; unsigned char* ws = A->ws;
    pg8::Gemm g{(const bf16*)(ws + WS_HID), (const bf16*)(ws + WS_WDN), M, D, FF}; pg8::StaticOrder S; S.init(M, D, G, bx);
    pg8::EpiResid E{A->out, A->out, D};
    pg8::gemm_phase<pg8::EpiResid, pg8::StaticOrder, true, true>(lds + RING_OFF, g, S, E);
}
__device__ __forceinline__ void phase_pp(LAS unsigned char* lds, int layer) {
    KArgs A = kargs(); TID_VARS; unsigned char* ws = A->ws;
    int kpl = PLE; asm volatile("" : "+s"(kpl));
    pg8::Gemm g{(const bf16*)(ws + WS_PB) + (size_t)layer * M * PLE, (const bf16*)(ws + WS_WPL), M, D, kpl}; pg8::StaticOrder S; S.init(M, D, G, bx);
    pg8::EpiStoreBf16 E{(bf16*)(ws + WS_PP), D};
    pg8::gemm_phase<pg8::EpiStoreBf16, pg8::StaticOrder, true, true>(lds + RING_OFF, g, S, E);
}
__device__ __forceinline__ void phase_gate(LAS unsigned char* lds) {
    KArgs A = kargs(); TID_VARS; unsigned char* ws = A->ws;
    pg8::Gemm g{(const bf16*)(ws + WS_HN), (const bf16*)(ws + WS_WG), M, D, D}; pg8::StaticOrder S; S.init(M, D, G, bx);
    pg8::EpiGate E{A->out, (const bf16*)(ws + WS_PP), D};
    pg8::gemm_phase<pg8::EpiGate, pg8::StaticOrder, true, true>(lds + RING_OFF, g, S, E);
}

__global__ void __launch_bounds__(NTHR, 2) trunk_fwd(Args args) {
    extern __shared__ __attribute__((aligned(16))) unsigned char lds_raw[];
    LAS unsigned char* lds = (LAS unsigned char*)lds_raw;
    for (int u = threadIdx.x; u < (LDS_BYTES - LDSCTL_OFF) / 4; u += NTHR) ((LAS unsigned*)(lds + LDSCTL_OFF))[u] = 0u;
    __syncthreads();
    { KArgs A = kargs(); (void)xcd_barrier_post((unsigned*)(A->ws + WS_CTL) + CW_BAR, (volatile LAS unsigned*)(lds + MISC_OFF) + 8); }
    if (PH(0)) phase_prologue(lds);
    for (int layer = 0; layer < DEPTH; ++layer) {
        const int kind = layer % 3;
        if (PH(1)) phase_convert_norm1(lds, layer);
        grid_bar(lds);
        if (PH(2)) phase_inproj(lds, layer);
        grid_bar(lds);
        if (PH(3)) { if (kind != 1) phase_postproj_dense(lds, layer); else phase_postproj_dsa(lds); }
        grid_bar(lds);
        if (kind == 0) { if (PH(11)) phase_attn_dense<0>(lds, layer); }
        else if (kind == 2) { if (PH(12)) phase_attn_dense<1>(lds, layer); }
        else { if (PH(13)) phase_attn_dsa(lds, layer); }
        grid_bar(lds);
        if (PH(5)) phase_wo(lds, layer);
        grid_bar(lds);
        if (PH(6)) phase_norm(lds, layer, I_MLP_NORM);
        grid_bar(lds);
        if (PH(7)) phase_up(lds);
        grid_bar(lds);
        if (PH(8)) phase_down(lds);
        grid_bar(lds);
        if (PH(14)) phase_norm(lds, layer, I_PLE_NORM);
        if (PH(9)) phase_pp(lds, layer);
        grid_bar(lds);
        if (PH(10)) phase_gate(lds);
        grid_bar(lds);
    }
}

extern "C" void kernel_launch(void* const* d_in, const int* in_sizes, int n_in, void* d_out, int out_size, void* d_ws, size_t ws_size, hipStream_t stream) {
    static int grid = 0;
    if (grid == 0) {
        if (n_in != 21 || out_size != M * D || ws_size < WS_END) { fprintf(stderr, "kernel_launch: unexpected shapes (n_in %d, out %d, ws %zu)\n", n_in, out_size, ws_size); grid = -1; return; }
        int dev = 0, cus = 0, per_cu = 0;
        if (hipGetDevice(&dev) != hipSuccess || hipDeviceGetAttribute(&cus, hipDeviceAttributeMultiprocessorCount, dev) != hipSuccess) { grid = -1; return; }
        if (hipFuncSetAttribute((const void*)trunk_fwd, hipFuncAttributeMaxDynamicSharedMemorySize, LDS_BYTES) != hipSuccess) { fprintf(stderr, "kernel_launch: hipFuncSetAttribute failed\n"); grid = -1; return; }
        if (hipOccupancyMaxActiveBlocksPerMultiprocessor(&per_cu, (const void*)trunk_fwd, NTHR, LDS_BYTES) != hipSuccess || per_cu < 1) { fprintf(stderr, "kernel_launch: occupancy query says %d\n", per_cu); }
        (void)hipGetLastError();
        grid = cus > 256 ? 256 : cus;
    }
    if (grid < 0) return;
    if (hipMemsetAsync((char*)d_ws + WS_CTL, 0, CTL_ZERO_BYTES, stream) != hipSuccess) return;
    Args a{};
    for (int i = 0; i < 21; ++i) a.in[i] = (const float*)d_in[i];
    a.out = (float*)d_out; a.ws = (unsigned char*)d_ws;
    hipLaunchKernelGGL(trunk_fwd, dim3(grid), dim3(NTHR), LDS_BYTES, stream, a);
}
```

```cpp
#include <hip/hip_runtime.h>
#include <cstdio>
#include <cstdint>
namespace pg8 {
#define PG8_LAS __attribute__((address_space(3)))
typedef unsigned short bf16_t;
typedef short bf16x8 __attribute__((ext_vector_type(8)));
typedef float f32x4 __attribute__((ext_vector_type(4)));
typedef unsigned u32x4 __attribute__((ext_vector_type(4)));
constexpr int BM = 256, BK = 64, HALF = 128, HTB = HALF * BK * 2  , STAGE_BYTES = 8 * HTB, NXCD = 8, WGM = 8;

__host__ __device__ __forceinline__ int lds_byte(int r, int c) { const int st = (r >> 4) * 2 + (c >> 5), rr = r & 15, cc = c & 31, ob = rr * 64 + cc * 2; return st * 1024 + (ob ^ (((ob >> 9) & 1) << 5)); }
__host__ __device__ __forceinline__ void stage_rc(int b, int& R, int& C) { const int st = b / 1024, sb = b % 1024, swz = sb ^ (((sb >> 9) & 1) << 5); R = (st >> 1) * 16 + swz / 64; C = (st & 1) * 32 + (swz % 64) / 2; }
__host__ __device__ __forceinline__ int perm32(int rho) { const int n = rho >> 4, i = rho & 15; return 8 * (i >> 2) + 4 * n + (i & 3); }

struct Unit { int pm, pn; };
struct Gemm { const bf16_t* A; const bf16_t* Bt; int M, N, K; };

struct StaticOrder {
    int nM, nN, nwg, G, c, wgm;
    __host__ __device__ void init(int M, int N, int G_, int c_, int wgm_ = 4) { nM = M / BM; nN = N / BM; nwg = nM * nN; G = G_; c = c_; wgm = wgm_; }
    __host__ __device__ bool next(int i, Unit& u) const {
        const long L = (long)i * G + c; if (L >= nwg) return false;
        int wgid = (int)L; { const int q = nwg / NXCD, r = nwg % NXCD, xcd = wgid % NXCD, off = wgid / NXCD; wgid = (xcd < r ? xcd * (q + 1) : r * (q + 1) + (xcd - r) * q) + off; }
        const int nig = wgm * nN, gid = wgid / nig, fm = gid * wgm, gsz = (nM - fm) < wgm ? (nM - fm) : wgm;
        u.pm = fm + ((wgid % nig) % gsz); u.pn = (wgid % nig) / gsz; return true;
    }
    __device__ __forceinline__ void a_ready(const Unit&) const {}
    __device__ __forceinline__ void done(const Unit&) const {}
};

__device__ __forceinline__ unsigned cvt_pk_bf16(float lo, float hi) { unsigned r; asm volatile("v_cvt_pk_bf16_f32 %0, %1, %2" : "=v"(r) : "v"(lo), "v"(hi)); return r; }
typedef float f32x2 __attribute__((ext_vector_type(2)));
template <class Epi, class Sched, bool ALIGN_EPI = false, bool SP2 = false>
__device__ __forceinline__ void gemm_phase(PG8_LAS unsigned char* lds, const Gemm g, const Sched& S, const Epi& E) {
    int tid_l = threadIdx.x; asm volatile("" : "+v"(tid_l));
    const int tid = tid_l, wid = __builtin_amdgcn_readfirstlane(tid >> 6), lane = tid & 63, wr = wid >> 2, wc = wid & 3, fr = lane & 15, fq = lane >> 4;
    const int K = g.K, nt = K / BK;
    unsigned voffA[2], voffB[2];
#pragma unroll
    for (int i = 0; i < 2; ++i) { int R, C; stage_rc(tid * 16 + i * 8192, R, C); const int Rb = Epi::PERM ? ((R & ~31) + perm32(R & 31)) : R;
        voffA[i] = (unsigned)(R * K + C) * 2u; voffB[i] = (unsigned)(Rb * K + C) * 2u; }
    const size_t kstep = (size_t)(BK * 2);
    const size_t hstep = (size_t)HALF * K * 2;
    const size_t tstep = 2 * hstep;
    const unsigned ldsw = (unsigned)wid * 1024u;
    const int aoff = lds_byte(wr * 64 + fr, fq * 8), boff = lds_byte(wc * 32 + fr, fq * 8);
#define PG8_SA(b, h) (((b) * 2 + (h)) * HTB)
#define PG8_SB(b, h) ((4 + (b) * 2 + (h)) * HTB)
#define PG8_STAGE(bufoff, gbase, voff) do { _Pragma("unroll") for (int _i = 0; _i < 2; ++_i) \
        __builtin_amdgcn_global_load_lds((const unsigned*)((const char*)(gbase) + (voff)[_i]), (PG8_LAS unsigned*)(lds + (bufoff) + ldsw + _i * 8192), 16, 0, 0); } while (0)
#define PG8_LDA(dst, b, h) do { _Pragma("unroll") for (int m = 0; m < 4; ++m) _Pragma("unroll") for (int k = 0; k < 2; ++k) dst[m][k] = *(const PG8_LAS bf16x8*)(lds + PG8_SA(b, h) + aoff + m * 2048 + k * 1024); } while (0)
#define PG8_LDB(dst, b, h) do { _Pragma("unroll") for (int n = 0; n < 2; ++n) _Pragma("unroll") for (int k = 0; k < 2; ++k) dst[n][k] = *(const PG8_LAS bf16x8*)(lds + PG8_SB(b, h) + boff + n * 2048 + k * 1024); } while (0)
#define PG8_MMA(ai, bj, At, Bt) do { __builtin_amdgcn_s_setprio(1); _Pragma("unroll") for (int m = 0; m < 4; ++m) _Pragma("unroll") for (int n = 0; n < 2; ++n) _Pragma("unroll") for (int k = 0; k < 2; ++k) \
        acc[ai][bj][m][n] = __builtin_amdgcn_mfma_f32_16x16x32_bf16(Bt[n][k], At[m][k], acc[ai][bj][m][n], 0, 0, 0); __builtin_amdgcn_s_setprio(0); } while (0)
#define PG8_WAIT_V(n) asm volatile("s_waitcnt vmcnt(" #n ")" ::: "memory")
#define PG8_WAIT_L(n) asm volatile("s_waitcnt lgkmcnt(" #n ")" ::: "memory")
#define PG8_BAR __builtin_amdgcn_s_barrier()
#define PG8_SCHED __builtin_amdgcn_sched_barrier(0)
    Unit cur, nxt; int ui = 0;
    if (!S.next(0, cur)) return;
    f32x4 acc[2][2][4][2];
#pragma unroll
    for (int a = 0; a < 2; ++a)
#pragma unroll
        for (int b = 0; b < 2; ++b)
#pragma unroll
            for (int m = 0; m < 4; ++m)
#pragma unroll
                for (int n = 0; n < 2; ++n) acc[a][b][m][n] = (f32x4){0.f, 0.f, 0.f, 0.f};
    bf16x8 At[4][2], B0[2][2], B1[2][2];
    const char* cA = (const char*)g.A + (size_t)cur.pm * tstep; const char* cB = (const char*)g.Bt + (size_t)cur.pn * tstep;
    S.a_ready(cur);
    if constexpr (SP2) {
        PG8_STAGE(PG8_SB(0, 0), cB, voffB); PG8_STAGE(PG8_SB(0, 1), cB + hstep, voffB); PG8_STAGE(PG8_SA(0, 0), cA, voffA); PG8_STAGE(PG8_SA(0, 1), cA + hstep, voffA);
        if (wr == 1) PG8_BAR;
        PG8_WAIT_V(2); PG8_BAR;
        PG8_STAGE(PG8_SB(1, 0), cB + kstep, voffB); PG8_STAGE(PG8_SA(1, 0), cA + kstep, voffA); PG8_STAGE(PG8_SB(1, 1), cB + hstep + kstep, voffB);
        PG8_WAIT_V(6); PG8_BAR;
    } else {
        PG8_STAGE(PG8_SB(0, 0), cB, voffB); PG8_STAGE(PG8_SA(0, 0), cA, voffA); PG8_STAGE(PG8_SB(0, 1), cB + hstep, voffB); PG8_STAGE(PG8_SA(0, 1), cA + hstep, voffA);
        if (wr == 1) PG8_BAR;
        PG8_WAIT_V(4); PG8_BAR;
        PG8_STAGE(PG8_SB(1, 0), cB + kstep, voffB); PG8_STAGE(PG8_SA(1, 0), cA + kstep, voffA); PG8_STAGE(PG8_SB(1, 1), cB + hstep + kstep, voffB);
        PG8_WAIT_V(6); PG8_BAR;
    }
    for (;;) {
        const bool has_next = S.next(ui + 1, nxt);
        const char* nA = has_next ? (const char*)g.A + (size_t)nxt.pm * tstep : cA; const char* nB = has_next ? (const char*)g.Bt + (size_t)nxt.pn * tstep : cB;
        for (int t = 0; t < nt; t += 2) {
            const bool last = (t == nt - 2);
            const char* a1 = cA + (size_t)(t + 1) * kstep;
            const char* a2 = last ? nA : cA + (size_t)(t + 2) * kstep; const char* b2 = last ? nB : cB + (size_t)(t + 2) * kstep;
            const char* a3 = a2 + kstep; const char* b3 = b2 + kstep;
            if (last && has_next) S.a_ready(nxt);
            if constexpr (SP2) {
            PG8_LDB(B0, 0, 0); PG8_LDB(B1, 0, 1); PG8_SCHED; PG8_LDA(At, 0, 0); PG8_STAGE(PG8_SA(1, 1), a1 + hstep, voffA);
            PG8_WAIT_V(8); PG8_WAIT_L(0); PG8_BAR; PG8_MMA(0, 0, At, B0); PG8_MMA(0, 1, At, B1); PG8_BAR; PG8_SCHED;
            PG8_LDA(At, 0, 1); PG8_STAGE(PG8_SB(0, 0), b2, voffB); PG8_STAGE(PG8_SB(0, 1), b2 + hstep, voffB); PG8_STAGE(PG8_SA(0, 0), a2, voffA);
            PG8_WAIT_V(8); PG8_WAIT_L(0); PG8_BAR; PG8_MMA(1, 0, At, B0); PG8_MMA(1, 1, At, B1); PG8_BAR; PG8_SCHED;
            PG8_LDB(B0, 1, 0); PG8_LDB(B1, 1, 1); PG8_SCHED; PG8_LDA(At, 1, 0); PG8_STAGE(PG8_SA(0, 1), a2 + hstep, voffA);
            PG8_WAIT_V(8); PG8_WAIT_L(0); PG8_BAR; PG8_MMA(0, 0, At, B0); PG8_MMA(0, 1, At, B1); PG8_BAR; PG8_SCHED;
            PG8_LDA(At, 1, 1); PG8_STAGE(PG8_SB(1, 0), b3, voffB); PG8_STAGE(PG8_SB(1, 1), b3 + hstep, voffB); PG8_STAGE(PG8_SA(1, 0), a3, voffA);
            PG8_WAIT_V(8); PG8_WAIT_L(0); PG8_BAR; PG8_MMA(1, 0, At, B0); PG8_MMA(1, 1, At, B1); PG8_BAR; PG8_SCHED;
            } else {
            PG8_LDB(B0, 0, 0); PG8_SCHED; PG8_LDA(At, 0, 0); PG8_STAGE(PG8_SA(1, 1), a1 + hstep, voffA);
            PG8_WAIT_L(8); PG8_BAR; PG8_WAIT_L(0); PG8_MMA(0, 0, At, B0); PG8_BAR; PG8_SCHED;
            PG8_LDB(B1, 0, 1); PG8_STAGE(PG8_SB(0, 0), b2, voffB);
            PG8_BAR; PG8_WAIT_L(0); PG8_MMA(0, 1, At, B1); PG8_BAR;
            PG8_LDA(At, 0, 1); PG8_STAGE(PG8_SA(0, 0), a2, voffA);
            PG8_BAR; PG8_WAIT_L(0); PG8_MMA(1, 0, At, B0); PG8_BAR; PG8_SCHED;
            PG8_STAGE(PG8_SB(0, 1), b2 + hstep, voffB);
            PG8_WAIT_V(6); PG8_BAR; PG8_MMA(1, 1, At, B1); PG8_BAR;
            PG8_LDB(B0, 1, 0); PG8_SCHED; PG8_LDA(At, 1, 0); PG8_STAGE(PG8_SA(0, 1), a2 + hstep, voffA);
            PG8_WAIT_L(8); PG8_BAR; PG8_WAIT_L(0); PG8_MMA(0, 0, At, B0); PG8_BAR; PG8_SCHED;
            PG8_LDB(B1, 1, 1); PG8_STAGE(PG8_SB(1, 0), b3, voffB);
            PG8_BAR; PG8_WAIT_L(0); PG8_MMA(0, 1, At, B1); PG8_BAR;
            PG8_LDA(At, 1, 1); PG8_STAGE(PG8_SA(1, 0), a3, voffA);
            PG8_BAR; PG8_WAIT_L(0); PG8_MMA(1, 0, At, B0); PG8_BAR; PG8_SCHED;
            PG8_STAGE(PG8_SB(1, 1), b3 + hstep, voffB);
            PG8_WAIT_V(6); PG8_BAR; PG8_MMA(1, 1, At, B1); PG8_BAR;
            }
        }
        if constexpr (ALIGN_EPI) { if (wr == 0) PG8_BAR; }
#ifdef PROBE_EPI
        const unsigned long long te0_ = __builtin_amdgcn_s_memrealtime();
#endif
        if constexpr (!Epi::AFTER_DRAIN) { E(acc, cur, wr, wc, fr, fq); S.done(cur); }
#ifdef PROBE_EPI
        if (tid == 0) { volatile PG8_LAS unsigned long long* pe_ = (volatile PG8_LAS unsigned long long*)(lds + 131072 + 320 + 64); pe_[0] = pe_[0] + (__builtin_amdgcn_s_memrealtime() - te0_); }
#endif
        if (!has_next) break;
#pragma unroll
        for (int a = 0; a < 2; ++a)
#pragma unroll
            for (int b = 0; b < 2; ++b)
#pragma unroll
                for (int m = 0; m < 4; ++m)
#pragma unroll
                    for (int n = 0; n < 2; ++n) acc[a][b][m][n] = (f32x4){0.f, 0.f, 0.f, 0.f};
        cur = nxt; cA = nA; cB = nB; ++ui;
        if constexpr (ALIGN_EPI) { if (wr == 1) PG8_BAR; }
    }
    PG8_WAIT_V(0);
    if constexpr (!ALIGN_EPI) { if (wr == 0) PG8_BAR; }
    PG8_BAR;
    if constexpr (Epi::AFTER_DRAIN) { E.fused(acc, cur, wr, wc, fr, fq, lds, wid, lane); S.done(cur); }
#undef PG8_SA
#undef PG8_SB
#undef PG8_STAGE
#undef PG8_LDA
#undef PG8_LDB
#undef PG8_MMA
#undef PG8_WAIT_V
#undef PG8_WAIT_L
#undef PG8_BAR
#undef PG8_SCHED
}
}
#define GAS __attribute__((address_space(1)))
#define LAS __attribute__((address_space(3)))
typedef unsigned short bf16;
typedef unsigned v4u __attribute__((ext_vector_type(4)));
typedef float f32x4 __attribute__((ext_vector_type(4)));
typedef short bf16x8 __attribute__((ext_vector_type(8)));
typedef GAS unsigned gu32;
typedef GAS unsigned long long gu64;
#define RLX_AGENT __ATOMIC_RELAXED, __HIP_MEMORY_SCOPE_AGENT
#define LDS_WAIT() asm volatile("s_waitcnt lgkmcnt(0)" ::: "memory")
#define VM_WAIT() asm volatile("s_waitcnt vmcnt(0)" ::: "memory")
__device__ __forceinline__ unsigned long long rt() { return __builtin_amdgcn_s_memrealtime(); }
__device__ __forceinline__ unsigned f2bf(float f) { unsigned u = __builtin_bit_cast(unsigned, f); return (u + 0x7fffu + ((u >> 16) & 1u)) >> 16; }
__device__ __forceinline__ unsigned pk2(float lo, float hi) { return f2bf(lo) | (f2bf(hi) << 16); }
typedef unsigned u32x4 __attribute__((ext_vector_type(4)));
#define XB_TMO      128
#define XB_XCNT(j)  (256  + 64 * (j))
#define XB_XSUB(j)  (1280 + 64 * (j))
#define XB_XGEN(j)  (2304 + 64 * (j))
#define XB_TOP      3328
#define XB_TOPGEN   3392
#define XCD_BAR_WORDS 3456
#define XB_SPIN_CAP (1u << 18)

__device__ __forceinline__ unsigned xb_ld(unsigned* p)              { return __hip_atomic_load(p, __ATOMIC_RELAXED, __HIP_MEMORY_SCOPE_AGENT); }
__device__ __forceinline__ unsigned xb_add(unsigned* p, unsigned v) { return __hip_atomic_fetch_add(p, v, __ATOMIC_RELAXED, __HIP_MEMORY_SCOPE_AGENT); }
__device__ __forceinline__ unsigned xb_xcc_id() { return (unsigned)__builtin_amdgcn_s_getreg((3 << 11) | 20) & 0xFu; }
#define XB_SPIN(cond, bar) do { unsigned _sp = 0; while (cond) { __builtin_amdgcn_s_sleep(1); \
    if ((++_sp & 255u) == 0u) { if (xb_ld(&(bar)[XB_TMO])) break; if (_sp > XB_SPIN_CAP) { atomicAdd(&(bar)[XB_TMO], 1u); break; } } } } while (0)

struct XcdBarrier {
    unsigned* bar; unsigned x;
    volatile LAS unsigned* st;
};

__device__ __forceinline__ XcdBarrier xcd_barrier_post(unsigned* bar, volatile LAS unsigned* st) {
    XcdBarrier b; b.bar = bar; b.x = xb_xcc_id(); b.st = st;
    if (threadIdx.x == 0) (void)xb_add(&bar[XB_XCNT(b.x)], 1u);
    return b;
}
__device__ __forceinline__ void xcd_barrier_complete(unsigned* bar, unsigned x, unsigned& nloc, unsigned& nx) {
    const unsigned G = gridDim.x * gridDim.y * gridDim.z;
    unsigned sum, cnt, mine, sp = 0u;
    for (;;) {
        sum = 0u; cnt = 0u; mine = 0u;
#pragma unroll
        for (unsigned j = 0; j < 16; ++j) { const unsigned c = xb_ld(&bar[XB_XCNT(j)]); sum += c; cnt += (c > 0u) ? 1u : 0u; mine = (j == x) ? c : mine; }
        if (sum == G) break;
        __builtin_amdgcn_s_sleep(1);
        if ((++sp & 255u) == 0u) { if (xb_ld(&bar[XB_TMO])) break; if (sp > XB_SPIN_CAP) { atomicAdd(&bar[XB_TMO], 1u); break; } }
    }
    nloc = mine > 0u ? mine : 1u; nx = cnt > 0u ? cnt : 1u;
}

__device__ __forceinline__ void xcd_barrier(const XcdBarrier& b) {
    asm volatile("s_waitcnt vmcnt(0)" ::: "memory");
    __syncthreads();
    if (threadIdx.x == 0) {
        unsigned* bar = b.bar;
        __builtin_amdgcn_s_waitcnt(0);
        unsigned nloc = b.st[0], nx = b.st[1];
        if (nloc == 0u) { xcd_barrier_complete(bar, b.x, nloc, nx); b.st[0] = nloc; b.st[1] = nx; }
        const unsigned old = xb_add(&bar[XB_XSUB(b.x)], 1u);
        const unsigned gen = old / nloc;
        if (old + 1u == (gen + 1u) * nloc) {
            __builtin_amdgcn_fence(__ATOMIC_RELEASE, "agent");
            asm volatile("s_waitcnt vmcnt(0)" ::: "memory");
            const unsigned og = xb_add(&bar[XB_TOP], 1u);
            const unsigned tg = og / nx;
            if (og + 1u == (tg + 1u) * nx) xb_add(&bar[XB_TOPGEN], 1u);
            else XB_SPIN(xb_ld(&bar[XB_TOPGEN]) == tg, bar);
            __builtin_amdgcn_fence(__ATOMIC_ACQUIRE, "agent");
            xb_add(&bar[XB_XGEN(b.x)], 1u);
            asm volatile("s_waitcnt vmcnt(0)" ::: "memory");
        } else {
            XB_SPIN(xb_ld(&bar[XB_XGEN(b.x)]) == gen, bar);
            __builtin_amdgcn_fence(__ATOMIC_ACQUIRE, "agent");
            asm volatile("s_waitcnt vmcnt(0)" ::: "memory");
        }
    }
    __syncthreads();
}

constexpr int NWAVES = 8, NTHR = 512;
constexpr int BATCH = 4, SEQ = 8192, M = BATCH * SEQ, D = 2048, NH = 16, HD = 128, FF = 8192, PLE = 256, DEPTH = 4;
constexpr int NA_IN = 6144, NB_IN = 4176, NB_PAD = 4352, NC_IN = 6160, NC_PAD = 6400;
constexpr int B_K = 2048, B_V = 2560, B_QI = 3072, B_KI = 4096, B_WI = 4160;
constexpr float RMS_EPS = 1e-6f, LOG2E = 1.4426950408889634f;
constexpr float QSCALE = 0.08838834764831845f * 1.4426950408889634f;
constexpr float ZERO_LOG2 = -160.f;

constexpr size_t MiB = 1u << 20;
constexpr size_t WS_CTL = 0, CTL_ZERO_BYTES = 1 * MiB;
constexpr size_t WS_ROPE32 = 1 * MiB, WS_ROPE16 = 2 * MiB, WS_CUM = 3 * MiB, WS_TOT = 5 * MiB, WS_RSTD = 6 * MiB;
constexpr size_t WS_WIN = 8 * MiB, WS_WO = 33 * MiB, WS_WUP = 41 * MiB, WS_WDN = 73 * MiB, WS_WG = 105 * MiB, WS_WPL = 113 * MiB;
constexpr size_t WS_PB = 120 * MiB, WS_HN = 184 * MiB, WS_PROJ = 312 * MiB, WS_MIX = 712 * MiB, WS_VT = 840 * MiB, WS_END = 968 * MiB;
constexpr size_t WS_HID = WS_PROJ, WS_PP = WS_VT, WS_HB0 = WS_HN, WS_HB1 = 968 * MiB, WS_SSP_IN = 1096 * MiB, WS_SSP_WO = 1100 * MiB, WS_SSP_DN = 1104 * MiB, WS_K8 = 1108 * MiB, WS_V8 = 1124 * MiB, WS_Q8 = 1140 * MiB, WS_END2 = 1204 * MiB;
constexpr size_t WS_SCR_A = WS_PROJ + 272 * MiB, WS_SCR_B = WS_VT;
static_assert(WS_HID + (size_t)M * FF * 2 <= WS_VT, "hidden overlays proj|mix");
static_assert(WS_PROJ + (size_t)M * NB_PAD * 2 <= WS_SCR_A && WS_SCR_A + 128 * MiB <= WS_MIX, "scratch A");

constexpr int CW_BAR = 4096;
constexpr int CW_QUEUE = 16384;

constexpr int RING_OFF = 0, RING_BYTES = 131072;
constexpr int LDSCTL_OFF = RING_BYTES, MISC_OFF = LDSCTL_OFF + 320;
constexpr int LDS_BYTES = 147456;

typedef float f32x16 __attribute__((ext_vector_type(16)));
typedef unsigned u32x2 __attribute__((ext_vector_type(2)));
typedef __bf16 bf16x2_t __attribute__((ext_vector_type(2)));
typedef float f32x2_t __attribute__((ext_vector_type(2)));
typedef short s16x4_t __attribute__((ext_vector_type(4)));

__device__ __forceinline__ float bf2f(unsigned short b) { return __builtin_bit_cast(float, (unsigned)b << 16); }
__device__ __forceinline__ float bflo(unsigned u) { return __builtin_bit_cast(float, u << 16); }
__device__ __forceinline__ float bfhi(unsigned u) { return __builtin_bit_cast(float, u & 0xffff0000u); }
__device__ __forceinline__ float relu_raw(float x) { const int i = __builtin_bit_cast(int, x); return __builtin_bit_cast(float, i > 0 ? i : 0); }
__device__ __forceinline__ unsigned cvtpk(float lo, float hi) { f32x2_t v = {lo, hi}; bf16x2_t b = __builtin_convertvector(v, bf16x2_t); return __builtin_bit_cast(unsigned, b); }
__device__ __forceinline__ float wave_sum(float v) {
#pragma unroll
    for (int o = 1; o < 64; o <<= 1) v += __shfl_xor(v, o);
    return v;
}
__device__ __forceinline__ float wave_max(float v) {
#pragma unroll
    for (int o = 1; o < 64; o <<= 1) v = fmaxf(v, __shfl_xor(v, o));
    return v;
}
__device__ __forceinline__ float wave_min(float v) {
#pragma unroll
    for (int o = 1; o < 64; o <<= 1) v = fminf(v, __shfl_xor(v, o));
    return v;
}
__device__ __forceinline__ float fexp2(float x) { return __builtin_amdgcn_exp2f(x); }
__device__ __forceinline__ float flog2(float x) { return __builtin_amdgcn_logf(x); }

namespace pg8 {
__device__ __forceinline__ void row_rstd(const float* ssp, int rowbase, int fr, int fq, float (&rs)[2][4]) {
    float mine[2];
#pragma unroll
    for (int t = 0; t < 2; ++t) { const int row = rowbase + (fq >> 1) * HALF + (2 * (fq & 1) + t) * 16 + fr;
        const f32x4* p = (const f32x4*)(ssp + (size_t)row * 32); float sm = 0.f;
#pragma unroll
        for (int q = 0; q < 8; ++q) { const f32x4 v = p[q]; sm += (v.x + v.y) + (v.z + v.w); }
        mine[t] = 1.f / sqrtf(sm * (1.f / 2048.f) + 1e-6f); }
#pragma unroll
    for (int ai = 0; ai < 2; ++ai)
#pragma unroll
        for (int m = 0; m < 4; ++m) { const int src = (ai * 2 + (m >> 1)) * 16 + fr; const float a = __shfl(mine[0], src), b = __shfl(mine[1], src); rs[ai][m] = (m & 1) ? b : a; }
}
template <int ACT  , bool SCALE>
struct EpiStore {
    static constexpr bool PERM = true, AFTER_DRAIN = false;
    bf16_t* O; int ldc; const float* ssp;
    __device__ __forceinline__ void operator()(const f32x4 (&acc)[2][2][4][2], const Unit& u, int wr, int wc, int fr, int fq) const {
        const int row0 = u.pm * BM + wr * 64 + fr, col0 = u.pn * BM + wc * 32 + 8 * fq;
        float rs[2][4];
        if (SCALE) row_rstd(ssp, u.pm * BM + wr * 64, fr, fq, rs);
#pragma unroll
        for (int ai = 0; ai < 2; ++ai)
#pragma unroll
            for (int m = 0; m < 4; ++m) { bf16_t* rowp = O + (size_t)(row0 + ai * HALF + m * 16) * ldc + col0; const float r = SCALE ? rs[ai][m] : 1.f;
#pragma unroll
                for (int bj = 0; bj < 2; ++bj) { f32x4 v0 = acc[ai][bj][m][0] * r, v1 = acc[ai][bj][m][1] * r;
                    if (ACT == 1) {
#pragma unroll
                        for (int e = 0; e < 4; ++e) { v0[e] = fmaxf(v0[e], 0.f); v0[e] *= v0[e]; v1[e] = fmaxf(v1[e], 0.f); v1[e] *= v1[e]; } }
                    u32x4 w; w.x = cvtpk(v0[0], v0[1]); w.y = cvtpk(v0[2], v0[3]); w.z = cvtpk(v1[0], v1[1]); w.w = cvtpk(v1[2], v1[3]);
                    *(u32x4*)(rowp + bj * HALF) = w; } }
    }
};
template <bool GATE  , bool FINAL  , bool SQ = false  >
struct EpiH {
    static constexpr bool PERM = true, AFTER_DRAIN = false;
    const bf16_t* hin; bf16_t* hout; float* sspo; const bf16_t* pp; const float* sspi; float* outf;
    __device__ __forceinline__ void operator()(const f32x4 (&acc)[2][2][4][2], const Unit& u, int wr, int wc, int fr, int fq) const {
        constexpr int ld = 2048;
        const int row0 = u.pm * BM + wr * 64 + fr, col0 = u.pn * BM + wc * 32 + 8 * fq;
        float rs[2][4];
        u32x4 rh[2][2], rp[2][2];
        { const size_t off = (size_t)row0 * ld + col0;
#pragma unroll
          for (int bj = 0; bj < 2; ++bj) { rh[0][bj] = *(const u32x4*)(hin + off + bj * HALF); if (GATE) rp[0][bj] = *(const u32x4*)(pp + off + bj * HALF); } }
        if (GATE || SQ) row_rstd(sspi, u.pm * BM + wr * 64, fr, fq, rs);
#pragma unroll
        for (int r = 0; r < 8; ++r) { const int ai = r >> 2, m = r & 3, cb = r & 1, nb = cb ^ 1;
            const int row = row0 + ai * HALF + m * 16; const size_t off = (size_t)row * ld + col0;
            if (r + 1 < 8) { const int ai2 = (r + 1) >> 2, m2 = (r + 1) & 3; const size_t off2 = (size_t)(row0 + ai2 * HALF + m2 * 16) * ld + col0;
#pragma unroll
                for (int bj = 0; bj < 2; ++bj) { rh[nb][bj] = *(const u32x4*)(hin + off2 + bj * HALF); if (GATE) rp[nb][bj] = *(const u32x4*)(pp + off2 + bj * HALF); } }
            float ss = 0.f;
#pragma unroll
            for (int bj = 0; bj < 2; ++bj) { const u32x4 hv = rh[cb][bj];
                f32x4 a = {bflo(hv.x), bfhi(hv.x), bflo(hv.y), bfhi(hv.y)}, b = {bflo(hv.z), bfhi(hv.z), bflo(hv.w), bfhi(hv.w)};
                const f32x4 v0 = acc[ai][bj][m][0], v1 = acc[ai][bj][m][1];
                if (GATE) { const u32x4 p = rp[cb][bj]; const float rr = rs[ai][m] * (-LOG2E);
                    const f32x4 p0 = {bflo(p.x), bfhi(p.x), bflo(p.y), bfhi(p.y)}, p1 = {bflo(p.z), bfhi(p.z), bflo(p.w), bfhi(p.w)};
#pragma unroll
                    for (int e = 0; e < 4; ++e) { a[e] += __builtin_amdgcn_rcpf(1.f + fexp2(rr * v0[e])) * p0[e]; b[e] += __builtin_amdgcn_rcpf(1.f + fexp2(rr * v1[e])) * p1[e]; }
                } else if (SQ) { const float r2 = rs[ai][m] * rs[ai][m]; a += v0 * r2; b += v1 * r2; }
                else { a += v0; b += v1; }
                if (FINAL) { *(f32x4*)(outf + off + bj * HALF) = a; *(f32x4*)(outf + off + bj * HALF + 4) = b; }
                else { u32x4 w; w.x = cvtpk(a[0], a[1]); w.y = cvtpk(a[2], a[3]); w.z = cvtpk(b[0], b[1]); w.w = cvtpk(b[2], b[3]);
                    *(u32x4*)(hout + off + bj * HALF) = w;
                    ss += (a[0] * a[0] + a[1] * a[1]) + (a[2] * a[2] + a[3] * a[3]) + (b[0] * b[0] + b[1] * b[1]) + (b[2] * b[2] + b[3] * b[3]); } }
            if (!FINAL) { ss += __shfl_xor(ss, 16); ss += __shfl_xor(ss, 32);
                if (fq == 0) sspo[(size_t)row * 32 + u.pn * 4 + wc] = ss; } }
    }
};
}

struct Args { const float* in[21]; float* out; unsigned char* ws; };
enum { I_X = 0, I_P, I_ATTN_NORM, I_WO, I_MLP_NORM, I_WUP, I_WDOWN, I_PLE_NORM, I_WGATE, I_WPLE, I_A_WIN, I_A_QN, I_A_KN, I_B_WIN, I_B_QN, I_B_KN, I_B_IKN, I_C_WIN, I_C_BF, I_C_QN, I_C_KN };

__device__ __forceinline__ void transpose_item(const float* W, const float* gain, int K, int N, bf16* WT, int kb, int nb, int lane) {
    const int k0 = 64 * kb, n = 64 * nb + lane; const bool ok = n < N;
    const float* src = W + (size_t)k0 * N + (ok ? n : 0);
    float v[64];
#pragma unroll
    for (int r = 0; r < 64; ++r) v[r] = src[(size_t)r * N];
    if (gain) {
#pragma unroll
        for (int r = 0; r < 64; ++r) v[r] *= gain[k0 + r];
    }
    bf16* dst = WT + (size_t)n * K + k0;
#pragma unroll
    for (int c = 0; c < 8; ++c) { v4u o;
        o.x = ok ? cvtpk(v[8 * c + 0], v[8 * c + 1]) : 0u; o.y = ok ? cvtpk(v[8 * c + 2], v[8 * c + 3]) : 0u; o.z = ok ? cvtpk(v[8 * c + 4], v[8 * c + 5]) : 0u; o.w = ok ? cvtpk(v[8 * c + 6], v[8 * c + 7]) : 0u;
        *(v4u*)(dst + 8 * c) = o; }
}
__device__ __forceinline__ void convert_weight(const float* W, const float* gain, int K, int N, int Npad, bf16* WT, LAS float* scr, int gw, int ngw, int lane) {
    const int nblk = Npad / 64, nitems = (K / 64) * nblk;
    for (int it = gw; it < nitems; it += ngw) transpose_item(W, gain, K, N, WT, it / nblk, it % nblk, lane);
}
__device__ __forceinline__ void x_rows(const float* src, bf16* hb, float* ssp, int gw, int ngw, int lane) {
    for (int m = gw; m < M; m += ngw) {
        const f32x4* xr = (const f32x4*)(src + (size_t)m * D) + lane;
        f32x4 v[8]; float ss = 0.f;
#pragma unroll
        for (int j = 0; j < 8; ++j) { v[j] = xr[64 * j]; ss += (v[j].x * v[j].x + v[j].y * v[j].y) + (v[j].z * v[j].z + v[j].w * v[j].w); }
        ss = wave_sum(ss);
        unsigned long long* o8 = (unsigned long long*)(hb + (size_t)m * D) + lane;
#pragma unroll
        for (int j = 0; j < 8; ++j) o8[64 * j] = (unsigned long long)cvtpk(v[j].x, v[j].y) | ((unsigned long long)cvtpk(v[j].z, v[j].w) << 32);
        if (lane < 32) ssp[(size_t)m * 32 + lane] = lane == 0 ? ss : 0.f;
    }
}

__device__ __forceinline__ void rmsnorm_rows(const float* src, const float* g, bf16* dst, int gw, int ngw, int lane) {
    for (int m = gw; m < M; m += ngw) {
        const f32x4* xr = (const f32x4*)(src + (size_t)m * D) + lane;
        f32x4 v[8]; float ss = 0.f;
#pragma unroll
        for (int j = 0; j < 8; ++j) { v[j] = xr[64 * j]; ss += (v[j].x * v[j].x + v[j].y * v[j].y) + (v[j].z * v[j].z + v[j].w * v[j].w); }
        const float rstd = 1.f / sqrtf(wave_sum(ss) * (1.f / D) + RMS_EPS);
        unsigned long long* o8 = (unsigned long long*)(dst + (size_t)m * D) + lane;
#pragma unroll
        for (int j = 0; j < 8; ++j) { const f32x4 gg = ((const f32x4*)g)[lane + 64 * j];
            o8[64 * j] = (unsigned long long)cvtpk(v[j].x * rstd * gg.x, v[j].y * rstd * gg.y) | ((unsigned long long)cvtpk(v[j].z * rstd * gg.z, v[j].w * rstd * gg.w) << 32); }
    }
}

template <bool ROPE>
__device__ __forceinline__ void head128_norm(bf16* p, const u32x4 raw, const float a  , const float* gain, float scale, const float2* rope, int lane, unsigned char* f8out = nullptr) {
    float x[8] = {bflo(raw.x), bfhi(raw.x), bflo(raw.y), bfhi(raw.y), bflo(raw.z), bfhi(raw.z), bflo(raw.w), bfhi(raw.w)};
    float ss = 0.f;
#pragma unroll
    for (int e = 0; e < 8; ++e) ss += x[e] * x[e];
    ss += __shfl_xor(ss, 1); ss += __shfl_xor(ss, 2); ss += __shfl_xor(ss, 4); ss += __shfl_xor(ss, 8);
    const float rstd = a / sqrtf(a * a * ss * (1.f / 128.f) + RMS_EPS);
    const int lh = lane & 15;
    const f32x4 g0 = *(const f32x4*)(gain + 8 * lh), g1 = *(const f32x4*)(gain + 8 * lh + 4);
    const float gg[8] = {g0.x, g0.y, g0.z, g0.w, g1.x, g1.y, g1.z, g1.w};
#pragma unroll
    for (int e = 0; e < 8; ++e) x[e] = x[e] * rstd * gg[e];
    if (ROPE) {
        float px[8];
#pragma unroll
        for (int e = 0; e < 8; ++e) px[e] = __shfl_xor(x[e], 2);
        if (lh < 4) {
#pragma unroll
            for (int e = 0; e < 8; ++e) { const float2 cs = rope[8 * (lh & 1) + e];
                x[e] = (lh < 2) ? (x[e] * cs.x - px[e] * cs.y) : (px[e] * cs.y + x[e] * cs.x); }
        }
    }
    if (f8out) {
        int w0 = 0, w1 = 0;
        w0 = __builtin_amdgcn_cvt_pk_fp8_f32(x[0] * scale, x[1] * scale, w0, false); w0 = __builtin_amdgcn_cvt_pk_fp8_f32(x[2] * scale, x[3] * scale, w0, true);
        w1 = __builtin_amdgcn_cvt_pk_fp8_f32(x[4] * scale, x[5] * scale, w1, false); w1 = __builtin_amdgcn_cvt_pk_fp8_f32(x[6] * scale, x[7] * scale, w1, true);
        *(u32x2*)f8out = (u32x2){(unsigned)w0, (unsigned)w1};
    } else {
        u32x4 w; w.x = cvtpk(x[0] * scale, x[1] * scale); w.y = cvtpk(x[2] * scale, x[3] * scale); w.z = cvtpk(x[4] * scale, x[5] * scale); w.w = cvtpk(x[6] * scale, x[7] * scale);
        *(u32x4*)p = w;
    }
}
template <bool NORM>
__device__ __forceinline__ void head64_rope(bf16* p, const u32x4 raw, const float a, const float* gain, const float2* rope, int lane, bool active) {
    float x[8] = {bflo(raw.x) * a, bfhi(raw.x) * a, bflo(raw.y) * a, bfhi(raw.y) * a, bflo(raw.z) * a, bfhi(raw.z) * a, bflo(raw.w) * a, bfhi(raw.w) * a};
    const int li = lane & 7;
    if (NORM) {
        float ss = 0.f;
#pragma unroll
        for (int e = 0; e < 8; ++e) ss += x[e] * x[e];
        ss += __shfl_xor(ss, 1); ss += __shfl_xor(ss, 2); ss += __shfl_xor(ss, 4);
        const float rstd = 1.f / sqrtf(ss * (1.f / 64.f) + RMS_EPS);
        const f32x4 g0 = *(const f32x4*)(gain + 8 * li), g1 = *(const f32x4*)(gain + 8 * li + 4);
        const float gg[8] = {g0.x, g0.y, g0.z, g0.w, g1.x, g1.y, g1.z, g1.w};
#pragma unroll
        for (int e = 0; e < 8; ++e) x[e] = x[e] * rstd * gg[e];
    }
    float px[8];
#pragma unroll
    for (int e = 0; e < 8; ++e) px[e] = __shfl_xor(x[e], 1);
    if (li < 2) {
#pragma unroll
        for (int e = 0; e < 8; ++e) { const float2 cs = rope[e];
            x[e] = (li == 0) ? (x[e] * cs.x - px[e] * cs.y) : (px[e] * cs.y + x[e] * cs.x); }
    }
    if (active) { u32x4 w; w.x = cvtpk(x[0], x[1]); w.y = cvtpk(x[2], x[3]); w.z = cvtpk(x[4], x[5]); w.w = cvtpk(x[6], x[7]); *(u32x4*)p = w; }
}

__device__ __forceinline__ void vt_item(const bf16* proj, int ldp, int voff, const float* rstdv, bf16* VT, LAS unsigned char* tile, int item, int lane) {
    const int h = item & 15, tc = (item >> 4) & 255, b = item >> 12;
    const size_t row0 = (size_t)b * SEQ + 32 * tc;
#pragma unroll
    for (int i = 0; i < 8; ++i) { const int tok = 4 * i + (lane >> 4), ch = lane & 15;
        const u32x4 v = *(const u32x4*)(proj + (row0 + tok) * ldp + voff + h * 128 + ch * 8); const float a = rstdv[row0 + tok];
        LAS u32x2* d = (LAS u32x2*)(tile + tok * 264 + ch * 16);
        d[0] = (u32x2){cvtpk(bflo(v.x) * a, bfhi(v.x) * a), cvtpk(bflo(v.y) * a, bfhi(v.y) * a)}; d[1] = (u32x2){cvtpk(bflo(v.z) * a, bfhi(v.z) * a), cvtpk(bflo(v.w) * a, bfhi(v.w) * a)}; }
    LDS_WAIT(); asm volatile("" ::: "memory");
#pragma unroll
    for (int i = 0; i < 8; ++i) { const int d = 16 * i + (lane >> 2), tg = lane & 3;
        const LAS unsigned short* s = (const LAS unsigned short*)(tile + (8 * tg) * 264 + d * 2);
        u32x4 w; w.x = (unsigned)s[0] | ((unsigned)s[132] << 16); w.y = (unsigned)s[2 * 132] | ((unsigned)s[3 * 132] << 16);
        w.z = (unsigned)s[4 * 132] | ((unsigned)s[5 * 132] << 16); w.w = (unsigned)s[6 * 132] | ((unsigned)s[7 * 132] << 16);
        *(u32x4*)(VT + ((size_t)(b * 16 + h) * 128 + d) * SEQ + 32 * tc + 8 * tg) = w; }
    LDS_WAIT(); asm volatile("" ::: "memory");
}

__device__ __forceinline__ void cumchunk_item(const bf16* proj, int ldp, const float* rstdv, const float* bfv, float* cum2, float* tot, int item, int lane) {
    const int b = item >> 7, ch = item & 127; const int t = 64 * ch + lane;
    const bf16* gp = proj + ((size_t)b * SEQ + t) * ldp + 3 * D;
    const u32x4 g0 = *(const u32x4*)gp, g1 = *(const u32x4*)(gp + 8);
    const float x[16] = {bflo(g0.x), bfhi(g0.x), bflo(g0.y), bfhi(g0.y), bflo(g0.z), bfhi(g0.z), bflo(g0.w), bfhi(g0.w), bflo(g1.x), bfhi(g1.x), bflo(g1.y), bfhi(g1.y), bflo(g1.z), bfhi(g1.z), bflo(g1.w), bfhi(g1.w)};
    const float a = rstdv[(size_t)b * SEQ + t];
#pragma unroll
    for (int h = 0; h < 16; ++h) { const float y = x[h] * a + bfv[h];
        float lf = -(fmaxf(-y, 0.f) + log1pf(expf(-fabsf(y)))) * LOG2E;
#pragma unroll
        for (int o = 1; o < 64; o <<= 1) { const float u = __shfl_up(lf, o); if (lane >= o) lf += u; }
        cum2[((size_t)(b * 16 + h)) * SEQ + t] = lf;
        if (lane == 63) tot[(b * 16 + h) * 128 + ch] = lf; }
}

#define MFMA32(a, b, c) __builtin_amdgcn_mfma_f32_32x32x16_bf16((a), (b), (c), 0, 0, 0)
#define MFMA16(a, b, c) __builtin_amdgcn_mfma_f32_16x16x32_bf16((a), (b), (c), 0, 0, 0)
template <int MODE>
__device__ __forceinline__ void attn_dense_item(const bf16* proj, int ldp, const bf16* VT, const float* cum2, bf16* mix, float zb2, int qt, int bh, int lane) {
    const int b = bh >> 4, h = bh & 15;
    const int n = lane & 31, hi = lane >> 5, q0 = 32 * qt;
    const size_t row0 = (size_t)b * SEQ;
    const int prow = (n & 0x13) | ((n & 4) << 1) | ((n & 8) >> 1);
    bf16x8 qf[8];
    { const bf16* qp = proj + (row0 + q0 + n) * ldp + h * 128 + hi * 8;
#pragma unroll
      for (int kk = 0; kk < 8; ++kk) qf[kk] = *(const bf16x8*)(qp + kk * 16); }
    f32x16 o[4];
#pragma unroll
    for (int d = 0; d < 4; ++d)
#pragma unroll
        for (int i = 0; i < 16; ++i) o[d][i] = 0.f;
    float R = 0.f, mrun = -1e30f, lrun = 0.f, cq = 0.f;
    const float* cb = cum2 + (size_t)bh * SEQ;
    if (MODE == 1) cq = cb[q0 + n];
    const int tq = q0 + n;
    const bf16* kbase = proj + (row0 + prow) * ldp + D + h * 128 + hi * 8;
    bf16x8 kf[8];
#pragma unroll
    for (int kk = 0; kk < 8; ++kk) kf[kk] = *(const bf16x8*)(kbase + (size_t)q0 * ldp + kk * 16);
    for (int kb = q0; kb >= 0; kb -= 32) {
        if (MODE == 0) { if (__all(R + zb2 < ZERO_LOG2)) break; }
        else { const float dmax = cb[q0] - cb[kb + 31]; if (dmax + 2.f * zb2 < ZERO_LOG2) break; }
        bf16x8 vf[4][2];
#pragma unroll
        for (int d = 0; d < 4; ++d)
#pragma unroll
            for (int s = 0; s < 2; ++s) vf[d][s] = *(const bf16x8*)(VT + ((size_t)bh * 128 + d * 32 + n) * SEQ + kb + 16 * s + 8 * hi);
        f32x16 sc;
#pragma unroll
        for (int i = 0; i < 16; ++i) sc[i] = 0.f;
#pragma unroll
        for (int kk = 0; kk < 8; ++kk) sc = MFMA32(kf[kk], qf[kk], sc);
        if (kb >= 32) {
#pragma unroll
            for (int kk = 0; kk < 8; ++kk) kf[kk] = *(const bf16x8*)(kbase + (size_t)(kb - 32) * ldp + kk * 16);
        }
        const bool diag = (kb == q0);
        float w[16];
        if (MODE == 0) {
            float L[16];
#pragma unroll
            for (int i = 0; i < 16; ++i) { const int key = kb + 16 * (i >> 3) + 8 * hi + (i & 7);
                const bool valid = !diag || (key < tq);
                L[i] = valid ? -flog2(1.f + fexp2(sc[i])) : 0.f; }
            float G0 = 0.f, G1 = 0.f;
#pragma unroll
            for (int j = 0; j < 8; ++j) { G0 += L[j]; G1 += L[8 + j]; }
            const float Gp0 = __shfl_xor(G0, 32), Gp1 = __shfl_xor(G1, 32);
            const float pre1 = hi ? R : (R + Gp1);
            const float pre0 = hi ? (R + G1 + Gp1) : (R + Gp1 + G1 + Gp0);
            float c = pre1;
#pragma unroll
            for (int j = 7; j >= 0; --j) { c += L[8 + j]; const int key = kb + 16 + 8 * hi + j; w[8 + j] = (!diag || key < tq) ? fexp2(sc[8 + j] + c) : 0.f; }
            c = pre0;
#pragma unroll
            for (int j = 7; j >= 0; --j) { c += L[j]; const int key = kb + 8 * hi + j; w[j] = (!diag || key < tq) ? fexp2(sc[j] + c) : 0.f; }
            R += (G0 + G1) + (Gp0 + Gp1);
        } else {
            float lg[16]; float bm = -3e38f;
#pragma unroll
            for (int s = 0; s < 2; ++s) { const f32x4 c0 = *(const f32x4*)(cb + kb + 16 * s + 8 * hi), c1 = *(const f32x4*)(cb + kb + 16 * s + 8 * hi + 4);
                const float ck[8] = {c0.x, c0.y, c0.z, c0.w, c1.x, c1.y, c1.z, c1.w};
#pragma unroll
                for (int j = 0; j < 8; ++j) { const int i = 8 * s + j, key = kb + 16 * s + 8 * hi + j;
                    const float v = sc[i] + (cq - ck[j]);
                    lg[i] = (!diag || key <= tq) ? v : -3e38f; bm = fmaxf(bm, lg[i]); } }
            bm = fmaxf(bm, __shfl_xor(bm, 32));
            const float mn = fmaxf(mrun, bm), alpha = fexp2(mrun - mn);
            mrun = mn;
            float ps = 0.f;
#pragma unroll
            for (int i = 0; i < 16; ++i) { w[i] = fexp2(lg[i] - mn); ps += w[i]; }
            lrun = lrun * alpha + ps;
#pragma unroll
            for (int d = 0; d < 4; ++d)
#pragma unroll
                for (int i = 0; i < 16; ++i) o[d][i] *= alpha;
        }
        bf16x8 pf[2];
#pragma unroll
        for (int s = 0; s < 2; ++s) { u32x4 t; t.x = cvtpk(w[8 * s + 0], w[8 * s + 1]); t.y = cvtpk(w[8 * s + 2], w[8 * s + 3]); t.z = cvtpk(w[8 * s + 4], w[8 * s + 5]); t.w = cvtpk(w[8 * s + 6], w[8 * s + 7]);
            pf[s] = __builtin_bit_cast(bf16x8, t); }
#pragma unroll
        for (int d = 0; d < 4; ++d)
#pragma unroll
            for (int s = 0; s < 2; ++s) o[d] = MFMA32(vf[d][s], pf[s], o[d]);
    }
    float inv = 1.f;
    if (MODE == 1) { const float lt = lrun + __shfl_xor(lrun, 32); inv = 1.f / lt; }
    bf16* op = mix + (row0 + q0 + n) * (size_t)D + h * 128 + 4 * hi;
#pragma unroll
    for (int d = 0; d < 4; ++d)
#pragma unroll
        for (int g = 0; g < 4; ++g) { u32x2 t; t.x = cvtpk(o[d][4 * g] * inv, o[d][4 * g + 1] * inv); t.y = cvtpk(o[d][4 * g + 2] * inv, o[d][4 * g + 3] * inv);
            *(u32x2*)(op + d * 32 + 8 * g) = t; }
}

constexpr int DL_SEL = 0, DL_MISC = 16384, DL_HIST = 17408, DL_CAND = DL_HIST + 8 * 8192, DL_P = DL_CAND + 8 * 512, DL_INVL = DL_P + 8 * 4096, DL_MM = DL_INVL + 8 * 16, DL_END = DL_MM + 8 * 128;
static_assert(DL_END <= RING_BYTES, "DSA LDS map");
constexpr int NBIN = 2048;

__device__ __forceinline__ int tk_bin(float x, float lo, float inv) { int bb = (int)((x - lo) * inv); return bb > NBIN - 1 ? NBIN - 1 : (bb < 0 ? 0 : bb); }
__device__ __forceinline__ void topk_row(const float* S, int c, float lo, float hi  , LAS unsigned short* sel, LAS unsigned* hist, LAS float* cval, LAS int* cidx, int lane) {
    const f32x4* S4 = (const f32x4*)S; const int c4 = c >> 2;
    int kk = 256, mc = c;
    bool usebin = false; float blo = 0.f, binv = 0.f; int bsel = 0;
    for (int level = 0; level < 48; ++level) {
        if (lo == hi || mc <= 64) break;
#pragma unroll
        for (int j = 0; j < NBIN / 64; ++j) hist[lane + 64 * j] = 0u;
        const float inv = (float)NBIN / (hi - lo);
        for (int i0 = 0; i0 < c4; i0 += 512) { f32x4 vb[8];
#pragma unroll
            for (int u = 0; u < 8; ++u) { const int i = i0 + 64 * u + lane; vb[u] = S4[i < c4 ? i : lane]; }
#pragma unroll
            for (int u = 0; u < 8; ++u) { const bool inr = (i0 + 64 * u + lane) < c4;
#pragma unroll
                for (int e = 0; e < 4; ++e) { const float x = vb[u][e]; if (inr && x >= lo && x <= hi) __hip_atomic_fetch_add(&hist[tk_bin(x, lo, inv)], 1u, __ATOMIC_RELAXED, __HIP_MEMORY_SCOPE_WORKGROUP); } } }
        LDS_WAIT(); asm volatile("" ::: "memory");
        unsigned own = 0u;
#pragma unroll
        for (int j = 0; j < 32; ++j) own += hist[32 * lane + j];
        unsigned suf = own;
#pragma unroll
        for (int o = 1; o < 64; o <<= 1) { const unsigned u = __shfl_down(suf, o); if (lane + o < 64) suf += u; }
        const unsigned long long pm = __ballot(suf >= (unsigned)kk);
        const int Ln = 63 - __builtin_clzll(pm);
        const unsigned above = __shfl(suf - own, Ln);
        const int k2 = kk - (int)above;
        int bs = 0, kn = 1, mn = 1;
        { unsigned acc = 0u; bool found = false;
          for (int j = 31; j >= 0; --j) { const unsigned hc = hist[32 * Ln + j]; if (!found && acc + hc >= (unsigned)k2) { bs = 32 * Ln + j; kn = k2 - (int)acc; mn = (int)hc; found = true; } if (!found) acc += hc; } }
        kk = kn; mc = mn;
        if (mc <= 64) { usebin = true; blo = lo; binv = inv; bsel = bs; break; }
        float nlo = 3e38f, nhi = -3e38f;
        for (int i0 = 0; i0 < c4; i0 += 256) { f32x4 vb[4];
#pragma unroll
            for (int u = 0; u < 4; ++u) { const int i = i0 + 64 * u + lane; vb[u] = S4[i < c4 ? i : lane]; }
#pragma unroll
            for (int u = 0; u < 4; ++u) { const bool inr = (i0 + 64 * u + lane) < c4;
#pragma unroll
                for (int e = 0; e < 4; ++e) { const float x = vb[u][e]; if (inr && x >= lo && x <= hi && tk_bin(x, lo, inv) == bs) { nlo = fminf(nlo, x); nhi = fmaxf(nhi, x); } } } }
        lo = wave_min(nlo); hi = wave_max(nhi);
    }
    const bool tie = !usebin && (lo == hi);
    const int base = 256 - kk;
    int nout = 0, ncand = 0;
    const unsigned long long ltmask = (1ull << lane) - 1ull;
    for (int j0 = 0; j0 < c4; j0 += 512) { f32x4 vb[8];
#pragma unroll
      for (int u = 0; u < 8; ++u) { const int i = j0 + 64 * u + lane; vb[u] = S4[i < c4 ? i : lane]; }
#pragma unroll
      for (int u = 0; u < 8; ++u) { const int i4 = j0 + 64 * u; if (i4 >= c4) break;
        bool gt[4], cd[4]; int glow = 0, clow = 0, gtot = 0, ctot = 0;
#pragma unroll
        for (int e = 0; e < 4; ++e) { const float x = vb[u][e]; const bool inr = (x >= lo) && (x <= hi);
            if (usebin) { const int bb = tk_bin(x, blo, binv); gt[e] = (x > hi) || (inr && bb > bsel); cd[e] = inr && bb == bsel; }
            else { gt[e] = x > hi; cd[e] = inr; }
            const unsigned long long gm = __ballot(gt[e]), cm = __ballot(cd[e]);
            glow += __builtin_popcountll(gm & ltmask); gtot += __builtin_popcountll(gm); clow += __builtin_popcountll(cm & ltmask); ctot += __builtin_popcountll(cm); }
        int gpos = nout + glow, cpos = ncand + clow;
#pragma unroll
        for (int e = 0; e < 4; ++e) { const int idx = 4 * (i4 + lane) + e;
            if (gt[e]) { if (gpos < 256) sel[gpos] = (unsigned short)idx; ++gpos; }
            if (cd[e]) { if (tie) { if (cpos < kk) sel[base + cpos] = (unsigned short)idx; } else if (cpos < 64) { cval[cpos] = vb[u][e]; cidx[cpos] = idx; } ++cpos; } }
        nout += gtot; ncand += ctot;
      } }
    if (!tie) {
        LDS_WAIT(); asm volatile("" ::: "memory");
        const int nc = ncand < 64 ? ncand : 64;
        const float mv = lane < nc ? cval[lane] : 0.f; const int mi = lane < nc ? cidx[lane] : 0;
        int rank = 0;
        for (int i = 0; i < nc; ++i) { const float v = cval[i]; rank += (v > mv || (v == mv && i < lane)) ? 1 : 0; }
        if (lane < nc && rank < kk) sel[base + rank] = (unsigned short)mi;
    }
    LDS_WAIT(); asm volatile("" ::: "memory");
}

__device__ __forceinline__ void dsa_unit(const bf16* proj, const unsigned char* q8, const unsigned char* k8, const unsigned char* v8, bf16* mix, float* scr, LAS unsigned char* lds, int unit, int tid) {
    constexpr int ldp = NB_PAD;
    const int lane = tid & 63, wave = __builtin_amdgcn_readfirstlane(tid >> 6);
    const int tile = 255 - (unit >> 2), b = unit & 3, t0 = 32 * tile, c = ((t0 >> 6) + 1) << 6;
    const size_t row0 = (size_t)b * SEQ;
    LAS unsigned short* sel = (LAS unsigned short*)(lds + DL_SEL);
#ifdef PROBE_DSA
    unsigned long long td0_ = __builtin_amdgcn_s_memrealtime();
#define DSA_PT(st) do { const unsigned long long n_ = __builtin_amdgcn_s_memrealtime(); if (tid == 0 && (st) == PROBE_DSA) { volatile LAS unsigned long long* pe_ = (volatile LAS unsigned long long*)(lds + MISC_OFF + 64); pe_[0] = pe_[0] + (n_ - td0_); } td0_ = n_; } while (0)
#else
#define DSA_PT(st) do { } while (0)
#endif
#ifndef DSA_NO_A
    if (c > 256) {
        int lane_a = lane; asm volatile("" : "+v"(lane_a));
        const int qg = wave & 1, kpart = wave >> 1, ql = lane_a & 15, kq = lane_a >> 4;
        const bf16* qrow = proj + (row0 + t0 + 16 * qg + ql) * ldp;
#pragma unroll 1
        for (int hp = 0; hp < 2; ++hp) {
            bf16x8 qif[8][2];
#pragma unroll
            for (int hh = 0; hh < 8; ++hh)
#pragma unroll
                for (int kk = 0; kk < 2; ++kk) qif[hh][kk] = *(const bf16x8*)(qrow + B_QI + (8 * hp + hh) * 64 + kk * 32 + kq * 8);
            float wv[8];
            { const u32x4 w0 = *(const u32x4*)(qrow + B_WI + 8 * hp);
              wv[0] = bflo(w0.x); wv[1] = bfhi(w0.x); wv[2] = bflo(w0.y); wv[3] = bfhi(w0.y); wv[4] = bflo(w0.z); wv[5] = bfhi(w0.z); wv[6] = bflo(w0.w); wv[7] = bfhi(w0.w); }
            bf16x8 kring[3][2][2]; f32x4 sring[3][2];
            const bf16* kibase = proj + (row0 + ql) * ldp + B_KI + kq * 8;
            float* sbase = scr + (size_t)(16 * qg + ql) * c + 4 * kq;
#define IDX_LOAD(SL, KB0) do { _Pragma("unroll") for (int u = 0; u < 2; ++u) { const int kb = (KB0) + 64 * u; const int kbc = kb < c ? kb : 16 * kpart; \
                    const bf16* kr = kibase + (size_t)kbc * ldp; \
                    kring[SL][u][0] = *(const bf16x8*)kr; kring[SL][u][1] = *(const bf16x8*)(kr + 32); \
                    sring[SL][u] = (f32x4){0.f, 0.f, 0.f, 0.f}; \
                    if (hp) sring[SL][u] = *(const f32x4*)(sbase + kbc); } } while (0)
#define IDX_COMP(SL, KB0) do { _Pragma("unroll") for (int u = 0; u < 2; ++u) { const int kb = (KB0) + 64 * u; \
                    if (kb < c) { f32x2_t s01 = {sring[SL][u][0], sring[SL][u][1]}, s23 = {sring[SL][u][2], sring[SL][u][3]}; \
                        _Pragma("unroll") for (int hh = 0; hh < 8; ++hh) { f32x4 d = {0.f, 0.f, 0.f, 0.f}; d = MFMA16(kring[SL][u][0], qif[hh][0], d); d = MFMA16(kring[SL][u][1], qif[hh][1], d); \
                            const f32x2_t w2 = {wv[hh], wv[hh]}; \
                            s01 = __builtin_elementwise_fma((f32x2_t){relu_raw(d[0]), relu_raw(d[1])}, w2, s01); s23 = __builtin_elementwise_fma((f32x2_t){relu_raw(d[2]), relu_raw(d[3])}, w2, s23); } \
                        const f32x4 sacc = {s01.x, s01.y, s23.x, s23.y}; \
                        *(f32x4*)(sbase + kb) = sacc; \
                        smin = fminf(smin, fminf(fminf(sacc[0], sacc[1]), fminf(sacc[2], sacc[3]))); smax = fmaxf(smax, fmaxf(fmaxf(sacc[0], sacc[1]), fmaxf(sacc[2], sacc[3]))); } } } while (0)
            float smin = 3e38f, smax = -3e38f;
            const int kbs = 16 * kpart;
            IDX_LOAD(0, kbs); IDX_LOAD(1, kbs + 128);
#pragma unroll 1
            for (int kb0 = kbs; kb0 < c; kb0 += 384) {
                IDX_LOAD(2, kb0 + 256); IDX_COMP(0, kb0);
                IDX_LOAD(0, kb0 + 384); IDX_COMP(1, kb0 + 128);
                IDX_LOAD(1, kb0 + 512); IDX_COMP(2, kb0 + 256);
            }
#undef IDX_COMP
#undef IDX_LOAD
            if (hp) {
                smin = fminf(smin, __shfl_xor(smin, 16)); smin = fminf(smin, __shfl_xor(smin, 32)); smax = fmaxf(smax, __shfl_xor(smax, 16)); smax = fmaxf(smax, __shfl_xor(smax, 32));
                if (lane < 16) { LAS float* mm = (LAS float*)(lds + DL_MM) + (wave * 16 + lane) * 2; mm[0] = smin; mm[1] = smax; }
            }
        }
    }
#endif
    __syncthreads(); DSA_PT(0);
    __builtin_amdgcn_fence(__ATOMIC_ACQUIRE, "agent");
    asm volatile("s_waitcnt vmcnt(0)" ::: "memory");
#ifndef DSA_NO_B
    LAS int* nselp = (LAS int*)(lds + DL_MISC);
    for (int qi = 0; qi < 4; ++qi) { const int ql = 4 * wave + qi;
        LAS unsigned short* s = sel + ql * 256;
        if (c > 256) { const LAS float* mm = (const LAS float*)(lds + DL_MM);
            float lo = 3e38f, hi = -3e38f;
#pragma unroll
            for (int kp = 0; kp < 4; ++kp) { const int w2 = (ql >> 4) + 2 * kp; lo = fminf(lo, mm[(w2 * 16 + (ql & 15)) * 2]); hi = fmaxf(hi, mm[(w2 * 16 + (ql & 15)) * 2 + 1]); }
            topk_row(scr + (size_t)ql * c, c, lo, hi, s, (LAS unsigned*)(lds + DL_HIST + wave * 8192), (LAS float*)(lds + DL_CAND + wave * 512), (LAS int*)(lds + DL_CAND + wave * 512 + 256), lane); }
        else { for (int i = lane; i < c; i += 64) s[i] = (unsigned short)i; }
    }
#endif
    const int nsel = c > 256 ? 256 : c;
    LDS_WAIT(); asm volatile("" ::: "memory"); DSA_PT(1);
#ifndef DSA_NO_C
    LAS unsigned short* Pb = (LAS unsigned short*)(lds + DL_P + wave * 4096);
    LAS unsigned char* vt = lds + DL_HIST + wave * 8192;
    LAS float* invl = (LAS float*)(lds + DL_INVL + wave * 16);
    for (int pi = 0; pi < 16; ++pi) { const int pr = 16 * wave + pi, ql = pr >> 2, g = pr & 3;
        const LAS unsigned short* s = sel + ql * 256;
        const size_t qrow = row0 + t0 + ql;
        int lane_c = lane; asm volatile("" : "+v"(lane_c));
        const int r = lane_c & 15, kq = lane_c >> 4;
        long qf[4];
#pragma unroll
        for (int kk = 0; kk < 4; ++kk) { qf[kk] = 0; if (r < 4) qf[kk] = *(const long*)(q8 + qrow * 2048 + (g * 4 + r) * 128 + kq * 32 + kk * 8); }
        f32x4 lg[16]; float mx = -3e38f;
#pragma unroll
        for (int g8 = 0; g8 < 2; ++g8) {
            if (g8 * 128 < nsel) {
                long kfr[8][4];
#pragma unroll
                for (int u = 0; u < 8; ++u) { const int key = ((g8 * 128 + u * 16) < nsel) ? s[g8 * 128 + u * 16 + r] : 0;
                    const unsigned char* kr = k8 + (row0 + key) * 512 + g * 128 + kq * 32;
                    const u32x4 ka = *(const u32x4*)kr, kb2 = *(const u32x4*)(kr + 16);
                    kfr[u][0] = (long)(((unsigned long long)ka.y << 32) | ka.x); kfr[u][1] = (long)(((unsigned long long)ka.w << 32) | ka.z);
                    kfr[u][2] = (long)(((unsigned long long)kb2.y << 32) | kb2.x); kfr[u][3] = (long)(((unsigned long long)kb2.w << 32) | kb2.z); }
#pragma unroll
                for (int u = 0; u < 8; ++u) { f32x4 d = {0.f, 0.f, 0.f, 0.f};
#pragma unroll
                    for (int kk = 0; kk < 4; ++kk) d = __builtin_amdgcn_mfma_f32_16x16x32_fp8_fp8(kfr[u][kk], qf[kk], d, 0, 0, 0);
                    const bool live = (g8 * 128 + u * 16) < nsel;
                    if (!live) d = (f32x4){-3e38f, -3e38f, -3e38f, -3e38f};
                    lg[g8 * 8 + u] = d; mx = fmaxf(mx, fmaxf(fmaxf(d[0], d[1]), fmaxf(d[2], d[3]))); }
            } else {
#pragma unroll
                for (int u = 0; u < 8; ++u) lg[g8 * 8 + u] = (f32x4){-3e38f, -3e38f, -3e38f, -3e38f};
            }
        }
        mx = fmaxf(mx, __shfl_xor(mx, 16)); mx = fmaxf(mx, __shfl_xor(mx, 32));
        float ls = 0.f;
#pragma unroll
        for (int blk = 0; blk < 16; ++blk) {
            if (blk * 16 < nsel) {
#pragma unroll
                for (int e = 0; e < 4; ++e) { const float p = fexp2((lg[blk][e] - mx) * 0.125f); ls += p; if (r < 4) Pb[r * 256 + blk * 16 + 4 * kq + e] = (unsigned short)(cvtpk(p, p) & 0xffffu); } }
        }
        ls += __shfl_xor(ls, 16); ls += __shfl_xor(ls, 32);
        if (lane < 4) invl[lane] = 1.f / ls;
        LDS_WAIT(); asm volatile("" ::: "memory");
        const int ks = lane_c >> 4, dc = lane_c & 15;
        f32x4 oacc[8];
#pragma unroll
        for (int cb = 0; cb < 8; ++cb) oacc[cb] = (f32x4){0.f, 0.f, 0.f, 0.f};
        const unsigned tq_ = (unsigned)(lane_c & 15) >> 2, tp_ = (unsigned)lane_c & 3u;
        for (int i0 = 0; i0 < nsel / 4; i0 += 16) {
            u32x2 v[16];
#pragma unroll
            for (int u = 0; u < 16; ++u) { const int key = s[4 * (i0 + u) + ks];
                v[u] = *(const u32x2*)(v8 + (row0 + key) * 512 + g * 128 + dc * 8); }
#pragma unroll
            for (int half = 0; half < 2; ++half) {
#pragma unroll
                for (int uu = 0; uu < 8; ++uu) { const int u = 8 * half + uu; const unsigned row = 4u * uu + (unsigned)ks;
                    const f32x2_t a0 = __builtin_amdgcn_cvt_pk_f32_fp8((int)v[u].x, false), a1 = __builtin_amdgcn_cvt_pk_f32_fp8((int)v[u].x, true), a2 = __builtin_amdgcn_cvt_pk_f32_fp8((int)v[u].y, false), a3 = __builtin_amdgcn_cvt_pk_f32_fp8((int)v[u].y, true);
                    u32x4 w; w.x = cvtpk(a0.x, a0.y); w.y = cvtpk(a1.x, a1.y); w.z = cvtpk(a2.x, a2.y); w.w = cvtpk(a3.x, a3.y);
                    *(LAS u32x4*)(vt + 256u * row + 16u * ((unsigned)dc ^ (((row & 3u) << 2) | ((row >> 2) & 3u)))) = w; }
                asm volatile("" ::: "memory");
                bf16x8 af = (bf16x8){0, 0, 0, 0, 0, 0, 0, 0};
                if (r < 4) af = *(const LAS bf16x8*)(Pb + r * 256 + 4 * i0 + 32 * half + 8 * kq);
#pragma unroll
                for (int cb = 0; cb < 8; ++cb) {
                    s16x4_t bq[2];
#pragma unroll
                    for (int t = 0; t < 2; ++t) { const unsigned trow = 8u * (unsigned)ks + 4u * t + tq_, tch = 2u * cb + (tp_ >> 1);
                        const unsigned ta = 256u * trow + 16u * (tch ^ (((trow & 3u) << 2) | ((trow >> 2) & 3u))) + 8u * (tp_ & 1u);
                        bq[t] = __builtin_amdgcn_ds_read_tr16_b64_v4i16((LAS s16x4_t*)(vt + ta)); }
                    const bf16x8 bfrag = {bq[0][0], bq[0][1], bq[0][2], bq[0][3], bq[1][0], bq[1][1], bq[1][2], bq[1][3]};
                    oacc[cb] = MFMA16(af, bfrag, oacc[cb]); }
                asm volatile("" ::: "memory");
            }
        }
        if (ks == 0) {
#pragma unroll
            for (int hd = 0; hd < 4; ++hd) { const float il = invl[hd];
#pragma unroll
                for (int cb = 0; cb < 8; ++cb) mix[qrow * D + (g * 4 + hd) * 128 + 16 * cb + dc] = (unsigned short)(cvtpk(oacc[cb][hd] * il, 0.f) & 0xffffu); }
        }
        LDS_WAIT(); asm volatile("" ::: "memory");
    }
#endif
    __syncthreads(); DSA_PT(2);
}


constexpr int A2_SLOT = 40960, A2_NSLOT = 3, A2_CTRL = A2_SLOT * A2_NSLOT;
static_assert(A2_CTRL + 256 <= RING_BYTES, "attention LDS map");
#define A2_WAIT_V(n) asm volatile("s_waitcnt vmcnt(" #n ")" ::: "memory")
template <int MODE>
__device__ __forceinline__ void attn2_stage(LAS unsigned char* slot, const bf16* kbase  ,
                                            const bf16* vbase  , const float* cbase  , int ldp, int kb, int wave) {
#pragma unroll
    for (int i = 0; i < 2; ++i) { const int f = wave + 8 * i, sb = f >> 3, kk = f & 7;
        __builtin_amdgcn_global_load_lds((const unsigned*)(kbase + (size_t)(kb + 32 * sb) * ldp + kk * 16), (LAS unsigned*)(slot + f * 1024), 16, 0, 0); }
#pragma unroll
    for (int i = 0; i < 2; ++i) { const int f = wave + 8 * i, sb = f >> 3, d = (f >> 1) & 3, s = f & 1;
        __builtin_amdgcn_global_load_lds((const unsigned*)(vbase + (size_t)(d * 32) * SEQ + kb + 32 * sb + 16 * s), (LAS unsigned*)(slot + 16384 + f * 1024), 16, 0, 0); }
    if (MODE == 1) __builtin_amdgcn_global_load_lds((const unsigned*)(cbase + kb), (LAS unsigned*)(slot + 32768 + wave * 1024), 16, 0, 0);
}
template <int MODE>
__device__ __forceinline__ void attn2_unit(const bf16* proj, int ldp, const bf16* VT, const float* cum2, const float* tot, const float* gq, const float* rstdv, bf16* mix, float zb2, int grp, int bh, LAS unsigned char* lds, int tid) {
    const int lane = tid & 63, wave = __builtin_amdgcn_readfirstlane(tid >> 6);
    const int b = bh >> 4, h = bh & 15, n = lane & 31, hi = lane >> 5;
    const int q_base = 256 * grp, q0 = q_base + 32 * wave, tq = q0 + n;
    const size_t row0 = (size_t)b * SEQ;
    const int prow = (n & 0x13) | ((n & 4) << 1) | ((n & 8) >> 1);
    const bf16* kbase = proj + (row0 + prow) * ldp + D + h * 128 + hi * 8;
    const bf16* vbase = VT + ((size_t)bh * 128 + n) * SEQ + 8 * hi;
    const float* cb = cum2 + (size_t)bh * SEQ;
    const float* cbase = cb + 4 * (lane & 15);
    volatile LAS unsigned* flags = (volatile LAS unsigned*)(lds + A2_CTRL + 64);
    bf16x8 qf[8];
    {
      const bf16* qp = proj + (row0 + q0 + n) * ldp + h * 128 + hi * 8;
      u32x4 raw[8];
#pragma unroll
      for (int kk = 0; kk < 8; ++kk) raw[kk] = *(const u32x4*)(qp + kk * 16);
      float ss = 0.f;
#pragma unroll
      for (int kk = 0; kk < 8; ++kk) { const float x0 = bflo(raw[kk].x), x1 = bfhi(raw[kk].x), x2 = bflo(raw[kk].y), x3 = bfhi(raw[kk].y), x4 = bflo(raw[kk].z), x5 = bfhi(raw[kk].z), x6 = bflo(raw[kk].w), x7 = bfhi(raw[kk].w);
          ss += x0 * x0 + x1 * x1 + x2 * x2 + x3 * x3 + x4 * x4 + x5 * x5 + x6 * x6 + x7 * x7; }
      ss += __shfl_xor(ss, 32);
      const float ar = rstdv[row0 + q0 + n];
      const float rstd = ar / sqrtf(ar * ar * ss * (1.f / 128.f) + RMS_EPS);
#pragma unroll
      for (int kk = 0; kk < 8; ++kk) { const f32x4 g0 = *(const f32x4*)(gq + kk * 16 + hi * 8), g1 = *(const f32x4*)(gq + kk * 16 + hi * 8 + 4);
          u32x4 w; w.x = cvtpk(bflo(raw[kk].x) * rstd * g0.x * QSCALE, bfhi(raw[kk].x) * rstd * g0.y * QSCALE); w.y = cvtpk(bflo(raw[kk].y) * rstd * g0.z * QSCALE, bfhi(raw[kk].y) * rstd * g0.w * QSCALE);
          w.z = cvtpk(bflo(raw[kk].z) * rstd * g1.x * QSCALE, bfhi(raw[kk].z) * rstd * g1.y * QSCALE); w.w = cvtpk(bflo(raw[kk].w) * rstd * g1.z * QSCALE, bfhi(raw[kk].w) * rstd * g1.w * QSCALE);
          qf[kk] = __builtin_bit_cast(bf16x8, w); } }
    float cq = 0.f, c_low = 0.f, Pe = 0.f, Po = 0.f, Pq = 0.f, Plow = 0.f;
    if (MODE == 1) { cq = cb[tq]; c_low = cb[q_base];
        const float te = tot[bh * 128 + 2 * lane], to = tot[bh * 128 + 2 * lane + 1]; float sc2 = te + to;
#pragma unroll
        for (int o = 1; o < 64; o <<= 1) { const float u = __shfl_up(sc2, o); if (lane >= o) sc2 += u; }
        Pe = sc2 - (te + to); Po = Pe + te;
        { const int cw = q0 >> 6; Pq = (cw & 1) ? __shfl(Po, cw >> 1) : __shfl(Pe, cw >> 1); }
        { const int cl = q_base >> 6; Plow = (cl & 1) ? __shfl(Po, cl >> 1) : __shfl(Pe, cl >> 1); } }
    f32x16 o[4];
#pragma unroll
    for (int d = 0; d < 4; ++d)
#pragma unroll
        for (int i = 0; i < 16; ++i) o[d][i] = 0.f;
    float R = 0.f, mrun = -1e30f, lrun = 0.f;
    const int nsteps = (q_base + 256) >> 6, kb_top = q_base + 192;
    if (wave < 4) __builtin_amdgcn_s_setprio(2); else __builtin_amdgcn_s_setprio(0);
    if (MODE == 0 && tid < 16) flags[tid] = 0u;
    asm volatile("s_waitcnt vmcnt(0)" ::: "memory");
    attn2_stage<MODE>(lds, kbase, vbase, cbase, ldp, kb_top, wave);
    if (nsteps > 1) attn2_stage<MODE>(lds + A2_SLOT, kbase, vbase, cbase, ldp, kb_top - 64, wave);
    bool mydone = false;
    for (int j = 0; j < nsteps; ++j) {
        const int kb = kb_top - 64 * j;
        if (j + 1 < nsteps) { if (MODE == 1) A2_WAIT_V(5); else A2_WAIT_V(4); } else A2_WAIT_V(0);
        __builtin_amdgcn_s_barrier();
        __builtin_amdgcn_sched_barrier(0); asm volatile("" ::: "memory");
        LAS unsigned char* slot = lds + (j % A2_NSLOT) * A2_SLOT;
        float dq = 0.f;
        if (MODE == 1) { const int ck_ = kb >> 6; const float Pk = (ck_ & 1) ? __shfl(Po, ck_ >> 1) : __shfl(Pe, ck_ >> 1);
            dq = Pq - Pk;
            const float ck63 = *(const LAS float*)(slot + 32768 + wave * 1024 + 63 * 4);
            if ((c_low + (Plow - Pk) - ck63) + 2.f * zb2 < ZERO_LOG2) break; }
        else if (j > 0) { const volatile LAS unsigned* fl = flags + 8 * ((j - 1) & 1); unsigned all = 1u;
#pragma unroll
            for (int w2 = 0; w2 < 8; ++w2) all &= fl[w2];
            if (all) break; }
        if (j + 2 < nsteps) attn2_stage<MODE>(lds + ((j + 2) % A2_NSLOT) * A2_SLOT, kbase, vbase, cbase, ldp, kb - 128, wave);
#pragma unroll
        for (int sbi = 0; sbi < 2; ++sbi) { const int sb = 1 - sbi, kk0 = kb + 32 * sb;
            if (kk0 > q0 || mydone) continue;
            if (MODE == 1) { const float ck31 = *(const LAS float*)(slot + 32768 + wave * 1024 + (32 * sb + 31) * 4);
                const float cq0 = __shfl(cq, 0); if ((cq0 + dq - ck31) + 2.f * zb2 < ZERO_LOG2) { mydone = true; continue; } }
            bf16x8 kf[8];
#pragma unroll
            for (int kk = 0; kk < 8; ++kk) kf[kk] = *(const LAS bf16x8*)(slot + (sb * 8 + kk) * 1024 + lane * 16);
            f32x16 sc;
#pragma unroll
            for (int i = 0; i < 16; ++i) sc[i] = 0.f;
#pragma unroll
            for (int kk = 0; kk < 8; ++kk) sc = MFMA32(kf[kk], qf[kk], sc);
            bf16x8 vf[4][2];
#pragma unroll
            for (int d = 0; d < 4; ++d)
#pragma unroll
                for (int s = 0; s < 2; ++s) vf[d][s] = *(const LAS bf16x8*)(slot + 16384 + (sb * 8 + d * 2 + s) * 1024 + lane * 16);
            const bool diag = (kk0 == q0);
            float w[16];
            if (MODE == 0) {
                float L[16];
#pragma unroll
                for (int i = 0; i < 16; ++i) L[i] = flog2(1.f + fexp2(sc[i]));
                if (diag) {
#pragma unroll
                    for (int i = 0; i < 16; ++i) { const int key = kk0 + 16 * (i >> 3) + 8 * hi + (i & 7); if (key >= tq) { L[i] = 0.f; sc[i] = -3e38f; } }
                }
                const float G0 = -(((L[0] + L[1]) + (L[2] + L[3])) + ((L[4] + L[5]) + (L[6] + L[7]))), G1 = -(((L[8] + L[9]) + (L[10] + L[11])) + ((L[12] + L[13]) + (L[14] + L[15])));
                const float Gp0 = __shfl_xor(G0, 32), Gp1 = __shfl_xor(G1, 32);
                const float pre1 = hi ? R : (R + Gp1);
                const float pre0 = hi ? (R + G1 + Gp1) : (R + Gp1 + G1 + Gp0);
                float c = pre1;
#pragma unroll
                for (int jj = 7; jj >= 0; --jj) { c -= L[8 + jj]; w[8 + jj] = fexp2(sc[8 + jj] + c); }
                c = pre0;
#pragma unroll
                for (int jj = 7; jj >= 0; --jj) { c -= L[jj]; w[jj] = fexp2(sc[jj] + c); }
                R += (G0 + G1) + (Gp0 + Gp1);
                if (__all(R + zb2 < ZERO_LOG2)) mydone = true;
            } else {
                f32x2_t v2[8]; const f32x2_t cq2 = {cq + dq, cq + dq};
#pragma unroll
                for (int s = 0; s < 2; ++s) { const LAS f32x4* cp = (const LAS f32x4*)(slot + 32768 + wave * 1024 + (32 * sb + 16 * s + 8 * hi) * 4);
                    const f32x4 c0 = cp[0], c1 = cp[1];
                    v2[4 * s + 0] = (f32x2_t){sc[8 * s + 0], sc[8 * s + 1]} - (f32x2_t){c0.x, c0.y};
                    v2[4 * s + 1] = (f32x2_t){sc[8 * s + 2], sc[8 * s + 3]} - (f32x2_t){c0.z, c0.w};
                    v2[4 * s + 2] = (f32x2_t){sc[8 * s + 4], sc[8 * s + 5]} - (f32x2_t){c1.x, c1.y};
                    v2[4 * s + 3] = (f32x2_t){sc[8 * s + 6], sc[8 * s + 7]} - (f32x2_t){c1.z, c1.w}; }
                if (diag) {
#pragma unroll
                    for (int p = 0; p < 8; ++p) { const int key = kk0 + 16 * (p >> 2) + 8 * hi + 2 * (p & 3);
                        if (key > tq) v2[p].x = -3e38f; if (key + 1 > tq) v2[p].y = -3e38f; }
                }
#pragma unroll
                for (int p = 0; p < 8; ++p) v2[p] += cq2;
                float bm = fmaxf(fmaxf(v2[0].x, v2[0].y), fmaxf(v2[1].x, v2[1].y));
#pragma unroll
                for (int p = 2; p < 8; p += 2) bm = fmaxf(bm, fmaxf(fmaxf(v2[p].x, v2[p].y), fmaxf(v2[p + 1].x, v2[p + 1].y)));
                bm = fmaxf(bm, __shfl_xor(bm, 32));
                const bool upd = bm > mrun + 8.f;
                const float mn = upd ? bm : mrun, alpha = upd ? fexp2(mrun - mn) : 1.f;
                mrun = mn;
                const f32x2_t nmn2 = {-mn, -mn}; f32x2_t ps2 = {0.f, 0.f};
#pragma unroll
                for (int p = 0; p < 8; ++p) { const f32x2_t d2 = v2[p] + nmn2; f32x2_t e2; e2.x = fexp2(d2.x); e2.y = fexp2(d2.y); w[2 * p] = e2.x; w[2 * p + 1] = e2.y; ps2 += e2; }
                lrun = lrun * alpha + (ps2.x + ps2.y);
                if (__any(alpha != 1.f)) {
#pragma unroll
                    for (int d = 0; d < 4; ++d)
#pragma unroll
                        for (int i = 0; i < 16; ++i) o[d][i] *= alpha;
                }
            }
            bf16x8 pf[2];
#pragma unroll
            for (int s = 0; s < 2; ++s) { u32x4 t; t.x = cvtpk(w[8 * s + 0], w[8 * s + 1]); t.y = cvtpk(w[8 * s + 2], w[8 * s + 3]); t.z = cvtpk(w[8 * s + 4], w[8 * s + 5]); t.w = cvtpk(w[8 * s + 6], w[8 * s + 7]);
                pf[s] = __builtin_bit_cast(bf16x8, t); }
#pragma unroll
            for (int d = 0; d < 4; ++d)
#pragma unroll
                for (int s = 0; s < 2; ++s) o[d] = MFMA32(vf[d][s], pf[s], o[d]);
        }
        if (MODE == 0) { if (lane == 0) flags[8 * (j & 1) + wave] = (mydone || kb == 0) ? 1u : 0u; }
    }
    A2_WAIT_V(0);
    __builtin_amdgcn_s_setprio(0);
    float inv = 1.f;
    if (MODE == 1) { const float lt = lrun + __shfl_xor(lrun, 32); inv = 1.f / lt; }
    bf16* op = mix + (row0 + q0 + n) * (size_t)D + h * 128 + 4 * hi;
#pragma unroll
    for (int d = 0; d < 4; ++d)
#pragma unroll
        for (int g = 0; g < 4; ++g) { u32x2 t; t.x = cvtpk(o[d][4 * g] * inv, o[d][4 * g + 1] * inv); t.y = cvtpk(o[d][4 * g + 2] * inv, o[d][4 * g + 3] * inv);
            *(u32x2*)(op + d * 32 + 8 * g) = t; }
    asm volatile("s_waitcnt vmcnt(0) lgkmcnt(0)" ::: "memory");
    __builtin_amdgcn_s_barrier();
}

typedef const __attribute__((address_space(4))) Args* KArgs;
__device__ __forceinline__ KArgs kargs() { auto p = __builtin_amdgcn_kernarg_segment_ptr(); asm volatile("" : "+s"(p)); return (KArgs)p; }
#define TID_VARS int tid_l = threadIdx.x; asm volatile("" : "+v"(tid_l)); const int tid = tid_l, lane = tid & 63, wave = __builtin_amdgcn_readfirstlane(tid >> 6); const int G = gridDim.x, bx = blockIdx.x; const int gw = bx * NWAVES + wave, ngw = G * NWAVES; (void)gw; (void)ngw; (void)lane; (void)G
#ifndef WGM_IN
#define WGM_IN 4
#endif
#ifndef WGM_WO
#define WGM_WO 4
#endif
#ifndef WGM_PP
#define WGM_PP 4
#endif
#ifndef WGM_UP
#define WGM_UP 4
#endif
#ifndef WGM_DN
#define WGM_DN 4
#endif
#ifndef WGM_GT
#define WGM_GT 4
#endif
#ifndef PG_ALIGN
#define PG_ALIGN true
#endif
#ifndef PG_SP2
#define PG_SP2 true
#endif
#ifndef PHMASK
#define PHMASK 0xFFFF
#endif
#define PH(k) ((PHMASK >> (k)) & 1)
#ifndef REP_GEMM
#define REP_GEMM 1
#endif
#ifndef REP_ATTN
#define REP_ATTN 1
#endif
#ifndef REP_LIGHT
#define REP_LIGHT 1
#endif
#ifndef REP_A
#define REP_A REP_ATTN
#endif
#ifndef REP_B
#define REP_B REP_ATTN
#endif
#ifndef REP_C
#define REP_C REP_ATTN
#endif

#ifndef REP_BAR
#define REP_BAR 1
#endif
__device__ __forceinline__ void grid_bar(LAS unsigned char* lds) {
  for (int rb = 0; rb < REP_BAR; ++rb) {
    KArgs A = kargs(); XcdBarrier b; b.bar = (unsigned*)(A->ws + WS_CTL) + CW_BAR; b.x = xb_xcc_id(); b.st = (volatile LAS unsigned*)(lds + MISC_OFF) + 8;
    xcd_barrier(b);
  }
}
struct LayerCfg { int kind, jk, nin, npad; };
__device__ __forceinline__ LayerCfg layer_cfg(int layer) { LayerCfg c; c.kind = layer % 3; c.jk = layer / 3; c.nin = c.kind == 0 ? NA_IN : (c.kind == 1 ? NB_IN : NC_IN); c.npad = c.kind == 0 ? NA_IN : (c.kind == 1 ? NB_PAD : NC_PAD); return c; }

__device__ __forceinline__ void convert_layer(KArgs A, unsigned char* ws, LAS float* scrw, int layer, int which, int gw, int ngw, int lane) {
    const LayerCfg L = layer_cfg(layer);
    if (which & 1) {
        const float* w_in = L.kind == 0 ? A->in[I_A_WIN] + (size_t)L.jk * D * NA_IN : (L.kind == 1 ? A->in[I_B_WIN] : A->in[I_C_WIN]);
        convert_weight(w_in, A->in[I_ATTN_NORM] + layer * D, D, L.nin, L.npad, (bf16*)(ws + WS_WIN), scrw, gw, ngw, lane);
        convert_weight(A->in[I_WO] + (size_t)layer * D * D, nullptr, D, D, D, (bf16*)(ws + WS_WO), scrw, gw, ngw, lane);
        convert_weight(A->in[I_WUP] + (size_t)layer * D * FF, A->in[I_MLP_NORM] + layer * D, D, FF, FF, (bf16*)(ws + WS_WUP), scrw, gw, ngw, lane);
        convert_weight(A->in[I_WDOWN] + (size_t)layer * FF * D, nullptr, FF, D, D, (bf16*)(ws + WS_WDN), scrw, gw, ngw, lane);
    }
    if (which & 2) {
        convert_weight(A->in[I_WGATE] + (size_t)layer * D * D, A->in[I_PLE_NORM] + layer * D, D, D, D, (bf16*)(ws + WS_WG), scrw, gw, ngw, lane);
        convert_weight(A->in[I_WPLE] + (size_t)layer * PLE * D, nullptr, PLE, D, D, (bf16*)(ws + WS_WPL), scrw, gw, ngw, lane);
    }
}
__device__ __forceinline__ void phase_prologue(LAS unsigned char* lds) {
    KArgs A = kargs(); TID_VARS; unsigned char* ws = A->ws;
    float2* rope32 = (float2*)(ws + WS_ROPE32); float2* rope16 = (float2*)(ws + WS_ROPE16);
    const int gt = bx * NTHR + tid, ngt = G * NTHR;
    for (int i = gt; i < SEQ * 16; i += ngt) { const int pos = i >> 4, k = i & 15; const float inv = exp2f(-(float)k * (1.f / 16.f) * 18.931568569324174f);
        const float ang = (float)pos * inv; float s, c; sincosf(ang, &s, &c); rope32[i] = make_float2(c, s); }
    for (int i = gt; i < SEQ * 8; i += ngt) { const int pos = i >> 3, k = i & 7; const float inv = exp2f(-(float)k * (1.f / 8.f) * 18.931568569324174f);
        const float ang = (float)pos * inv; float s, c; sincosf(ang, &s, &c); rope16[i] = make_float2(c, s); }
    const f32x4* p4 = (const f32x4*)A->in[I_P]; u32x2* pb2 = (u32x2*)(ws + WS_PB);
    for (size_t i = gt; i < (size_t)DEPTH * M * PLE / 4; i += ngt) { const f32x4 v = p4[i]; pb2[i] = (u32x2){cvtpk(v.x, v.y), cvtpk(v.z, v.w)}; }
    x_rows(A->in[I_X], (bf16*)(ws + WS_HB0), (float*)(ws + WS_SSP_IN), gw, ngw, lane);
    convert_layer(A, ws, (LAS float*)(lds + RING_OFF + wave * 8448), 0, 1, gw, ngw, lane);
}
__device__ __forceinline__ void phase_inproj(LAS unsigned char* lds, int layer) {
    KArgs A = kargs(); TID_VARS; unsigned char* ws = A->ws; const LayerCfg L = layer_cfg(layer);
    pg8::Gemm g{(const bf16*)(ws + ((layer & 1) ? WS_HB1 : WS_HB0)), (const bf16*)(ws + WS_WIN), M, L.npad, D}; pg8::StaticOrder S; S.init(M, L.npad, G, bx, WGM_IN);
    { const float* ssp = (const float*)(ws + WS_SSP_IN); float* rv = (float*)(ws + WS_RSTD);
      for (int r = gw; r < M; r += ngw) { float v = lane < 32 ? ssp[(size_t)r * 32 + lane] : 0.f; v = wave_sum(v); if (lane == 0) rv[r] = 1.f / sqrtf(v * (1.f / 2048.f) + RMS_EPS); } }
    pg8::EpiStore<0, false> E{(bf16*)(ws + WS_PROJ), L.npad, nullptr};
    pg8::gemm_phase<pg8::EpiStore<0, false>, pg8::StaticOrder, PG_ALIGN, PG_SP2>(lds + RING_OFF, g, S, E);
}
__device__ __forceinline__ float zbound2(const float* gq, const float* gk, int lane) {
    const float a = wave_max(fmaxf(fabsf(gq[lane]), fabsf(gq[lane + 64]))), bq = wave_max(fmaxf(fabsf(gk[lane]), fabsf(gk[lane + 64])));
    return a * bq * 11.313708498984761f * LOG2E * 1.02f;
}
__device__ __forceinline__ void phase_postproj_dense(LAS unsigned char* lds, int layer) {
    KArgs A = kargs(); TID_VARS; unsigned char* ws = A->ws; const LayerCfg L = layer_cfg(layer);
    bf16* PROJ = (bf16*)(ws + WS_PROJ); LAS float* scrw = (LAS float*)(lds + RING_OFF + wave * 8448);
    const float* gq = L.kind == 0 ? A->in[I_A_QN] + L.jk * HD : A->in[I_C_QN]; const float* gk = L.kind == 0 ? A->in[I_A_KN] + L.jk * HD : A->in[I_C_KN];
    const int npad = L.npad;
    const int nscan = L.kind == 2 ? BATCH * 128 : 0, nvt = BATCH * 256 * 16, total = nscan + nvt + M;
    for (int it = gw; it < total; it += ngw) {
        if (it < nscan) { cumchunk_item(PROJ, npad, (const float*)(ws + WS_RSTD), A->in[I_C_BF], (float*)(ws + WS_CUM), (float*)(ws + WS_TOT), it, lane); continue; }
        int r = it - nscan;
        if (r < nvt) { vt_item(PROJ, npad, 2 * D, (const float*)(ws + WS_RSTD), (bf16*)(ws + WS_VT), (LAS unsigned char*)scrw, r, lane); continue; }
        r -= nvt;
        bf16* base = PROJ + (size_t)r * npad + 8 * lane;
        u32x4 raw[4];
#pragma unroll
        for (int j = 0; j < 4; ++j) raw[j] = *(const u32x4*)(base + D + 512 * j);
        const float ar = ((const float*)(ws + WS_RSTD))[r];
#pragma unroll
        for (int j = 0; j < 4; ++j) head128_norm<false>(base + D + 512 * j, raw[j], ar, gk, 1.f, nullptr, lane);
    }
    convert_layer(A, ws, scrw, layer, 2, gw, ngw, lane);
}
__device__ __forceinline__ void phase_postproj_dsa(LAS unsigned char* lds, int layer) {
    KArgs A = kargs(); TID_VARS; unsigned char* ws = A->ws;
    bf16* PROJ = (bf16*)(ws + WS_PROJ); const float2* rope32 = (const float2*)(ws + WS_ROPE32); const float2* rope16 = (const float2*)(ws + WS_ROPE16);
    const float* gq = A->in[I_B_QN]; const float* gk = A->in[I_B_KN]; const float* gi = A->in[I_B_IKN];
    constexpr int npad = NB_PAD;
    for (int r = gw; r < M; r += ngw) { const int pos = r & (SEQ - 1);
        bf16* base = PROJ + (size_t)r * npad;
        const float2* r32 = rope32 + pos * 16; const float2* r16 = rope16 + pos * 8;
        u32x4 raw[8]; u32x4 rawi, raww;
#pragma unroll
        for (int j = 0; j < 5; ++j) raw[j] = *(const u32x4*)(base + 512 * j + 8 * lane);
        raw[5] = *(const u32x4*)(base + B_QI + 8 * lane); raw[6] = *(const u32x4*)(base + B_QI + 512 + 8 * lane);
        rawi = *(const u32x4*)(base + B_KI + 8 * (lane & 7)); raww = *(const u32x4*)(base + B_WI + 8 * (lane & 1));
        const float ar = ((const float*)(ws + WS_RSTD))[r];
        unsigned char* q8 = ws + WS_Q8 + (size_t)r * 2048 + 8 * lane; unsigned char* k8 = ws + WS_K8 + (size_t)r * 512 + 8 * lane; unsigned char* v8 = ws + WS_V8 + (size_t)r * 512 + 8 * lane;
#pragma unroll
        for (int j = 0; j < 4; ++j) head128_norm<true>(base + 512 * j + 8 * lane, raw[j], ar, gq, QSCALE * 8.f, r32, lane, q8 + 512 * j);
        head128_norm<true>(base + B_K + 8 * lane, raw[4], ar, gk, 1.f, r32, lane, k8);
        { const u32x4 rv = *(const u32x4*)(base + B_V + 8 * lane); int w0 = 0, w1 = 0;
          w0 = __builtin_amdgcn_cvt_pk_fp8_f32(bflo(rv.x) * ar, bfhi(rv.x) * ar, w0, false); w0 = __builtin_amdgcn_cvt_pk_fp8_f32(bflo(rv.y) * ar, bfhi(rv.y) * ar, w0, true);
          w1 = __builtin_amdgcn_cvt_pk_fp8_f32(bflo(rv.z) * ar, bfhi(rv.z) * ar, w1, false); w1 = __builtin_amdgcn_cvt_pk_fp8_f32(bflo(rv.w) * ar, bfhi(rv.w) * ar, w1, true);
          *(u32x2*)v8 = (u32x2){(unsigned)w0, (unsigned)w1}; }
#pragma unroll
        for (int j = 0; j < 2; ++j) head64_rope<false>(base + B_QI + 512 * j + 8 * lane, raw[5 + j], ar, nullptr, r16, lane, true);
        head64_rope<true>(base + B_KI + 8 * (lane & 7), rawi, ar, gi, r16, lane, lane < 8);
        if (lane < 2) { bf16* wp = base + B_WI + 8 * lane; const u32x4 raw = raww;
            const float sw = 0.03125f * ar;
            u32x4 w; w.x = cvtpk(bflo(raw.x) * sw, bfhi(raw.x) * sw); w.y = cvtpk(bflo(raw.y) * sw, bfhi(raw.y) * sw);
            w.z = cvtpk(bflo(raw.z) * sw, bfhi(raw.z) * sw); w.w = cvtpk(bflo(raw.w) * sw, bfhi(raw.w) * sw); *(u32x4*)wp = w; }
    }
    convert_layer(A, ws, (LAS float*)(lds + RING_OFF + wave * 8448), layer, 2, gw, ngw, lane);
}
template <int MODE>
__device__ __forceinline__ void phase_attn_dense(LAS unsigned char* lds, int layer, int rep) {
    KArgs A = kargs(); TID_VARS; unsigned char* ws = A->ws; const LayerCfg L = layer_cfg(layer);
    const float* gq = L.kind == 0 ? A->in[I_A_QN] + L.jk * HD : A->in[I_C_QN]; const float* gk = L.kind == 0 ? A->in[I_A_KN] + L.jk * HD : A->in[I_C_KN];
    const float zb2 = zbound2(gq, gk, lane);
    gu32* qhead = (gu32*)(ws + WS_CTL) + CW_QUEUE + 64 * layer + 16 * rep;
    volatile LAS unsigned* uw = (volatile LAS unsigned*)(lds + RING_OFF + A2_CTRL);
    for (;;) { if (tid == 0) uw[0] = __hip_atomic_fetch_add(qhead, 1u, RLX_AGENT); __syncthreads(); const unsigned it = uw[0]; __syncthreads();
        if (it >= 32u * 64u) break;
        const int grp = 31 - (int)(it >> 6), bh = (int)(it & 63u);
        attn2_unit<MODE>((const bf16*)(ws + WS_PROJ), L.npad, (const bf16*)(ws + WS_VT), (const float*)(ws + WS_CUM), (const float*)(ws + WS_TOT), gq, (const float*)(ws + WS_RSTD), (bf16*)(ws + WS_MIX), zb2, grp, bh, lds + RING_OFF, tid); }
}
__device__ __forceinline__ void phase_attn_dsa(LAS unsigned char* lds, int layer, int rep) {
    KArgs A = kargs(); TID_VARS; unsigned char* ws = A->ws;
    gu32* qhead = (gu32*)(ws + WS_CTL) + CW_QUEUE + 64 * layer + 16 * rep;
    float* scr = (float*)(ws + (bx < 128 ? WS_SCR_A + (size_t)bx * MiB : WS_SCR_B + (size_t)(bx - 128) * MiB));
    volatile LAS unsigned* uw = (volatile LAS unsigned*)(lds + RING_OFF + DL_MISC + 128);
    for (;;) { if (tid == 0) uw[0] = __hip_atomic_fetch_add(qhead, 1u, RLX_AGENT); __syncthreads(); const unsigned u = uw[0]; __syncthreads();
        if (u >= 1024u) break; dsa_unit((const bf16*)(ws + WS_PROJ), ws + WS_Q8, ws + WS_K8, ws + WS_V8, (bf16*)(ws + WS_MIX), scr, lds + RING_OFF, (int)u, tid); }
}
__device__ __forceinline__ void phase_wo(LAS unsigned char* lds, int layer) {
    KArgs A = kargs(); TID_VARS; unsigned char* ws = A->ws;
    pg8::Gemm g{(const bf16*)(ws + WS_MIX), (const bf16*)(ws + WS_WO), M, D, D}; pg8::StaticOrder S; S.init(M, D, G, bx, WGM_WO);
    bf16* hb = (bf16*)(ws + ((layer & 1) ? WS_HB1 : WS_HB0));
    pg8::EpiH<false, false> E{hb, hb, (float*)(ws + WS_SSP_WO), nullptr, nullptr, nullptr};
    pg8::gemm_phase<pg8::EpiH<false, false>, pg8::StaticOrder, PG_ALIGN, PG_SP2>(lds + RING_OFF, g, S, E);
}
__device__ __forceinline__ void phase_pp(LAS unsigned char* lds, int layer) {
    KArgs A = kargs(); TID_VARS; unsigned char* ws = A->ws;
    int kpl = PLE; asm volatile("" : "+s"(kpl));
    pg8::Gemm g{(const bf16*)(ws + WS_PB) + (size_t)layer * M * PLE, (const bf16*)(ws + WS_WPL), M, D, kpl}; pg8::StaticOrder S; S.init(M, D, G, bx, WGM_PP);
    pg8::EpiStore<0, false> E{(bf16*)(ws + WS_PP), D, nullptr};
    pg8::gemm_phase<pg8::EpiStore<0, false>, pg8::StaticOrder, PG_ALIGN, PG_SP2>(lds + RING_OFF, g, S, E);
}
__device__ __forceinline__ void phase_up(LAS unsigned char* lds, int layer) {
    KArgs A = kargs(); TID_VARS; unsigned char* ws = A->ws;
    pg8::Gemm g{(const bf16*)(ws + ((layer & 1) ? WS_HB1 : WS_HB0)), (const bf16*)(ws + WS_WUP), M, FF, D}; pg8::StaticOrder S; S.init(M, FF, G, bx, WGM_UP);
    pg8::EpiStore<1, false> E{(bf16*)(ws + WS_HID), FF, nullptr};
    pg8::gemm_phase<pg8::EpiStore<1, false>, pg8::StaticOrder, PG_ALIGN, PG_SP2>(lds + RING_OFF, g, S, E);
}
__device__ __forceinline__ void phase_down(LAS unsigned char* lds, int layer) {
    KArgs A = kargs(); TID_VARS; unsigned char* ws = A->ws;
    pg8::Gemm g{(const bf16*)(ws + WS_HID), (const bf16*)(ws + WS_WDN), M, D, FF}; pg8::StaticOrder S; S.init(M, D, G, bx, WGM_DN);
    bf16* hb = (bf16*)(ws + ((layer & 1) ? WS_HB1 : WS_HB0));
    pg8::EpiH<false, false, true> E{hb, hb, (float*)(ws + WS_SSP_DN), nullptr, (const float*)(ws + WS_SSP_WO), nullptr};
    pg8::gemm_phase<pg8::EpiH<false, false, true>, pg8::StaticOrder, PG_ALIGN, PG_SP2>(lds + RING_OFF, g, S, E);
}
template <bool FINAL>
__device__ __forceinline__ void phase_gate(LAS unsigned char* lds, int layer) {
    KArgs A = kargs(); TID_VARS; unsigned char* ws = A->ws;
    pg8::Gemm g{(const bf16*)(ws + ((layer & 1) ? WS_HB1 : WS_HB0)), (const bf16*)(ws + WS_WG), M, D, D}; pg8::StaticOrder S; S.init(M, D, G, bx, WGM_GT);
    pg8::EpiH<true, FINAL> E{(const bf16*)(ws + ((layer & 1) ? WS_HB1 : WS_HB0)), (bf16*)(ws + ((layer & 1) ? WS_HB0 : WS_HB1)), (float*)(ws + WS_SSP_IN), (const bf16*)(ws + WS_PP), (const float*)(ws + WS_SSP_DN), A->out};
    pg8::gemm_phase<pg8::EpiH<true, FINAL>, pg8::StaticOrder, PG_ALIGN, PG_SP2>(lds + RING_OFF, g, S, E);
}
__device__ __forceinline__ void phase_convert_next(LAS unsigned char* lds, int layer) {
    KArgs A = kargs(); TID_VARS; unsigned char* ws = A->ws;
    convert_layer(A, ws, (LAS float*)(lds + RING_OFF + wave * 8448), layer, 1, gw, ngw, lane);
}

__global__ void __launch_bounds__(NTHR, 2) trunk_fwd(Args args) {
    extern __shared__ __attribute__((aligned(16))) unsigned char lds_raw[];
    LAS unsigned char* lds = (LAS unsigned char*)lds_raw;
    for (int u = threadIdx.x; u < (LDS_BYTES - LDSCTL_OFF) / 4; u += NTHR) ((LAS unsigned*)(lds + LDSCTL_OFF))[u] = 0u;
    __syncthreads();
    { KArgs A = kargs(); (void)xcd_barrier_post((unsigned*)(A->ws + WS_CTL) + CW_BAR, (volatile LAS unsigned*)(lds + MISC_OFF) + 8); }
#ifdef PROBE_MASK
    unsigned long long pt_acc = 0ull, pt_last = __builtin_amdgcn_s_memrealtime();
#define PT(cls) do { const unsigned long long now_ = __builtin_amdgcn_s_memrealtime(); if ((PROBE_MASK >> (cls)) & 1) pt_acc += now_ - pt_last; pt_last = now_; } while (0)
#else
#define PT(cls) do { } while (0)
#endif
    phase_prologue(lds);
    grid_bar(lds); PT(7);
    for (int layer = 0; layer < DEPTH; ++layer) {
        const int kind = layer % 3;
        phase_inproj(lds, layer);
        grid_bar(lds); PT(0);
        if (kind != 1) phase_postproj_dense(lds, layer); else phase_postproj_dsa(lds, layer);
        grid_bar(lds); PT(1);
        if (kind == 0) phase_attn_dense<0>(lds, layer, 0);
        else if (kind == 2) phase_attn_dense<1>(lds, layer, 0);
        else phase_attn_dsa(lds, layer, 0);
        grid_bar(lds); PT(kind == 0 ? 2 : (kind == 1 ? 8 : 9));
        phase_wo(lds, layer);
        phase_pp(lds, layer);
        grid_bar(lds); PT(3);
        phase_up(lds, layer);
        grid_bar(lds); PT(4);
        phase_down(lds, layer);
        grid_bar(lds); PT(5);
        if (layer + 1 < DEPTH) { phase_gate<false>(lds, layer); __syncthreads(); phase_convert_next(lds, layer + 1); }
        else phase_gate<true>(lds, layer);
        grid_bar(lds); PT(6);
    }
#ifdef PROBE_MASK
#if defined(PROBE_EPI) || defined(PROBE_DSA)
    pt_acc = *(volatile LAS unsigned long long*)(lds + MISC_OFF + 64);
#endif
    if (blockIdx.x == 0 && threadIdx.x == 0) { const unsigned long long until = __builtin_amdgcn_s_memrealtime() + (unsigned long long)PROBE_AMP * pt_acc;
        while (__builtin_amdgcn_s_memrealtime() < until) __builtin_amdgcn_s_sleep(32); }
#endif
}

extern "C" void kernel_launch(void* const* d_in, const int* in_sizes, int n_in, void* d_out, int out_size, void* d_ws, size_t ws_size, hipStream_t stream) {
    static int grid = 0;
    if (grid == 0) {
        if (n_in != 21 || out_size != M * D || ws_size < WS_END2) { fprintf(stderr, "kernel_launch: unexpected shapes (n_in %d, out %d, ws %zu)\n", n_in, out_size, ws_size); grid = -1; return; }
        int dev = 0, cus = 0, per_cu = 0;
        if (hipGetDevice(&dev) != hipSuccess || hipDeviceGetAttribute(&cus, hipDeviceAttributeMultiprocessorCount, dev) != hipSuccess) { grid = -1; return; }
        if (hipFuncSetAttribute((const void*)trunk_fwd, hipFuncAttributeMaxDynamicSharedMemorySize, LDS_BYTES) != hipSuccess) { fprintf(stderr, "kernel_launch: hipFuncSetAttribute failed\n"); grid = -1; return; }
        if (hipOccupancyMaxActiveBlocksPerMultiprocessor(&per_cu, (const void*)trunk_fwd, NTHR, LDS_BYTES) != hipSuccess || per_cu < 1) { fprintf(stderr, "kernel_launch: occupancy query says %d\n", per_cu); }
        (void)hipGetLastError();
        grid = cus > 256 ? 256 : cus;
    }
    if (grid < 0) return;
    if (hipMemsetAsync((char*)d_ws + WS_CTL, 0, CTL_ZERO_BYTES, stream) != hipSuccess) return;
    Args a{};
    for (int i = 0; i < 21; ++i) a.in[i] = (const float*)d_in[i];
    a.out = (float*)d_out; a.ws = (unsigned char*)d_ws;
    hipLaunchKernelGGL(trunk_fwd, dim3(grid), dim3(NTHR), LDS_BYTES, stream, a);
}
```

```cpp
#include <hip/hip_runtime.h>
#include <cstdio>
#include <cstdint>
namespace pg8 {
#define PG8_LAS __attribute__((address_space(3)))
typedef unsigned short bf16_t;
typedef short bf16x8 __attribute__((ext_vector_type(8)));
typedef float f32x4 __attribute__((ext_vector_type(4)));
typedef unsigned u32x4 __attribute__((ext_vector_type(4)));
constexpr int BM = 256, BK = 64, HALF = 128, HTB = HALF * BK * 2  , STAGE_BYTES = 8 * HTB, NXCD = 8, WGM = 8;

__host__ __device__ __forceinline__ int lds_byte(int r, int c) { const int st = (r >> 4) * 2 + (c >> 5), rr = r & 15, cc = c & 31, ob = rr * 64 + cc * 2; return st * 1024 + (ob ^ (((ob >> 9) & 1) << 5)); }
__host__ __device__ __forceinline__ void stage_rc(int b, int& R, int& C) { const int st = b / 1024, sb = b % 1024, swz = sb ^ (((sb >> 9) & 1) << 5); R = (st >> 1) * 16 + swz / 64; C = (st & 1) * 32 + (swz % 64) / 2; }
__host__ __device__ __forceinline__ int perm32(int rho) { const int n = rho >> 4, i = rho & 15; return 8 * (i >> 2) + 4 * n + (i & 3); }

struct Unit { int pm, pn; };
struct Gemm { const bf16_t* A; const bf16_t* Bt; int M, N, K; };

struct StaticOrder {
    int nM, nN, nwg, G, c, wgm;
    __host__ __device__ void init(int M, int N, int G_, int c_, int wgm_ = 4) { nM = M / BM; nN = N / BM; nwg = nM * nN; G = G_; c = c_; wgm = wgm_; }
    __host__ __device__ bool next(int i, Unit& u) const {
        const long L = (long)i * G + c; if (L >= nwg) return false;
        int wgid = (int)L; { const int q = nwg / NXCD, r = nwg % NXCD, xcd = wgid % NXCD, off = wgid / NXCD; wgid = (xcd < r ? xcd * (q + 1) : r * (q + 1) + (xcd - r) * q) + off; }
        const int nig = wgm * nN, gid = wgid / nig, fm = gid * wgm, gsz = (nM - fm) < wgm ? (nM - fm) : wgm;
        u.pm = fm + ((wgid % nig) % gsz); u.pn = (wgid % nig) / gsz; return true;
    }
    __device__ __forceinline__ void a_ready(const Unit&) const {}
    __device__ __forceinline__ void done(const Unit&) const {}
};

__device__ __forceinline__ unsigned cvt_pk_bf16(float lo, float hi) { unsigned r; asm volatile("v_cvt_pk_bf16_f32 %0, %1, %2" : "=v"(r) : "v"(lo), "v"(hi)); return r; }
typedef float f32x2 __attribute__((ext_vector_type(2)));
template <class Epi, class Sched, bool ALIGN_EPI = false, bool SP2 = false>
__device__ __forceinline__ void gemm_phase(PG8_LAS unsigned char* lds, const Gemm g, const Sched& S, const Epi& E) {
    int tid_l = threadIdx.x; asm volatile("" : "+v"(tid_l));
    const int tid = tid_l, wid = __builtin_amdgcn_readfirstlane(tid >> 6), lane = tid & 63, wr = wid >> 2, wc = wid & 3, fr = lane & 15, fq = lane >> 4;
    const int K = g.K, nt = K / BK;
    unsigned voffA[2], voffB[2];
#pragma unroll
    for (int i = 0; i < 2; ++i) { int R, C; stage_rc(tid * 16 + i * 8192, R, C); const int Rb = Epi::PERM ? ((R & ~31) + perm32(R & 31)) : R;
        voffA[i] = (unsigned)(R * K + C) * 2u; voffB[i] = (unsigned)(Rb * K + C) * 2u; }
    const size_t kstep = (size_t)(BK * 2);
    const size_t hstep = (size_t)HALF * K * 2;
    const size_t tstep = 2 * hstep;
    const unsigned ldsw = (unsigned)wid * 1024u;
    const int aoff = lds_byte(wr * 64 + fr, fq * 8), boff = lds_byte(wc * 32 + fr, fq * 8);
#define PG8_SA(b, h) (((b) * 2 + (h)) * HTB)
#define PG8_SB(b, h) ((4 + (b) * 2 + (h)) * HTB)
#define PG8_STAGE(bufoff, gbase, voff) do { _Pragma("unroll") for (int _i = 0; _i < 2; ++_i) \
        __builtin_amdgcn_global_load_lds((const unsigned*)((const char*)(gbase) + (voff)[_i]), (PG8_LAS unsigned*)(lds + (bufoff) + ldsw + _i * 8192), 16, 0, 0); } while (0)
#define PG8_LDA(dst, b, h) do { _Pragma("unroll") for (int m = 0; m < 4; ++m) _Pragma("unroll") for (int k = 0; k < 2; ++k) dst[m][k] = *(const PG8_LAS bf16x8*)(lds + PG8_SA(b, h) + aoff + m * 2048 + k * 1024); } while (0)
#define PG8_LDB(dst, b, h) do { _Pragma("unroll") for (int n = 0; n < 2; ++n) _Pragma("unroll") for (int k = 0; k < 2; ++k) dst[n][k] = *(const PG8_LAS bf16x8*)(lds + PG8_SB(b, h) + boff + n * 2048 + k * 1024); } while (0)
#define PG8_MMA(ai, bj, At, Bt) do { __builtin_amdgcn_s_setprio(1); _Pragma("unroll") for (int m = 0; m < 4; ++m) _Pragma("unroll") for (int n = 0; n < 2; ++n) _Pragma("unroll") for (int k = 0; k < 2; ++k) \
        acc[ai][bj][m][n] = __builtin_amdgcn_mfma_f32_16x16x32_bf16(Bt[n][k], At[m][k], acc[ai][bj][m][n], 0, 0, 0); __builtin_amdgcn_s_setprio(0); } while (0)
#define PG8_WAIT_V(n) asm volatile("s_waitcnt vmcnt(" #n ")" ::: "memory")
#define PG8_WAIT_L(n) asm volatile("s_waitcnt lgkmcnt(" #n ")" ::: "memory")
#define PG8_BAR __builtin_amdgcn_s_barrier()
#define PG8_SCHED __builtin_amdgcn_sched_barrier(0)
    Unit cur, nxt; int ui = 0;
    if (!S.next(0, cur)) return;
    f32x4 acc[2][2][4][2];
#pragma unroll
    for (int a = 0; a < 2; ++a)
#pragma unroll
        for (int b = 0; b < 2; ++b)
#pragma unroll
            for (int m = 0; m < 4; ++m)
#pragma unroll
                for (int n = 0; n < 2; ++n) acc[a][b][m][n] = (f32x4){0.f, 0.f, 0.f, 0.f};
    bf16x8 At[4][2], B0[2][2], B1[2][2];
    const char* cA = (const char*)g.A + (size_t)cur.pm * tstep; const char* cB = (const char*)g.Bt + (size_t)cur.pn * tstep;
    S.a_ready(cur);
    if constexpr (SP2) {
        PG8_STAGE(PG8_SB(0, 0), cB, voffB); PG8_STAGE(PG8_SB(0, 1), cB + hstep, voffB); PG8_STAGE(PG8_SA(0, 0), cA, voffA); PG8_STAGE(PG8_SA(0, 1), cA + hstep, voffA);
        if (wr == 1) PG8_BAR;
        PG8_WAIT_V(2); PG8_BAR;
        PG8_STAGE(PG8_SB(1, 0), cB + kstep, voffB); PG8_STAGE(PG8_SA(1, 0), cA + kstep, voffA); PG8_STAGE(PG8_SB(1, 1), cB + hstep + kstep, voffB);
        PG8_WAIT_V(6); PG8_BAR;
    } else {
        PG8_STAGE(PG8_SB(0, 0), cB, voffB); PG8_STAGE(PG8_SA(0, 0), cA, voffA); PG8_STAGE(PG8_SB(0, 1), cB + hstep, voffB); PG8_STAGE(PG8_SA(0, 1), cA + hstep, voffA);
        if (wr == 1) PG8_BAR;
        PG8_WAIT_V(4); PG8_BAR;
        PG8_STAGE(PG8_SB(1, 0), cB + kstep, voffB); PG8_STAGE(PG8_SA(1, 0), cA + kstep, voffA); PG8_STAGE(PG8_SB(1, 1), cB + hstep + kstep, voffB);
        PG8_WAIT_V(6); PG8_BAR;
    }
    for (;;) {
        const bool has_next = S.next(ui + 1, nxt);
        const char* nA = has_next ? (const char*)g.A + (size_t)nxt.pm * tstep : cA; const char* nB = has_next ? (const char*)g.Bt + (size_t)nxt.pn * tstep : cB;
        for (int t = 0; t < nt; t += 2) {
            const bool last = (t == nt - 2);
            const char* a1 = cA + (size_t)(t + 1) * kstep;
            const char* a2 = last ? nA : cA + (size_t)(t + 2) * kstep; const char* b2 = last ? nB : cB + (size_t)(t + 2) * kstep;
            const char* a3 = a2 + kstep; const char* b3 = b2 + kstep;
            if (last && has_next) S.a_ready(nxt);
            if constexpr (SP2) {
            PG8_LDB(B0, 0, 0); PG8_LDB(B1, 0, 1); PG8_SCHED; PG8_LDA(At, 0, 0); PG8_STAGE(PG8_SA(1, 1), a1 + hstep, voffA);
            PG8_WAIT_V(8); PG8_WAIT_L(0); PG8_BAR; PG8_MMA(0, 0, At, B0); PG8_MMA(0, 1, At, B1); PG8_BAR; PG8_SCHED;
            PG8_LDA(At, 0, 1); PG8_STAGE(PG8_SB(0, 0), b2, voffB); PG8_STAGE(PG8_SB(0, 1), b2 + hstep, voffB); PG8_STAGE(PG8_SA(0, 0), a2, voffA);
            PG8_WAIT_V(8); PG8_WAIT_L(0); PG8_BAR; PG8_MMA(1, 0, At, B0); PG8_MMA(1, 1, At, B1); PG8_BAR; PG8_SCHED;
            PG8_LDB(B0, 1, 0); PG8_LDB(B1, 1, 1); PG8_SCHED; PG8_LDA(At, 1, 0); PG8_STAGE(PG8_SA(0, 1), a2 + hstep, voffA);
            PG8_WAIT_V(8); PG8_WAIT_L(0); PG8_BAR; PG8_MMA(0, 0, At, B0); PG8_MMA(0, 1, At, B1); PG8_BAR; PG8_SCHED;
            PG8_LDA(At, 1, 1); PG8_STAGE(PG8_SB(1, 0), b3, voffB); PG8_STAGE(PG8_SB(1, 1), b3 + hstep, voffB); PG8_STAGE(PG8_SA(1, 0), a3, voffA);
            PG8_WAIT_V(8); PG8_WAIT_L(0); PG8_BAR; PG8_MMA(1, 0, At, B0); PG8_MMA(1, 1, At, B1); PG8_BAR; PG8_SCHED;
            } else {
            PG8_LDB(B0, 0, 0); PG8_SCHED; PG8_LDA(At, 0, 0); PG8_STAGE(PG8_SA(1, 1), a1 + hstep, voffA);
            PG8_WAIT_L(8); PG8_BAR; PG8_WAIT_L(0); PG8_MMA(0, 0, At, B0); PG8_BAR; PG8_SCHED;
            PG8_LDB(B1, 0, 1); PG8_STAGE(PG8_SB(0, 0), b2, voffB);
            PG8_BAR; PG8_WAIT_L(0); PG8_MMA(0, 1, At, B1); PG8_BAR;
            PG8_LDA(At, 0, 1); PG8_STAGE(PG8_SA(0, 0), a2, voffA);
            PG8_BAR; PG8_WAIT_L(0); PG8_MMA(1, 0, At, B0); PG8_BAR; PG8_SCHED;
            PG8_STAGE(PG8_SB(0, 1), b2 + hstep, voffB);
            PG8_WAIT_V(6); PG8_BAR; PG8_MMA(1, 1, At, B1); PG8_BAR;
            PG8_LDB(B0, 1, 0); PG8_SCHED; PG8_LDA(At, 1, 0); PG8_STAGE(PG8_SA(0, 1), a2 + hstep, voffA);
            PG8_WAIT_L(8); PG8_BAR; PG8_WAIT_L(0); PG8_MMA(0, 0, At, B0); PG8_BAR; PG8_SCHED;
            PG8_LDB(B1, 1, 1); PG8_STAGE(PG8_SB(1, 0), b3, voffB);
            PG8_BAR; PG8_WAIT_L(0); PG8_MMA(0, 1, At, B1); PG8_BAR;
            PG8_LDA(At, 1, 1); PG8_STAGE(PG8_SA(1, 0), a3, voffA);
            PG8_BAR; PG8_WAIT_L(0); PG8_MMA(1, 0, At, B0); PG8_BAR; PG8_SCHED;
            PG8_STAGE(PG8_SB(1, 1), b3 + hstep, voffB);
            PG8_WAIT_V(6); PG8_BAR; PG8_MMA(1, 1, At, B1); PG8_BAR;
            }
        }
        if constexpr (ALIGN_EPI) { if (wr == 0) PG8_BAR; }
#ifdef PROBE_EPI
        const unsigned long long te0_ = __builtin_amdgcn_s_memrealtime();
#endif
        if constexpr (!Epi::AFTER_DRAIN) { E(acc, cur, wr, wc, fr, fq); S.done(cur); }
#ifdef PROBE_EPI
        if (tid == 0) { volatile PG8_LAS unsigned long long* pe_ = (volatile PG8_LAS unsigned long long*)(lds + 131072 + 320 + 64); pe_[0] = pe_[0] + (__builtin_amdgcn_s_memrealtime() - te0_); }
#endif
        if (!has_next) break;
#pragma unroll
        for (int a = 0; a < 2; ++a)
#pragma unroll
            for (int b = 0; b < 2; ++b)
#pragma unroll
                for (int m = 0; m < 4; ++m)
#pragma unroll
                    for (int n = 0; n < 2; ++n) acc[a][b][m][n] = (f32x4){0.f, 0.f, 0.f, 0.f};
        cur = nxt; cA = nA; cB = nB; ++ui;
        if constexpr (ALIGN_EPI) { if (wr == 1) PG8_BAR; }
    }
    PG8_WAIT_V(0);
    if constexpr (!ALIGN_EPI) { if (wr == 0) PG8_BAR; }
    PG8_BAR;
    if constexpr (Epi::AFTER_DRAIN) { E.fused(acc, cur, wr, wc, fr, fq, lds, wid, lane); S.done(cur); }
#undef PG8_SA
#undef PG8_SB
#undef PG8_STAGE
#undef PG8_LDA
#undef PG8_LDB
#undef PG8_MMA
#undef PG8_WAIT_V
#undef PG8_WAIT_L
#undef PG8_BAR
#undef PG8_SCHED
}
}
#define GAS __attribute__((address_space(1)))
#define LAS __attribute__((address_space(3)))
typedef unsigned short bf16;
typedef unsigned v4u __attribute__((ext_vector_type(4)));
typedef float f32x4 __attribute__((ext_vector_type(4)));
typedef short bf16x8 __attribute__((ext_vector_type(8)));
typedef GAS unsigned gu32;
typedef GAS unsigned long long gu64;
#define RLX_AGENT __ATOMIC_RELAXED, __HIP_MEMORY_SCOPE_AGENT
#define LDS_WAIT() asm volatile("s_waitcnt lgkmcnt(0)" ::: "memory")
#define VM_WAIT() asm volatile("s_waitcnt vmcnt(0)" ::: "memory")
__device__ __forceinline__ unsigned long long rt() { return __builtin_amdgcn_s_memrealtime(); }
__device__ __forceinline__ unsigned f2bf(float f) { unsigned u = __builtin_bit_cast(unsigned, f); return (u + 0x7fffu + ((u >> 16) & 1u)) >> 16; }
__device__ __forceinline__ unsigned pk2(float lo, float hi) { return f2bf(lo) | (f2bf(hi) << 16); }
typedef unsigned u32x4 __attribute__((ext_vector_type(4)));
#define XB_TMO      128
#define XB_XCNT(j)  (256  + 64 * (j))
#define XB_XSUB(j)  (1280 + 64 * (j))
#define XB_XGEN(j)  (2304 + 64 * (j))
#define XB_TOP      3328
#define XB_TOPGEN   3392
#define XCD_BAR_WORDS 3456
#define XB_SPIN_CAP (1u << 18)

__device__ __forceinline__ unsigned xb_ld(unsigned* p)              { return __hip_atomic_load(p, __ATOMIC_RELAXED, __HIP_MEMORY_SCOPE_AGENT); }
__device__ __forceinline__ unsigned xb_add(unsigned* p, unsigned v) { return __hip_atomic_fetch_add(p, v, __ATOMIC_RELAXED, __HIP_MEMORY_SCOPE_AGENT); }
__device__ __forceinline__ unsigned xb_xcc_id() { return (unsigned)__builtin_amdgcn_s_getreg((3 << 11) | 20) & 0xFu; }
#define XB_SPIN(cond, bar) do { unsigned _sp = 0; while (cond) { __builtin_amdgcn_s_sleep(1); \
    if ((++_sp & 255u) == 0u) { if (xb_ld(&(bar)[XB_TMO])) break; if (_sp > XB_SPIN_CAP) { atomicAdd(&(bar)[XB_TMO], 1u); break; } } } } while (0)

struct XcdBarrier {
    unsigned* bar; unsigned x;
    volatile LAS unsigned* st;
};

__device__ __forceinline__ XcdBarrier xcd_barrier_post(unsigned* bar, volatile LAS unsigned* st) {
    XcdBarrier b; b.bar = bar; b.x = xb_xcc_id(); b.st = st;
    if (threadIdx.x == 0) (void)xb_add(&bar[XB_XCNT(b.x)], 1u);
    return b;
}
__device__ __forceinline__ void xcd_barrier_complete(unsigned* bar, unsigned x, unsigned& nloc, unsigned& nx) {
    const unsigned G = gridDim.x * gridDim.y * gridDim.z;
    unsigned sum, cnt, mine, sp = 0u;
    for (;;) {
        sum = 0u; cnt = 0u; mine = 0u;
#pragma unroll
        for (unsigned j = 0; j < 16; ++j) { const unsigned c = xb_ld(&bar[XB_XCNT(j)]); sum += c; cnt += (c > 0u) ? 1u : 0u; mine = (j == x) ? c : mine; }
        if (sum == G) break;
        __builtin_amdgcn_s_sleep(1);
        if ((++sp & 255u) == 0u) { if (xb_ld(&bar[XB_TMO])) break; if (sp > XB_SPIN_CAP) { atomicAdd(&bar[XB_TMO], 1u); break; } }
    }
    nloc = mine > 0u ? mine : 1u; nx = cnt > 0u ? cnt : 1u;
}

__device__ __forceinline__ void xcd_barrier(const XcdBarrier& b) {
    asm volatile("s_waitcnt vmcnt(0)" ::: "memory");
    __syncthreads();
    if (threadIdx.x == 0) {
        unsigned* bar = b.bar;
        __builtin_amdgcn_s_waitcnt(0);
        unsigned nloc = b.st[0], nx = b.st[1];
        if (nloc == 0u) { xcd_barrier_complete(bar, b.x, nloc, nx); b.st[0] = nloc; b.st[1] = nx; }
        const unsigned old = xb_add(&bar[XB_XSUB(b.x)], 1u);
        const unsigned gen = old / nloc;
        if (old + 1u == (gen + 1u) * nloc) {
            __builtin_amdgcn_fence(__ATOMIC_RELEASE, "agent");
            asm volatile("s_waitcnt vmcnt(0)" ::: "memory");
            const unsigned og = xb_add(&bar[XB_TOP], 1u);
            const unsigned tg = og / nx;
            if (og + 1u == (tg + 1u) * nx) xb_add(&bar[XB_TOPGEN], 1u);
            else XB_SPIN(xb_ld(&bar[XB_TOPGEN]) == tg, bar);
            __builtin_amdgcn_fence(__ATOMIC_ACQUIRE, "agent");
            xb_add(&bar[XB_XGEN(b.x)], 1u);
            asm volatile("s_waitcnt vmcnt(0)" ::: "memory");
        } else {
            XB_SPIN(xb_ld(&bar[XB_XGEN(b.x)]) == gen, bar);
            __builtin_amdgcn_fence(__ATOMIC_ACQUIRE, "agent");
            asm volatile("s_waitcnt vmcnt(0)" ::: "memory");
        }
    }
    __syncthreads();
}

constexpr int NWAVES = 8, NTHR = 512;
constexpr int BATCH = 4, SEQ = 8192, M = BATCH * SEQ, D = 2048, NH = 16, HD = 128, FF = 8192, PLE = 256, DEPTH = 4;
constexpr int NA_IN = 6144, NB_IN = 4176, NB_PAD = 4352, NC_IN = 6160, NC_PAD = 6400;
constexpr int B_K = 2048, B_V = 2560, B_QI = 3072, B_KI = 4096, B_WI = 4160;
constexpr float RMS_EPS = 1e-6f, LOG2E = 1.4426950408889634f;
constexpr float QSCALE = 0.08838834764831845f * 1.4426950408889634f;
constexpr float ZERO_LOG2 = -160.f;

constexpr size_t MiB = 1u << 20;
constexpr size_t WS_CTL = 0, CTL_ZERO_BYTES = 1 * MiB;
constexpr size_t WS_ROPE32 = 1 * MiB, WS_ROPE16 = 2 * MiB, WS_CUM = 3 * MiB, WS_TOT = 5 * MiB, WS_RSTD = 6 * MiB;
constexpr size_t WS_WIN = 8 * MiB, WS_WO = 33 * MiB, WS_WUP = 41 * MiB, WS_WDN = 73 * MiB, WS_WG = 105 * MiB, WS_WPL = 113 * MiB;
constexpr size_t WS_PB = 120 * MiB, WS_HN = 184 * MiB, WS_PROJ = 312 * MiB, WS_MIX = 712 * MiB, WS_VT = 840 * MiB, WS_END = 968 * MiB;
constexpr size_t WS_HID = WS_PROJ, WS_PP = WS_VT, WS_HB0 = WS_HN, WS_HB1 = 968 * MiB, WS_SSP_IN = 1096 * MiB, WS_SSP_WO = 1100 * MiB, WS_SSP_DN = 1104 * MiB, WS_K8 = 1108 * MiB, WS_V8 = 1124 * MiB, WS_Q8 = 1140 * MiB, WS_END2 = 1204 * MiB;
constexpr size_t WS_SCR_A = WS_PROJ + 272 * MiB, WS_SCR_B = WS_VT;
static_assert(WS_HID + (size_t)M * FF * 2 <= WS_VT, "hidden overlays proj|mix");
static_assert(WS_PROJ + (size_t)M * NB_PAD * 2 <= WS_SCR_A && WS_SCR_A + 128 * MiB <= WS_MIX, "scratch A");

constexpr int CW_BAR = 4096;
constexpr int CW_QUEUE = 16384;

constexpr int RING_OFF = 0, RING_BYTES = 131072;
constexpr int LDSCTL_OFF = RING_BYTES, MISC_OFF = LDSCTL_OFF + 320;
constexpr int LDS_BYTES = 147456;

typedef float f32x16 __attribute__((ext_vector_type(16)));
typedef unsigned u32x2 __attribute__((ext_vector_type(2)));
typedef __bf16 bf16x2_t __attribute__((ext_vector_type(2)));
typedef float f32x2_t __attribute__((ext_vector_type(2)));
typedef short s16x4_t __attribute__((ext_vector_type(4)));

__device__ __forceinline__ float bf2f(unsigned short b) { return __builtin_bit_cast(float, (unsigned)b << 16); }
__device__ __forceinline__ float bflo(unsigned u) { return __builtin_bit_cast(float, u << 16); }
__device__ __forceinline__ float bfhi(unsigned u) { return __builtin_bit_cast(float, u & 0xffff0000u); }
__device__ __forceinline__ float relu_raw(float x) { const int i = __builtin_bit_cast(int, x); return __builtin_bit_cast(float, i > 0 ? i : 0); }
__device__ __forceinline__ unsigned cvtpk(float lo, float hi) { f32x2_t v = {lo, hi}; bf16x2_t b = __builtin_convertvector(v, bf16x2_t); return __builtin_bit_cast(unsigned, b); }
__device__ __forceinline__ float wave_sum(float v) {
#pragma unroll
    for (int o = 1; o < 64; o <<= 1) v += __shfl_xor(v, o);
    return v;
}
__device__ __forceinline__ float wave_max(float v) {
#pragma unroll
    for (int o = 1; o < 64; o <<= 1) v = fmaxf(v, __shfl_xor(v, o));
    return v;
}
__device__ __forceinline__ float wave_min(float v) {
#pragma unroll
    for (int o = 1; o < 64; o <<= 1) v = fminf(v, __shfl_xor(v, o));
    return v;
}
__device__ __forceinline__ float fexp2(float x) { return __builtin_amdgcn_exp2f(x); }
__device__ __forceinline__ float flog2(float x) { return __builtin_amdgcn_logf(x); }

namespace pg8 {
__device__ __forceinline__ void row_rstd(const float* ssp, int rowbase, int fr, int fq, float (&rs)[2][4]) {
    float mine[2];
#pragma unroll
    for (int t = 0; t < 2; ++t) { const int row = rowbase + (fq >> 1) * HALF + (2 * (fq & 1) + t) * 16 + fr;
        const f32x4* p = (const f32x4*)(ssp + (size_t)row * 32); float sm = 0.f;
#pragma unroll
        for (int q = 0; q < 8; ++q) { const f32x4 v = p[q]; sm += (v.x + v.y) + (v.z + v.w); }
        mine[t] = 1.f / sqrtf(sm * (1.f / 2048.f) + 1e-6f); }
#pragma unroll
    for (int ai = 0; ai < 2; ++ai)
#pragma unroll
        for (int m = 0; m < 4; ++m) { const int src = (ai * 2 + (m >> 1)) * 16 + fr; const float a = __shfl(mine[0], src), b = __shfl(mine[1], src); rs[ai][m] = (m & 1) ? b : a; }
}
template <int ACT  , bool SCALE>
struct EpiStore {
    static constexpr bool PERM = true, AFTER_DRAIN = false;
    bf16_t* O; int ldc; const float* ssp;
    __device__ __forceinline__ void operator()(const f32x4 (&acc)[2][2][4][2], const Unit& u, int wr, int wc, int fr, int fq) const {
        const int row0 = u.pm * BM + wr * 64 + fr, col0 = u.pn * BM + wc * 32 + 8 * fq;
        float rs[2][4];
        if (SCALE) row_rstd(ssp, u.pm * BM + wr * 64, fr, fq, rs);
#pragma unroll
        for (int ai = 0; ai < 2; ++ai)
#pragma unroll
            for (int m = 0; m < 4; ++m) { bf16_t* rowp = O + (size_t)(row0 + ai * HALF + m * 16) * ldc + col0; const float r = SCALE ? rs[ai][m] : 1.f;
#pragma unroll
                for (int bj = 0; bj < 2; ++bj) { f32x4 v0 = acc[ai][bj][m][0] * r, v1 = acc[ai][bj][m][1] * r;
                    if (ACT == 1) {
#pragma unroll
                        for (int e = 0; e < 4; ++e) { v0[e] = fmaxf(v0[e], 0.f); v0[e] *= v0[e]; v1[e] = fmaxf(v1[e], 0.f); v1[e] *= v1[e]; } }
                    u32x4 w; w.x = cvtpk(v0[0], v0[1]); w.y = cvtpk(v0[2], v0[3]); w.z = cvtpk(v1[0], v1[1]); w.w = cvtpk(v1[2], v1[3]);
                    *(u32x4*)(rowp + bj * HALF) = w; } }
    }
};
template <bool GATE  , bool FINAL  , bool SQ = false  >
struct EpiH {
    static constexpr bool PERM = true, AFTER_DRAIN = false;
    const bf16_t* hin; bf16_t* hout; float* sspo; const bf16_t* pp; const float* sspi; float* outf;
    __device__ __forceinline__ void operator()(const f32x4 (&acc)[2][2][4][2], const Unit& u, int wr, int wc, int fr, int fq) const {
        constexpr int ld = 2048;
        const int row0 = u.pm * BM + wr * 64 + fr, col0 = u.pn * BM + wc * 32 + 8 * fq;
        float rs[2][4];
        u32x4 rh[2][2], rp[2][2];
        { const size_t off = (size_t)row0 * ld + col0;
#pragma unroll
          for (int bj = 0; bj < 2; ++bj) { rh[0][bj] = *(const u32x4*)(hin + off + bj * HALF); if (GATE) rp[0][bj] = *(const u32x4*)(pp + off + bj * HALF); } }
        if (GATE || SQ) row_rstd(sspi, u.pm * BM + wr * 64, fr, fq, rs);
#pragma unroll
        for (int r = 0; r < 8; ++r) { const int ai = r >> 2, m = r & 3, cb = r & 1, nb = cb ^ 1;
            const int row = row0 + ai * HALF + m * 16; const size_t off = (size_t)row * ld + col0;
            if (r + 1 < 8) { const int ai2 = (r + 1) >> 2, m2 = (r + 1) & 3; const size_t off2 = (size_t)(row0 + ai2 * HALF + m2 * 16) * ld + col0;
#pragma unroll
                for (int bj = 0; bj < 2; ++bj) { rh[nb][bj] = *(const u32x4*)(hin + off2 + bj * HALF); if (GATE) rp[nb][bj] = *(const u32x4*)(pp + off2 + bj * HALF); } }
            float ss = 0.f;
#pragma unroll
            for (int bj = 0; bj < 2; ++bj) { const u32x4 hv = rh[cb][bj];
                f32x4 a = {bflo(hv.x), bfhi(hv.x), bflo(hv.y), bfhi(hv.y)}, b = {bflo(hv.z), bfhi(hv.z), bflo(hv.w), bfhi(hv.w)};
                const f32x4 v0 = acc[ai][bj][m][0], v1 = acc[ai][bj][m][1];
                if (GATE) { const u32x4 p = rp[cb][bj]; const float rr = rs[ai][m] * (-LOG2E);
                    const f32x4 p0 = {bflo(p.x), bfhi(p.x), bflo(p.y), bfhi(p.y)}, p1 = {bflo(p.z), bfhi(p.z), bflo(p.w), bfhi(p.w)};
#pragma unroll
                    for (int e = 0; e < 4; ++e) { a[e] += __builtin_amdgcn_rcpf(1.f + fexp2(rr * v0[e])) * p0[e]; b[e] += __builtin_amdgcn_rcpf(1.f + fexp2(rr * v1[e])) * p1[e]; }
                } else if (SQ) { const float r2 = rs[ai][m] * rs[ai][m]; a += v0 * r2; b += v1 * r2; }
                else { a += v0; b += v1; }
                if (FINAL) { *(f32x4*)(outf + off + bj * HALF) = a; *(f32x4*)(outf + off + bj * HALF + 4) = b; }
                else { u32x4 w; w.x = cvtpk(a[0], a[1]); w.y = cvtpk(a[2], a[3]); w.z = cvtpk(b[0], b[1]); w.w = cvtpk(b[2], b[3]);
                    *(u32x4*)(hout + off + bj * HALF) = w;
                    ss += (a[0] * a[0] + a[1] * a[1]) + (a[2] * a[2] + a[3] * a[3]) + (b[0] * b[0] + b[1] * b[1]) + (b[2] * b[2] + b[3] * b[3]); } }
            if (!FINAL) { ss += __shfl_xor(ss, 16); ss += __shfl_xor(ss, 32);
                if (fq == 0) sspo[(size_t)row * 32 + u.pn * 4 + wc] = ss; } }
    }
};
}

struct Args { const float* in[21]; float* out; unsigned char* ws; };
enum { I_X = 0, I_P, I_ATTN_NORM, I_WO, I_MLP_NORM, I_WUP, I_WDOWN, I_PLE_NORM, I_WGATE, I_WPLE, I_A_WIN, I_A_QN, I_A_KN, I_B_WIN, I_B_QN, I_B_KN, I_B_IKN, I_C_WIN, I_C_BF, I_C_QN, I_C_KN };

__device__ __forceinline__ void transpose_item(const float* W, const float* gain, int K, int N, bf16* WT, int kb, int nb, int lane) {
    const int k0 = 64 * kb, n = 64 * nb + lane; const bool ok = n < N;
    const float* src = W + (size_t)k0 * N + (ok ? n : 0);
    float v[64];
#pragma unroll
    for (int r = 0; r < 64; ++r) v[r] = src[(size_t)r * N];
    if (gain) {
#pragma unroll
        for (int r = 0; r < 64; ++r) v[r] *= gain[k0 + r];
    }
    bf16* dst = WT + (size_t)n * K + k0;
#pragma unroll
    for (int c = 0; c < 8; ++c) { v4u o;
        o.x = ok ? cvtpk(v[8 * c + 0], v[8 * c + 1]) : 0u; o.y = ok ? cvtpk(v[8 * c + 2], v[8 * c + 3]) : 0u; o.z = ok ? cvtpk(v[8 * c + 4], v[8 * c + 5]) : 0u; o.w = ok ? cvtpk(v[8 * c + 6], v[8 * c + 7]) : 0u;
        *(v4u*)(dst + 8 * c) = o; }
}
__device__ __forceinline__ void convert_weight(const float* W, const float* gain, int K, int N, int Npad, bf16* WT, LAS float* scr, int gw, int ngw, int lane) {
    const int nblk = Npad / 64, nitems = (K / 64) * nblk;
    for (int it = gw; it < nitems; it += ngw) transpose_item(W, gain, K, N, WT, it / nblk, it % nblk, lane);
}
__device__ __forceinline__ void x_rows(const float* src, bf16* hb, float* ssp, int gw, int ngw, int lane) {
    for (int m = gw; m < M; m += ngw) {
        const f32x4* xr = (const f32x4*)(src + (size_t)m * D) + lane;
        f32x4 v[8]; float ss = 0.f;
#pragma unroll
        for (int j = 0; j < 8; ++j) { v[j] = xr[64 * j]; ss += (v[j].x * v[j].x + v[j].y * v[j].y) + (v[j].z * v[j].z + v[j].w * v[j].w); }
        ss = wave_sum(ss);
        unsigned long long* o8 = (unsigned long long*)(hb + (size_t)m * D) + lane;
#pragma unroll
        for (int j = 0; j < 8; ++j) o8[64 * j] = (unsigned long long)cvtpk(v[j].x, v[j].y) | ((unsigned long long)cvtpk(v[j].z, v[j].w) << 32);
        if (lane < 32) ssp[(size_t)m * 32 + lane] = lane == 0 ? ss : 0.f;
    }
}

__device__ __forceinline__ void rmsnorm_rows(const float* src, const float* g, bf16* dst, int gw, int ngw, int lane) {
    for (int m = gw; m < M; m += ngw) {
        const f32x4* xr = (const f32x4*)(src + (size_t)m * D) + lane;
        f32x4 v[8]; float ss = 0.f;
#pragma unroll
        for (int j = 0; j < 8; ++j) { v[j] = xr[64 * j]; ss += (v[j].x * v[j].x + v[j].y * v[j].y) + (v[j].z * v[j].z + v[j].w * v[j].w); }
        const float rstd = 1.f / sqrtf(wave_sum(ss) * (1.f / D) + RMS_EPS);
        unsigned long long* o8 = (unsigned long long*)(dst + (size_t)m * D) + lane;
#pragma unroll
        for (int j = 0; j < 8; ++j) { const f32x4 gg = ((const f32x4*)g)[lane + 64 * j];
            o8[64 * j] = (unsigned long long)cvtpk(v[j].x * rstd * gg.x, v[j].y * rstd * gg.y) | ((unsigned long long)cvtpk(v[j].z * rstd * gg.z, v[j].w * rstd * gg.w) << 32); }
    }
}

template <bool ROPE>
__device__ __forceinline__ void head128_norm(bf16* p, const u32x4 raw, const float a  , const float* gain, float scale, const float2* rope, int lane, unsigned char* f8out = nullptr) {
    float x[8] = {bflo(raw.x), bfhi(raw.x), bflo(raw.y), bfhi(raw.y), bflo(raw.z), bfhi(raw.z), bflo(raw.w), bfhi(raw.w)};
    float ss = 0.f;
#pragma unroll
    for (int e = 0; e < 8; ++e) ss += x[e] * x[e];
    ss += __shfl_xor(ss, 1); ss += __shfl_xor(ss, 2); ss += __shfl_xor(ss, 4); ss += __shfl_xor(ss, 8);
    const float rstd = a / sqrtf(a * a * ss * (1.f / 128.f) + RMS_EPS);
    const int lh = lane & 15;
    const f32x4 g0 = *(const f32x4*)(gain + 8 * lh), g1 = *(const f32x4*)(gain + 8 * lh + 4);
    const float gg[8] = {g0.x, g0.y, g0.z, g0.w, g1.x, g1.y, g1.z, g1.w};
#pragma unroll
    for (int e = 0; e < 8; ++e) x[e] = x[e] * rstd * gg[e];
    if (ROPE) {
        float px[8];
#pragma unroll
        for (int e = 0; e < 8; ++e) px[e] = __shfl_xor(x[e], 2);
        if (lh < 4) {
#pragma unroll
            for (int e = 0; e < 8; ++e) { const float2 cs = rope[8 * (lh & 1) + e];
                x[e] = (lh < 2) ? (x[e] * cs.x - px[e] * cs.y) : (px[e] * cs.y + x[e] * cs.x); }
        }
    }
    if (f8out) {
        int w0 = 0, w1 = 0;
        w0 = __builtin_amdgcn_cvt_pk_fp8_f32(x[0] * scale, x[1] * scale, w0, false); w0 = __builtin_amdgcn_cvt_pk_fp8_f32(x[2] * scale, x[3] * scale, w0, true);
        w1 = __builtin_amdgcn_cvt_pk_fp8_f32(x[4] * scale, x[5] * scale, w1, false); w1 = __builtin_amdgcn_cvt_pk_fp8_f32(x[6] * scale, x[7] * scale, w1, true);
        *(u32x2*)f8out = (u32x2){(unsigned)w0, (unsigned)w1};
    } else {
        u32x4 w; w.x = cvtpk(x[0] * scale, x[1] * scale); w.y = cvtpk(x[2] * scale, x[3] * scale); w.z = cvtpk(x[4] * scale, x[5] * scale); w.w = cvtpk(x[6] * scale, x[7] * scale);
        *(u32x4*)p = w;
    }
}
template <bool NORM>
__device__ __forceinline__ void head64_rope(bf16* p, const u32x4 raw, const float a, const float* gain, const float2* rope, int lane, bool active) {
    float x[8] = {bflo(raw.x) * a, bfhi(raw.x) * a, bflo(raw.y) * a, bfhi(raw.y) * a, bflo(raw.z) * a, bfhi(raw.z) * a, bflo(raw.w) * a, bfhi(raw.w) * a};
    const int li = lane & 7;
    if (NORM) {
        float ss = 0.f;
#pragma unroll
        for (int e = 0; e < 8; ++e) ss += x[e] * x[e];
        ss += __shfl_xor(ss, 1); ss += __shfl_xor(ss, 2); ss += __shfl_xor(ss, 4);
        const float rstd = 1.f / sqrtf(ss * (1.f / 64.f) + RMS_EPS);
        const f32x4 g0 = *(const f32x4*)(gain + 8 * li), g1 = *(const f32x4*)(gain + 8 * li + 4);
        const float gg[8] = {g0.x, g0.y, g0.z, g0.w, g1.x, g1.y, g1.z, g1.w};
#pragma unroll
        for (int e = 0; e < 8; ++e) x[e] = x[e] * rstd * gg[e];
    }
    float px[8];
#pragma unroll
    for (int e = 0; e < 8; ++e) px[e] = __shfl_xor(x[e], 1);
    if (li < 2) {
#pragma unroll
        for (int e = 0; e < 8; ++e) { const float2 cs = rope[e];
            x[e] = (li == 0) ? (x[e] * cs.x - px[e] * cs.y) : (px[e] * cs.y + x[e] * cs.x); }
    }
    if (active) { u32x4 w; w.x = cvtpk(x[0], x[1]); w.y = cvtpk(x[2], x[3]); w.z = cvtpk(x[4], x[5]); w.w = cvtpk(x[6], x[7]); *(u32x4*)p = w; }
}

__device__ __forceinline__ void vt_item(const bf16* proj, int ldp, int voff, const float* rstdv, bf16* VT, LAS unsigned char* tile, int item, int lane) {
    const int h = item & 15, tc = (item >> 4) & 255, b = item >> 12;
    const size_t row0 = (size_t)b * SEQ + 32 * tc;
#pragma unroll
    for (int i = 0; i < 8; ++i) { const int tok = 4 * i + (lane >> 4), ch = lane & 15;
        const u32x4 v = *(const u32x4*)(proj + (row0 + tok) * ldp + voff + h * 128 + ch * 8); const float a = rstdv[row0 + tok];
        LAS u32x2* d = (LAS u32x2*)(tile + tok * 264 + ch * 16);
        d[0] = (u32x2){cvtpk(bflo(v.x) * a, bfhi(v.x) * a), cvtpk(bflo(v.y) * a, bfhi(v.y) * a)}; d[1] = (u32x2){cvtpk(bflo(v.z) * a, bfhi(v.z) * a), cvtpk(bflo(v.w) * a, bfhi(v.w) * a)}; }
    LDS_WAIT(); asm volatile("" ::: "memory");
#pragma unroll
    for (int i = 0; i < 8; ++i) { const int d = 16 * i + (lane >> 2), tg = lane & 3;
        const LAS unsigned short* s = (const LAS unsigned short*)(tile + (8 * tg) * 264 + d * 2);
        u32x4 w; w.x = (unsigned)s[0] | ((unsigned)s[132] << 16); w.y = (unsigned)s[2 * 132] | ((unsigned)s[3 * 132] << 16);
        w.z = (unsigned)s[4 * 132] | ((unsigned)s[5 * 132] << 16); w.w = (unsigned)s[6 * 132] | ((unsigned)s[7 * 132] << 16);
        *(u32x4*)(VT + ((size_t)(b * 16 + h) * 128 + d) * SEQ + 32 * tc + 8 * tg) = w; }
    LDS_WAIT(); asm volatile("" ::: "memory");
}

__device__ __forceinline__ void cumchunk_item(const bf16* proj, int ldp, const float* rstdv, const float* bfv, float* cum2, float* tot, int item, int lane) {
    const int b = item >> 7, ch = item & 127; const int t = 64 * ch + lane;
    const bf16* gp = proj + ((size_t)b * SEQ + t) * ldp + 3 * D;
    const u32x4 g0 = *(const u32x4*)gp, g1 = *(const u32x4*)(gp + 8);
    const float x[16] = {bflo(g0.x), bfhi(g0.x), bflo(g0.y), bfhi(g0.y), bflo(g0.z), bfhi(g0.z), bflo(g0.w), bfhi(g0.w), bflo(g1.x), bfhi(g1.x), bflo(g1.y), bfhi(g1.y), bflo(g1.z), bfhi(g1.z), bflo(g1.w), bfhi(g1.w)};
    const float a = rstdv[(size_t)b * SEQ + t];
#pragma unroll
    for (int h = 0; h < 16; ++h) { const float y = x[h] * a + bfv[h];
        float lf = -(fmaxf(-y, 0.f) + log1pf(expf(-fabsf(y)))) * LOG2E;
#pragma unroll
        for (int o = 1; o < 64; o <<= 1) { const float u = __shfl_up(lf, o); if (lane >= o) lf += u; }
        cum2[((size_t)(b * 16 + h)) * SEQ + t] = lf;
        if (lane == 63) tot[(b * 16 + h) * 128 + ch] = lf; }
}

#define MFMA32(a, b, c) __builtin_amdgcn_mfma_f32_32x32x16_bf16((a), (b), (c), 0, 0, 0)
#define MFMA16(a, b, c) __builtin_amdgcn_mfma_f32_16x16x32_bf16((a), (b), (c), 0, 0, 0)
template <int MODE>
__device__ __forceinline__ void attn_dense_item(const bf16* proj, int ldp, const bf16* VT, const float* cum2, bf16* mix, float zb2, int qt, int bh, int lane) {
    const int b = bh >> 4, h = bh & 15;
    const int n = lane & 31, hi = lane >> 5, q0 = 32 * qt;
    const size_t row0 = (size_t)b * SEQ;
    const int prow = (n & 0x13) | ((n & 4) << 1) | ((n & 8) >> 1);
    bf16x8 qf[8];
    { const bf16* qp = proj + (row0 + q0 + n) * ldp + h * 128 + hi * 8;
#pragma unroll
      for (int kk = 0; kk < 8; ++kk) qf[kk] = *(const bf16x8*)(qp + kk * 16); }
    f32x16 o[4];
#pragma unroll
    for (int d = 0; d < 4; ++d)
#pragma unroll
        for (int i = 0; i < 16; ++i) o[d][i] = 0.f;
    float R = 0.f, mrun = -1e30f, lrun = 0.f, cq = 0.f;
    const float* cb = cum2 + (size_t)bh * SEQ;
    if (MODE == 1) cq = cb[q0 + n];
    const int tq = q0 + n;
    const bf16* kbase = proj + (row0 + prow) * ldp + D + h * 128 + hi * 8;
    bf16x8 kf[8];
#pragma unroll
    for (int kk = 0; kk < 8; ++kk) kf[kk] = *(const bf16x8*)(kbase + (size_t)q0 * ldp + kk * 16);
    for (int kb = q0; kb >= 0; kb -= 32) {
        if (MODE == 0) { if (__all(R + zb2 < ZERO_LOG2)) break; }
        else { const float dmax = cb[q0] - cb[kb + 31]; if (dmax + 2.f * zb2 < ZERO_LOG2) break; }
        bf16x8 vf[4][2];
#pragma unroll
        for (int d = 0; d < 4; ++d)
#pragma unroll
            for (int s = 0; s < 2; ++s) vf[d][s] = *(const bf16x8*)(VT + ((size_t)bh * 128 + d * 32 + n) * SEQ + kb + 16 * s + 8 * hi);
        f32x16 sc;
#pragma unroll
        for (int i = 0; i < 16; ++i) sc[i] = 0.f;
#pragma unroll
        for (int kk = 0; kk < 8; ++kk) sc = MFMA32(kf[kk], qf[kk], sc);
        if (kb >= 32) {
#pragma unroll
            for (int kk = 0; kk < 8; ++kk) kf[kk] = *(const bf16x8*)(kbase + (size_t)(kb - 32) * ldp + kk * 16);
        }
        const bool diag = (kb == q0);
        float w[16];
        if (MODE == 0) {
            float L[16];
#pragma unroll
            for (int i = 0; i < 16; ++i) { const int key = kb + 16 * (i >> 3) + 8 * hi + (i & 7);
                const bool valid = !diag || (key < tq);
                L[i] = valid ? -flog2(1.f + fexp2(sc[i])) : 0.f; }
            float G0 = 0.f, G1 = 0.f;
#pragma unroll
            for (int j = 0; j < 8; ++j) { G0 += L[j]; G1 += L[8 + j]; }
            const float Gp0 = __shfl_xor(G0, 32), Gp1 = __shfl_xor(G1, 32);
            const float pre1 = hi ? R : (R + Gp1);
            const float pre0 = hi ? (R + G1 + Gp1) : (R + Gp1 + G1 + Gp0);
            float c = pre1;
#pragma unroll
            for (int j = 7; j >= 0; --j) { c += L[8 + j]; const int key = kb + 16 + 8 * hi + j; w[8 + j] = (!diag || key < tq) ? fexp2(sc[8 + j] + c) : 0.f; }
            c = pre0;
#pragma unroll
            for (int j = 7; j >= 0; --j) { c += L[j]; const int key = kb + 8 * hi + j; w[j] = (!diag || key < tq) ? fexp2(sc[j] + c) : 0.f; }
            R += (G0 + G1) + (Gp0 + Gp1);
        } else {
            float lg[16]; float bm = -3e38f;
#pragma unroll
            for (int s = 0; s < 2; ++s) { const f32x4 c0 = *(const f32x4*)(cb + kb + 16 * s + 8 * hi), c1 = *(const f32x4*)(cb + kb + 16 * s + 8 * hi + 4);
                const float ck[8] = {c0.x, c0.y, c0.z, c0.w, c1.x, c1.y, c1.z, c1.w};
#pragma unroll
                for (int j = 0; j < 8; ++j) { const int i = 8 * s + j, key = kb + 16 * s + 8 * hi + j;
                    const float v = sc[i] + (cq - ck[j]);
                    lg[i] = (!diag || key <= tq) ? v : -3e38f; bm = fmaxf(bm, lg[i]); } }
            bm = fmaxf(bm, __shfl_xor(bm, 32));
            const float mn = fmaxf(mrun, bm), alpha = fexp2(mrun - mn);
            mrun = mn;
            float ps = 0.f;
#pragma unroll
            for (int i = 0; i < 16; ++i) { w[i] = fexp2(lg[i] - mn); ps += w[i]; }
            lrun = lrun * alpha + ps;
#pragma unroll
            for (int d = 0; d < 4; ++d)
#pragma unroll
                for (int i = 0; i < 16; ++i) o[d][i] *= alpha;
        }
        bf16x8 pf[2];
#pragma unroll
        for (int s = 0; s < 2; ++s) { u32x4 t; t.x = cvtpk(w[8 * s + 0], w[8 * s + 1]); t.y = cvtpk(w[8 * s + 2], w[8 * s + 3]); t.z = cvtpk(w[8 * s + 4], w[8 * s + 5]); t.w = cvtpk(w[8 * s + 6], w[8 * s + 7]);
            pf[s] = __builtin_bit_cast(bf16x8, t); }
#pragma unroll
        for (int d = 0; d < 4; ++d)
#pragma unroll
            for (int s = 0; s < 2; ++s) o[d] = MFMA32(vf[d][s], pf[s], o[d]);
    }
    float inv = 1.f;
    if (MODE == 1) { const float lt = lrun + __shfl_xor(lrun, 32); inv = 1.f / lt; }
    bf16* op = mix + (row0 + q0 + n) * (size_t)D + h * 128 + 4 * hi;
#pragma unroll
    for (int d = 0; d < 4; ++d)
#pragma unroll
        for (int g = 0; g < 4; ++g) { u32x2 t; t.x = cvtpk(o[d][4 * g] * inv, o[d][4 * g + 1] * inv); t.y = cvtpk(o[d][4 * g + 2] * inv, o[d][4 * g + 3] * inv);
            *(u32x2*)(op + d * 32 + 8 * g) = t; }
}

constexpr int DL_SEL = 0, DL_MISC = 16384, DL_HIST = 17408, DL_CAND = DL_HIST + 8 * 8192, DL_P = DL_CAND + 8 * 512, DL_INVL = DL_P + 8 * 4096, DL_MM = DL_INVL + 8 * 16, DL_END = DL_MM + 8 * 128;
static_assert(DL_END <= RING_BYTES, "DSA LDS map");
constexpr int NBIN = 2048;

__device__ __forceinline__ int tk_bin(float x, float lo, float inv) { int bb = (int)((x - lo) * inv); return bb > NBIN - 1 ? NBIN - 1 : (bb < 0 ? 0 : bb); }
__device__ __forceinline__ void topk_row(const float* S, int c, float lo, float hi  , LAS unsigned short* sel, LAS unsigned* hist, LAS float* cval, LAS int* cidx, int lane) {
    const f32x4* S4 = (const f32x4*)S; const int c4 = c >> 2;
    int kk = 256, mc = c;
    bool usebin = false; float blo = 0.f, binv = 0.f; int bsel = 0;
    for (int level = 0; level < 48; ++level) {
        if (lo == hi || mc <= 64) break;
#pragma unroll
        for (int j = 0; j < NBIN / 64; ++j) hist[lane + 64 * j] = 0u;
        const float inv = (float)NBIN / (hi - lo);
        for (int i0 = 0; i0 < c4; i0 += 512) { f32x4 vb[8];
#pragma unroll
            for (int u = 0; u < 8; ++u) { const int i = i0 + 64 * u + lane; vb[u] = S4[i < c4 ? i : lane]; }
#pragma unroll
            for (int u = 0; u < 8; ++u) { const bool inr = (i0 + 64 * u + lane) < c4;
#pragma unroll
                for (int e = 0; e < 4; ++e) { const float x = vb[u][e]; if (inr && x >= lo && x <= hi) __hip_atomic_fetch_add(&hist[tk_bin(x, lo, inv)], 1u, __ATOMIC_RELAXED, __HIP_MEMORY_SCOPE_WORKGROUP); } } }
        LDS_WAIT(); asm volatile("" ::: "memory");
        unsigned own = 0u;
#pragma unroll
        for (int j = 0; j < 32; ++j) own += hist[32 * lane + j];
        unsigned suf = own;
#pragma unroll
        for (int o = 1; o < 64; o <<= 1) { const unsigned u = __shfl_down(suf, o); if (lane + o < 64) suf += u; }
        const unsigned long long pm = __ballot(suf >= (unsigned)kk);
        const int Ln = 63 - __builtin_clzll(pm);
        const unsigned above = __shfl(suf - own, Ln);
        const int k2 = kk - (int)above;
        int bs = 0, kn = 1, mn = 1;
        { unsigned acc = 0u; bool found = false;
          for (int j = 31; j >= 0; --j) { const unsigned hc = hist[32 * Ln + j]; if (!found && acc + hc >= (unsigned)k2) { bs = 32 * Ln + j; kn = k2 - (int)acc; mn = (int)hc; found = true; } if (!found) acc += hc; } }
        kk = kn; mc = mn;
        if (mc <= 64) { usebin = true; blo = lo; binv = inv; bsel = bs; break; }
        float nlo = 3e38f, nhi = -3e38f;
        for (int i0 = 0; i0 < c4; i0 += 256) { f32x4 vb[4];
#pragma unroll
            for (int u = 0; u < 4; ++u) { const int i = i0 + 64 * u + lane; vb[u] = S4[i < c4 ? i : lane]; }
#pragma unroll
            for (int u = 0; u < 4; ++u) { const bool inr = (i0 + 64 * u + lane) < c4;
#pragma unroll
                for (int e = 0; e < 4; ++e) { const float x = vb[u][e]; if (inr && x >= lo && x <= hi && tk_bin(x, lo, inv) == bs) { nlo = fminf(nlo, x); nhi = fmaxf(nhi, x); } } } }
        lo = wave_min(nlo); hi = wave_max(nhi);
    }
    const bool tie = !usebin && (lo == hi);
    const int base = 256 - kk;
    int nout = 0, ncand = 0;
    const unsigned long long ltmask = (1ull << lane) - 1ull;
    for (int j0 = 0; j0 < c4; j0 += 512) { f32x4 vb[8];
#pragma unroll
      for (int u = 0; u < 8; ++u) { const int i = j0 + 64 * u + lane; vb[u] = S4[i < c4 ? i : lane]; }
#pragma unroll
      for (int u = 0; u < 8; ++u) { const int i4 = j0 + 64 * u; if (i4 >= c4) break;
        bool gt[4], cd[4]; int glow = 0, clow = 0, gtot = 0, ctot = 0;
#pragma unroll
        for (int e = 0; e < 4; ++e) { const float x = vb[u][e]; const bool inr = (x >= lo) && (x <= hi);
            if (usebin) { const int bb = tk_bin(x, blo, binv); gt[e] = (x > hi) || (inr && bb > bsel); cd[e] = inr && bb == bsel; }
            else { gt[e] = x > hi; cd[e] = inr; }
            const unsigned long long gm = __ballot(gt[e]), cm = __ballot(cd[e]);
            glow += __builtin_popcountll(gm & ltmask); gtot += __builtin_popcountll(gm); clow += __builtin_popcountll(cm & ltmask); ctot += __builtin_popcountll(cm); }
        int gpos = nout + glow, cpos = ncand + clow;
#pragma unroll
        for (int e = 0; e < 4; ++e) { const int idx = 4 * (i4 + lane) + e;
            if (gt[e]) { if (gpos < 256) sel[gpos] = (unsigned short)idx; ++gpos; }
            if (cd[e]) { if (tie) { if (cpos < kk) sel[base + cpos] = (unsigned short)idx; } else if (cpos < 64) { cval[cpos] = vb[u][e]; cidx[cpos] = idx; } ++cpos; } }
        nout += gtot; ncand += ctot;
      } }
    if (!tie) {
        LDS_WAIT(); asm volatile("" ::: "memory");
        const int nc = ncand < 64 ? ncand : 64;
        const float mv = lane < nc ? cval[lane] : 0.f; const int mi = lane < nc ? cidx[lane] : 0;
        int rank = 0;
        for (int i = 0; i < nc; ++i) { const float v = cval[i]; rank += (v > mv || (v == mv && i < lane)) ? 1 : 0; }
        if (lane < nc && rank < kk) sel[base + rank] = (unsigned short)mi;
    }
    LDS_WAIT(); asm volatile("" ::: "memory");
}

__device__ __forceinline__ void dsa_unit(const bf16* proj, const unsigned char* q8, const unsigned char* k8, const unsigned char* v8, bf16* mix, float* scr, LAS unsigned char* lds, int unit, int tid) {
    constexpr int ldp = NB_PAD;
    const int lane = tid & 63, wave = __builtin_amdgcn_readfirstlane(tid >> 6);
    const int tile = 255 - (unit >> 2), b = unit & 3, t0 = 32 * tile, c = ((t0 >> 6) + 1) << 6;
    const size_t row0 = (size_t)b * SEQ;
    LAS unsigned short* sel = (LAS unsigned short*)(lds + DL_SEL);
#ifdef PROBE_DSA
    unsigned long long td0_ = __builtin_amdgcn_s_memrealtime();
#define DSA_PT(st) do { const unsigned long long n_ = __builtin_amdgcn_s_memrealtime(); if (tid == 0 && (st) == PROBE_DSA) { volatile LAS unsigned long long* pe_ = (volatile LAS unsigned long long*)(lds + MISC_OFF + 64); pe_[0] = pe_[0] + (n_ - td0_); } td0_ = n_; } while (0)
#else
#define DSA_PT(st) do { } while (0)
#endif
#ifndef DSA_NO_A
    if (c > 256) {
        int lane_a = lane; asm volatile("" : "+v"(lane_a));
        const int qg = wave & 1, kpart = wave >> 1, ql = lane_a & 15, kq = lane_a >> 4;
        const bf16* qrow = proj + (row0 + t0 + 16 * qg + ql) * ldp;
#pragma unroll 1
        for (int hp = 0; hp < 2; ++hp) {
            bf16x8 qif[8][2];
#pragma unroll
            for (int hh = 0; hh < 8; ++hh)
#pragma unroll
                for (int kk = 0; kk < 2; ++kk) qif[hh][kk] = *(const bf16x8*)(qrow + B_QI + (8 * hp + hh) * 64 + kk * 32 + kq * 8);
            float wv[8];
            { const u32x4 w0 = *(const u32x4*)(qrow + B_WI + 8 * hp);
              wv[0] = bflo(w0.x); wv[1] = bfhi(w0.x); wv[2] = bflo(w0.y); wv[3] = bfhi(w0.y); wv[4] = bflo(w0.z); wv[5] = bfhi(w0.z); wv[6] = bflo(w0.w); wv[7] = bfhi(w0.w); }
            bf16x8 kring[3][2][2]; f32x4 sring[3][2];
            const bf16* kibase = proj + (row0 + ql) * ldp + B_KI + kq * 8;
            float* sbase = scr + (size_t)(16 * qg + ql) * c + 4 * kq;
#define IDX_LOAD(SL, KB0) do { _Pragma("unroll") for (int u = 0; u < 2; ++u) { const int kb = (KB0) + 64 * u; const int kbc = kb < c ? kb : 16 * kpart; \
                    const bf16* kr = kibase + (size_t)kbc * ldp; \
                    kring[SL][u][0] = *(const bf16x8*)kr; kring[SL][u][1] = *(const bf16x8*)(kr + 32); \
                    sring[SL][u] = (f32x4){0.f, 0.f, 0.f, 0.f}; \
                    if (hp) sring[SL][u] = *(const f32x4*)(sbase + kbc); } } while (0)
#define IDX_COMP(SL, KB0) do { _Pragma("unroll") for (int u = 0; u < 2; ++u) { const int kb = (KB0) + 64 * u; \
                    if (kb < c) { f32x2_t s01 = {sring[SL][u][0], sring[SL][u][1]}, s23 = {sring[SL][u][2], sring[SL][u][3]}; \
                        _Pragma("unroll") for (int hh = 0; hh < 8; ++hh) { f32x4 d = {0.f, 0.f, 0.f, 0.f}; d = MFMA16(kring[SL][u][0], qif[hh][0], d); d = MFMA16(kring[SL][u][1], qif[hh][1], d); \
                            const f32x2_t w2 = {wv[hh], wv[hh]}; \
                            s01 = __builtin_elementwise_fma((f32x2_t){relu_raw(d[0]), relu_raw(d[1])}, w2, s01); s23 = __builtin_elementwise_fma((f32x2_t){relu_raw(d[2]), relu_raw(d[3])}, w2, s23); } \
                        const f32x4 sacc = {s01.x, s01.y, s23.x, s23.y}; \
                        *(f32x4*)(sbase + kb) = sacc; \
                        smin = fminf(smin, fminf(fminf(sacc[0], sacc[1]), fminf(sacc[2], sacc[3]))); smax = fmaxf(smax, fmaxf(fmaxf(sacc[0], sacc[1]), fmaxf(sacc[2], sacc[3]))); } } } while (0)
            float smin = 3e38f, smax = -3e38f;
            const int kbs = 16 * kpart;
            IDX_LOAD(0, kbs); IDX_LOAD(1, kbs + 128);
#pragma unroll 1
            for (int kb0 = kbs; kb0 < c; kb0 += 384) {
                IDX_LOAD(2, kb0 + 256); IDX_COMP(0, kb0);
                IDX_LOAD(0, kb0 + 384); IDX_COMP(1, kb0 + 128);
                IDX_LOAD(1, kb0 + 512); IDX_COMP(2, kb0 + 256);
            }
#undef IDX_COMP
#undef IDX_LOAD
            if (hp) {
                smin = fminf(smin, __shfl_xor(smin, 16)); smin = fminf(smin, __shfl_xor(smin, 32)); smax = fmaxf(smax, __shfl_xor(smax, 16)); smax = fmaxf(smax, __shfl_xor(smax, 32));
                if (lane < 16) { LAS float* mm = (LAS float*)(lds + DL_MM) + (wave * 16 + lane) * 2; mm[0] = smin; mm[1] = smax; }
            }
        }
    }
#endif
    __syncthreads(); DSA_PT(0);
    __builtin_amdgcn_fence(__ATOMIC_ACQUIRE, "agent");
    asm volatile("s_waitcnt vmcnt(0)" ::: "memory");
#ifndef DSA_NO_B
    LAS int* nselp = (LAS int*)(lds + DL_MISC);
    for (int qi = 0; qi < 4; ++qi) { const int ql = 4 * wave + qi;
        LAS unsigned short* s = sel + ql * 256;
        if (c > 256) { const LAS float* mm = (const LAS float*)(lds + DL_MM);
            float lo = 3e38f, hi = -3e38f;
#pragma unroll
            for (int kp = 0; kp < 4; ++kp) { const int w2 = (ql >> 4) + 2 * kp; lo = fminf(lo, mm[(w2 * 16 + (ql & 15)) * 2]); hi = fmaxf(hi, mm[(w2 * 16 + (ql & 15)) * 2 + 1]); }
            topk_row(scr + (size_t)ql * c, c, lo, hi, s, (LAS unsigned*)(lds + DL_HIST + wave * 8192), (LAS float*)(lds + DL_CAND + wave * 512), (LAS int*)(lds + DL_CAND + wave * 512 + 256), lane); }
        else { for (int i = lane; i < c; i += 64) s[i] = (unsigned short)i; }
    }
#endif
    const int nsel = c > 256 ? 256 : c;
    LDS_WAIT(); asm volatile("" ::: "memory"); DSA_PT(1);
#ifndef DSA_NO_C
    LAS unsigned short* Pb = (LAS unsigned short*)(lds + DL_P + wave * 4096);
    LAS unsigned char* vt = lds + DL_HIST + wave * 8192;
    LAS float* invl = (LAS float*)(lds + DL_INVL + wave * 16);
    for (int pi = 0; pi < 16; ++pi) { const int pr = 16 * wave + pi, ql = pr >> 2, g = pr & 3;
        const LAS unsigned short* s = sel + ql * 256;
        const size_t qrow = row0 + t0 + ql;
        int lane_c = lane; asm volatile("" : "+v"(lane_c));
        const int r = lane_c & 15, kq = lane_c >> 4;
        long qf[4];
#pragma unroll
        for (int kk = 0; kk < 4; ++kk) { qf[kk] = 0; if (r < 4) qf[kk] = *(const long*)(q8 + qrow * 2048 + (g * 4 + r) * 128 + kq * 32 + kk * 8); }
        f32x4 lg[16]; float mx = -3e38f;
#pragma unroll
        for (int g8 = 0; g8 < 2; ++g8) {
            if (g8 * 128 < nsel) {
                long kfr[8][4];
#pragma unroll
                for (int u = 0; u < 8; ++u) { const int key = ((g8 * 128 + u * 16) < nsel) ? s[g8 * 128 + u * 16 + r] : 0;
                    const unsigned char* kr = k8 + (row0 + key) * 512 + g * 128 + kq * 32;
                    const u32x4 ka = *(const u32x4*)kr, kb2 = *(const u32x4*)(kr + 16);
                    kfr[u][0] = (long)(((unsigned long long)ka.y << 32) | ka.x); kfr[u][1] = (long)(((unsigned long long)ka.w << 32) | ka.z);
                    kfr[u][2] = (long)(((unsigned long long)kb2.y << 32) | kb2.x); kfr[u][3] = (long)(((unsigned long long)kb2.w << 32) | kb2.z); }
#pragma unroll
                for (int u = 0; u < 8; ++u) { f32x4 d = {0.f, 0.f, 0.f, 0.f};
#pragma unroll
                    for (int kk = 0; kk < 4; ++kk) d = __builtin_amdgcn_mfma_f32_16x16x32_fp8_fp8(kfr[u][kk], qf[kk], d, 0, 0, 0);
                    const bool live = (g8 * 128 + u * 16) < nsel;
                    if (!live) d = (f32x4){-3e38f, -3e38f, -3e38f, -3e38f};
                    lg[g8 * 8 + u] = d; mx = fmaxf(mx, fmaxf(fmaxf(d[0], d[1]), fmaxf(d[2], d[3]))); }
            } else {
#pragma unroll
                for (int u = 0; u < 8; ++u) lg[g8 * 8 + u] = (f32x4){-3e38f, -3e38f, -3e38f, -3e38f};
            }
        }
        mx = fmaxf(mx, __shfl_xor(mx, 16)); mx = fmaxf(mx, __shfl_xor(mx, 32));
        float ls = 0.f;
#pragma unroll
        for (int blk = 0; blk < 16; ++blk) {
            if (blk * 16 < nsel) {
#pragma unroll
                for (int e = 0; e < 4; ++e) { const float p = fexp2((lg[blk][e] - mx) * 0.125f); ls += p; if (r < 4) Pb[r * 256 + blk * 16 + 4 * kq + e] = (unsigned short)(cvtpk(p, p) & 0xffffu); } }
        }
        ls += __shfl_xor(ls, 16); ls += __shfl_xor(ls, 32);
        if (lane < 4) invl[lane] = 1.f / ls;
        LDS_WAIT(); asm volatile("" ::: "memory");
        const int ks = lane_c >> 4, dc = lane_c & 15;
        f32x4 oacc[8];
#pragma unroll
        for (int cb = 0; cb < 8; ++cb) oacc[cb] = (f32x4){0.f, 0.f, 0.f, 0.f};
        const unsigned tq_ = (unsigned)(lane_c & 15) >> 2, tp_ = (unsigned)lane_c & 3u;
        u32x2 vn[16];
#define DSA_LOADV(I0) do { _Pragma("unroll") for (int u = 0; u < 16; ++u) { const int key = s[4 * ((I0) + u) + ks]; vn[u] = *(const u32x2*)(v8 + (row0 + key) * 512 + g * 128 + dc * 8); } } while (0)
        DSA_LOADV(0);
        for (int i0 = 0; i0 < nsel / 4; i0 += 16) {
            u32x2 v[16];
#pragma unroll
            for (int u = 0; u < 16; ++u) v[u] = vn[u];
            if (i0 + 16 < nsel / 4) DSA_LOADV(i0 + 16);
#pragma unroll
            for (int half = 0; half < 2; ++half) {
#pragma unroll
                for (int uu = 0; uu < 8; ++uu) { const int u = 8 * half + uu; const unsigned row = 4u * uu + (unsigned)ks;
                    const f32x2_t a0 = __builtin_amdgcn_cvt_pk_f32_fp8((int)v[u].x, false), a1 = __builtin_amdgcn_cvt_pk_f32_fp8((int)v[u].x, true), a2 = __builtin_amdgcn_cvt_pk_f32_fp8((int)v[u].y, false), a3 = __builtin_amdgcn_cvt_pk_f32_fp8((int)v[u].y, true);
                    u32x4 w; w.x = cvtpk(a0.x, a0.y); w.y = cvtpk(a1.x, a1.y); w.z = cvtpk(a2.x, a2.y); w.w = cvtpk(a3.x, a3.y);
                    *(LAS u32x4*)(vt + 256u * row + 16u * ((unsigned)dc ^ (((row & 3u) << 2) | ((row >> 2) & 3u)))) = w; }
                asm volatile("" ::: "memory");
                bf16x8 af = (bf16x8){0, 0, 0, 0, 0, 0, 0, 0};
                if (r < 4) af = *(const LAS bf16x8*)(Pb + r * 256 + 4 * i0 + 32 * half + 8 * kq);
#pragma unroll
                for (int cb = 0; cb < 8; ++cb) {
                    s16x4_t bq[2];
#pragma unroll
                    for (int t = 0; t < 2; ++t) { const unsigned trow = 8u * (unsigned)ks + 4u * t + tq_, tch = 2u * cb + (tp_ >> 1);
                        const unsigned ta = 256u * trow + 16u * (tch ^ (((trow & 3u) << 2) | ((trow >> 2) & 3u))) + 8u * (tp_ & 1u);
                        bq[t] = __builtin_amdgcn_ds_read_tr16_b64_v4i16((LAS s16x4_t*)(vt + ta)); }
                    const bf16x8 bfrag = {bq[0][0], bq[0][1], bq[0][2], bq[0][3], bq[1][0], bq[1][1], bq[1][2], bq[1][3]};
                    oacc[cb] = MFMA16(af, bfrag, oacc[cb]); }
                asm volatile("" ::: "memory");
            }
        }
        if (ks == 0) {
#pragma unroll
            for (int hd = 0; hd < 4; ++hd) { const float il = invl[hd];
#pragma unroll
                for (int cb = 0; cb < 8; ++cb) mix[qrow * D + (g * 4 + hd) * 128 + 16 * cb + dc] = (unsigned short)(cvtpk(oacc[cb][hd] * il, 0.f) & 0xffffu); }
        }
        LDS_WAIT(); asm volatile("" ::: "memory");
    }
#endif
    __syncthreads(); DSA_PT(2);
}


constexpr int A2_SLOT = 40960, A2_NSLOT = 3, A2_CTRL = A2_SLOT * A2_NSLOT;
static_assert(A2_CTRL + 256 <= RING_BYTES, "attention LDS map");
#define A2_WAIT_V(n) asm volatile("s_waitcnt vmcnt(" #n ")" ::: "memory")
template <int MODE>
__device__ __forceinline__ void attn2_stage(LAS unsigned char* slot, const bf16* kbase  ,
                                            const bf16* vbase  , const float* cbase  , int ldp, int kb, int wave) {
#pragma unroll
    for (int i = 0; i < 2; ++i) { const int f = wave + 8 * i, sb = f >> 3, kk = f & 7;
        __builtin_amdgcn_global_load_lds((const unsigned*)(kbase + (size_t)(kb + 32 * sb) * ldp + kk * 16), (LAS unsigned*)(slot + f * 1024), 16, 0, 0); }
#pragma unroll
    for (int i = 0; i < 2; ++i) { const int f = wave + 8 * i, sb = f >> 3, d = (f >> 1) & 3, s = f & 1;
        __builtin_amdgcn_global_load_lds((const unsigned*)(vbase + (size_t)(d * 32) * SEQ + kb + 32 * sb + 16 * s), (LAS unsigned*)(slot + 16384 + f * 1024), 16, 0, 0); }
    if (MODE == 1) __builtin_amdgcn_global_load_lds((const unsigned*)(cbase + kb), (LAS unsigned*)(slot + 32768 + wave * 1024), 16, 0, 0);
}
template <int MODE>
__device__ __forceinline__ void attn2_unit(const bf16* proj, int ldp, const bf16* VT, const float* cum2, const float* tot, const float* gq, const float* rstdv, bf16* mix, float zb2, int grp, int bh, LAS unsigned char* lds, int tid) {
    const int lane = tid & 63, wave = __builtin_amdgcn_readfirstlane(tid >> 6);
    const int b = bh >> 4, h = bh & 15, n = lane & 31, hi = lane >> 5;
    const int q_base = 256 * grp, q0 = q_base + 32 * wave, tq = q0 + n;
    const size_t row0 = (size_t)b * SEQ;
    const int prow = (n & 0x13) | ((n & 4) << 1) | ((n & 8) >> 1);
    const bf16* kbase = proj + (row0 + prow) * ldp + D + h * 128 + hi * 8;
    const bf16* vbase = VT + ((size_t)bh * 128 + n) * SEQ + 8 * hi;
    const float* cb = cum2 + (size_t)bh * SEQ;
    const float* cbase = cb + 4 * (lane & 15);
    volatile LAS unsigned* flags = (volatile LAS unsigned*)(lds + A2_CTRL + 64);
    bf16x8 qf[8];
    {
      const bf16* qp = proj + (row0 + q0 + n) * ldp + h * 128 + hi * 8;
      u32x4 raw[8];
#pragma unroll
      for (int kk = 0; kk < 8; ++kk) raw[kk] = *(const u32x4*)(qp + kk * 16);
      float ss = 0.f;
#pragma unroll
      for (int kk = 0; kk < 8; ++kk) { const float x0 = bflo(raw[kk].x), x1 = bfhi(raw[kk].x), x2 = bflo(raw[kk].y), x3 = bfhi(raw[kk].y), x4 = bflo(raw[kk].z), x5 = bfhi(raw[kk].z), x6 = bflo(raw[kk].w), x7 = bfhi(raw[kk].w);
          ss += x0 * x0 + x1 * x1 + x2 * x2 + x3 * x3 + x4 * x4 + x5 * x5 + x6 * x6 + x7 * x7; }
      ss += __shfl_xor(ss, 32);
      const float ar = rstdv[row0 + q0 + n];
      const float rstd = ar / sqrtf(ar * ar * ss * (1.f / 128.f) + RMS_EPS);
#pragma unroll
      for (int kk = 0; kk < 8; ++kk) { const f32x4 g0 = *(const f32x4*)(gq + kk * 16 + hi * 8), g1 = *(const f32x4*)(gq + kk * 16 + hi * 8 + 4);
          u32x4 w; w.x = cvtpk(bflo(raw[kk].x) * rstd * g0.x * QSCALE, bfhi(raw[kk].x) * rstd * g0.y * QSCALE); w.y = cvtpk(bflo(raw[kk].y) * rstd * g0.z * QSCALE, bfhi(raw[kk].y) * rstd * g0.w * QSCALE);
          w.z = cvtpk(bflo(raw[kk].z) * rstd * g1.x * QSCALE, bfhi(raw[kk].z) * rstd * g1.y * QSCALE); w.w = cvtpk(bflo(raw[kk].w) * rstd * g1.z * QSCALE, bfhi(raw[kk].w) * rstd * g1.w * QSCALE);
          qf[kk] = __builtin_bit_cast(bf16x8, w); } }
    float cq = 0.f, c_low = 0.f, Pe = 0.f, Po = 0.f, Pq = 0.f, Plow = 0.f;
    if (MODE == 1) { cq = cb[tq]; c_low = cb[q_base];
        const float te = tot[bh * 128 + 2 * lane], to = tot[bh * 128 + 2 * lane + 1]; float sc2 = te + to;
#pragma unroll
        for (int o = 1; o < 64; o <<= 1) { const float u = __shfl_up(sc2, o); if (lane >= o) sc2 += u; }
        Pe = sc2 - (te + to); Po = Pe + te;
        { const int cw = q0 >> 6; Pq = (cw & 1) ? __shfl(Po, cw >> 1) : __shfl(Pe, cw >> 1); }
        { const int cl = q_base >> 6; Plow = (cl & 1) ? __shfl(Po, cl >> 1) : __shfl(Pe, cl >> 1); } }
    f32x16 o[4];
#pragma unroll
    for (int d = 0; d < 4; ++d)
#pragma unroll
        for (int i = 0; i < 16; ++i) o[d][i] = 0.f;
    float R = 0.f, mrun = -1e30f, lrun = 0.f;
    const int nsteps = (q_base + 256) >> 6, kb_top = q_base + 192;
    if (wave < 4) __builtin_amdgcn_s_setprio(2); else __builtin_amdgcn_s_setprio(0);
    if (MODE == 0 && tid < 16) flags[tid] = 0u;
    asm volatile("s_waitcnt vmcnt(0)" ::: "memory");
    attn2_stage<MODE>(lds, kbase, vbase, cbase, ldp, kb_top, wave);
    if (nsteps > 1) attn2_stage<MODE>(lds + A2_SLOT, kbase, vbase, cbase, ldp, kb_top - 64, wave);
    bool mydone = false;
    for (int j = 0; j < nsteps; ++j) {
        const int kb = kb_top - 64 * j;
        if (j + 1 < nsteps) { if (MODE == 1) A2_WAIT_V(5); else A2_WAIT_V(4); } else A2_WAIT_V(0);
        __builtin_amdgcn_s_barrier();
        __builtin_amdgcn_sched_barrier(0); asm volatile("" ::: "memory");
        LAS unsigned char* slot = lds + (j % A2_NSLOT) * A2_SLOT;
        float dq = 0.f;
        if (MODE == 1) { const int ck_ = kb >> 6; const float Pk = (ck_ & 1) ? __shfl(Po, ck_ >> 1) : __shfl(Pe, ck_ >> 1);
            dq = Pq - Pk;
            const float ck63 = *(const LAS float*)(slot + 32768 + wave * 1024 + 63 * 4);
            if ((c_low + (Plow - Pk) - ck63) + 2.f * zb2 < ZERO_LOG2) break; }
        else if (j > 0) { const volatile LAS unsigned* fl = flags + 8 * ((j - 1) & 1); unsigned all = 1u;
#pragma unroll
            for (int w2 = 0; w2 < 8; ++w2) all &= fl[w2];
            if (all) break; }
        if (j + 2 < nsteps) attn2_stage<MODE>(lds + ((j + 2) % A2_NSLOT) * A2_SLOT, kbase, vbase, cbase, ldp, kb - 128, wave);
#pragma unroll
        for (int sbi = 0; sbi < 2; ++sbi) { const int sb = 1 - sbi, kk0 = kb + 32 * sb;
            if (kk0 > q0 || mydone) continue;
            if (MODE == 1) { const float ck31 = *(const LAS float*)(slot + 32768 + wave * 1024 + (32 * sb + 31) * 4);
                const float cq0 = __shfl(cq, 0); if ((cq0 + dq - ck31) + 2.f * zb2 < ZERO_LOG2) { mydone = true; continue; } }
            bf16x8 kf[8];
#pragma unroll
            for (int kk = 0; kk < 8; ++kk) kf[kk] = *(const LAS bf16x8*)(slot + (sb * 8 + kk) * 1024 + lane * 16);
            f32x16 sc;
#pragma unroll
            for (int i = 0; i < 16; ++i) sc[i] = 0.f;
#pragma unroll
            for (int kk = 0; kk < 8; ++kk) sc = MFMA32(kf[kk], qf[kk], sc);
            bf16x8 vf[4][2];
#pragma unroll
            for (int d = 0; d < 4; ++d)
#pragma unroll
                for (int s = 0; s < 2; ++s) vf[d][s] = *(const LAS bf16x8*)(slot + 16384 + (sb * 8 + d * 2 + s) * 1024 + lane * 16);
            const bool diag = (kk0 == q0);
            float w[16];
            if (MODE == 0) {
                float L[16];
#pragma unroll
                for (int i = 0; i < 16; ++i) L[i] = flog2(1.f + fexp2(sc[i]));
                if (diag) {
#pragma unroll
                    for (int i = 0; i < 16; ++i) { const int key = kk0 + 16 * (i >> 3) + 8 * hi + (i & 7); if (key >= tq) { L[i] = 0.f; sc[i] = -3e38f; } }
                }
                const float G0 = -(((L[0] + L[1]) + (L[2] + L[3])) + ((L[4] + L[5]) + (L[6] + L[7]))), G1 = -(((L[8] + L[9]) + (L[10] + L[11])) + ((L[12] + L[13]) + (L[14] + L[15])));
                const float Gp0 = __shfl_xor(G0, 32), Gp1 = __shfl_xor(G1, 32);
                const float pre1 = hi ? R : (R + Gp1);
                const float pre0 = hi ? (R + G1 + Gp1) : (R + Gp1 + G1 + Gp0);
                float c = pre1;
#pragma unroll
                for (int jj = 7; jj >= 0; --jj) { c -= L[8 + jj]; w[8 + jj] = fexp2(sc[8 + jj] + c); }
                c = pre0;
#pragma unroll
                for (int jj = 7; jj >= 0; --jj) { c -= L[jj]; w[jj] = fexp2(sc[jj] + c); }
                R += (G0 + G1) + (Gp0 + Gp1);
                if (__all(R + zb2 < ZERO_LOG2)) mydone = true;
            } else {
                f32x2_t v2[8]; const f32x2_t cq2 = {cq + dq, cq + dq};
#pragma unroll
                for (int s = 0; s < 2; ++s) { const LAS f32x4* cp = (const LAS f32x4*)(slot + 32768 + wave * 1024 + (32 * sb + 16 * s + 8 * hi) * 4);
                    const f32x4 c0 = cp[0], c1 = cp[1];
                    v2[4 * s + 0] = (f32x2_t){sc[8 * s + 0], sc[8 * s + 1]} - (f32x2_t){c0.x, c0.y};
                    v2[4 * s + 1] = (f32x2_t){sc[8 * s + 2], sc[8 * s + 3]} - (f32x2_t){c0.z, c0.w};
                    v2[4 * s + 2] = (f32x2_t){sc[8 * s + 4], sc[8 * s + 5]} - (f32x2_t){c1.x, c1.y};
                    v2[4 * s + 3] = (f32x2_t){sc[8 * s + 6], sc[8 * s + 7]} - (f32x2_t){c1.z, c1.w}; }
                if (diag) {
#pragma unroll
                    for (int p = 0; p < 8; ++p) { const int key = kk0 + 16 * (p >> 2) + 8 * hi + 2 * (p & 3);
                        if (key > tq) v2[p].x = -3e38f; if (key + 1 > tq) v2[p].y = -3e38f; }
                }
#pragma unroll
                for (int p = 0; p < 8; ++p) v2[p] += cq2;
                float bm = fmaxf(fmaxf(v2[0].x, v2[0].y), fmaxf(v2[1].x, v2[1].y));
#pragma unroll
                for (int p = 2; p < 8; p += 2) bm = fmaxf(bm, fmaxf(fmaxf(v2[p].x, v2[p].y), fmaxf(v2[p + 1].x, v2[p + 1].y)));
                bm = fmaxf(bm, __shfl_xor(bm, 32));
                const float mn = fmaxf(mrun, bm), alpha = fexp2(mrun - mn);
                mrun = mn;
                const f32x2_t nmn2 = {-mn, -mn}; f32x2_t ps2 = {0.f, 0.f};
#pragma unroll
                for (int p = 0; p < 8; ++p) { const f32x2_t d2 = v2[p] + nmn2; f32x2_t e2; e2.x = fexp2(d2.x); e2.y = fexp2(d2.y); w[2 * p] = e2.x; w[2 * p + 1] = e2.y; ps2 += e2; }
                lrun = lrun * alpha + (ps2.x + ps2.y);
                if (__any(alpha != 1.f)) {
#pragma unroll
                    for (int d = 0; d < 4; ++d)
#pragma unroll
                        for (int i = 0; i < 16; ++i) o[d][i] *= alpha;
                }
            }
            bf16x8 pf[2];
#pragma unroll
            for (int s = 0; s < 2; ++s) { u32x4 t; t.x = cvtpk(w[8 * s + 0], w[8 * s + 1]); t.y = cvtpk(w[8 * s + 2], w[8 * s + 3]); t.z = cvtpk(w[8 * s + 4], w[8 * s + 5]); t.w = cvtpk(w[8 * s + 6], w[8 * s + 7]);
                pf[s] = __builtin_bit_cast(bf16x8, t); }
#pragma unroll
            for (int d = 0; d < 4; ++d)
#pragma unroll
                for (int s = 0; s < 2; ++s) o[d] = MFMA32(vf[d][s], pf[s], o[d]);
        }
        if (MODE == 0) { if (lane == 0) flags[8 * (j & 1) + wave] = (mydone || kb == 0) ? 1u : 0u; }
    }
    A2_WAIT_V(0);
    __builtin_amdgcn_s_setprio(0);
    float inv = 1.f;
    if (MODE == 1) { const float lt = lrun + __shfl_xor(lrun, 32); inv = 1.f / lt; }
    bf16* op = mix + (row0 + q0 + n) * (size_t)D + h * 128 + 4 * hi;
#pragma unroll
    for (int d = 0; d < 4; ++d)
#pragma unroll
        for (int g = 0; g < 4; ++g) { u32x2 t; t.x = cvtpk(o[d][4 * g] * inv, o[d][4 * g + 1] * inv); t.y = cvtpk(o[d][4 * g + 2] * inv, o[d][4 * g + 3] * inv);
            *(u32x2*)(op + d * 32 + 8 * g) = t; }
    asm volatile("s_waitcnt vmcnt(0) lgkmcnt(0)" ::: "memory");
    __builtin_amdgcn_s_barrier();
}

typedef const __attribute__((address_space(4))) Args* KArgs;
__device__ __forceinline__ KArgs kargs() { auto p = __builtin_amdgcn_kernarg_segment_ptr(); asm volatile("" : "+s"(p)); return (KArgs)p; }
#define TID_VARS int tid_l = threadIdx.x; asm volatile("" : "+v"(tid_l)); const int tid = tid_l, lane = tid & 63, wave = __builtin_amdgcn_readfirstlane(tid >> 6); const int G = gridDim.x, bx = blockIdx.x; const int gw = bx * NWAVES + wave, ngw = G * NWAVES; (void)gw; (void)ngw; (void)lane; (void)G
#ifndef WGM_IN
#define WGM_IN 4
#endif
#ifndef WGM_WO
#define WGM_WO 4
#endif
#ifndef WGM_PP
#define WGM_PP 4
#endif
#ifndef WGM_UP
#define WGM_UP 4
#endif
#ifndef WGM_DN
#define WGM_DN 4
#endif
#ifndef WGM_GT
#define WGM_GT 4
#endif
#ifndef PG_ALIGN
#define PG_ALIGN true
#endif
#ifndef PG_SP2
#define PG_SP2 true
#endif
#ifndef PHMASK
#define PHMASK 0xFFFF
#endif
#define PH(k) ((PHMASK >> (k)) & 1)
#ifndef REP_GEMM
#define REP_GEMM 1
#endif
#ifndef REP_ATTN
#define REP_ATTN 1
#endif
#ifndef REP_LIGHT
#define REP_LIGHT 1
#endif
#ifndef REP_A
#define REP_A REP_ATTN
#endif
#ifndef REP_B
#define REP_B REP_ATTN
#endif
#ifndef REP_C
#define REP_C REP_ATTN
#endif

#ifndef REP_BAR
#define REP_BAR 1
#endif
__device__ __forceinline__ void grid_bar(LAS unsigned char* lds) {
  for (int rb = 0; rb < REP_BAR; ++rb) {
    KArgs A = kargs(); XcdBarrier b; b.bar = (unsigned*)(A->ws + WS_CTL) + CW_BAR; b.x = xb_xcc_id(); b.st = (volatile LAS unsigned*)(lds + MISC_OFF) + 8;
    xcd_barrier(b);
  }
}
struct LayerCfg { int kind, jk, nin, npad; };
__device__ __forceinline__ LayerCfg layer_cfg(int layer) { LayerCfg c; c.kind = layer % 3; c.jk = layer / 3; c.nin = c.kind == 0 ? NA_IN : (c.kind == 1 ? NB_IN : NC_IN); c.npad = c.kind == 0 ? NA_IN : (c.kind == 1 ? NB_PAD : NC_PAD); return c; }

__device__ __forceinline__ void convert_layer(KArgs A, unsigned char* ws, LAS float* scrw, int layer, int which, int gw, int ngw, int lane) {
    const LayerCfg L = layer_cfg(layer);
    if (which & 1) {
        const float* w_in = L.kind == 0 ? A->in[I_A_WIN] + (size_t)L.jk * D * NA_IN : (L.kind == 1 ? A->in[I_B_WIN] : A->in[I_C_WIN]);
        convert_weight(w_in, A->in[I_ATTN_NORM] + layer * D, D, L.nin, L.npad, (bf16*)(ws + WS_WIN), scrw, gw, ngw, lane);
        convert_weight(A->in[I_WO] + (size_t)layer * D * D, nullptr, D, D, D, (bf16*)(ws + WS_WO), scrw, gw, ngw, lane);
        convert_weight(A->in[I_WUP] + (size_t)layer * D * FF, A->in[I_MLP_NORM] + layer * D, D, FF, FF, (bf16*)(ws + WS_WUP), scrw, gw, ngw, lane);
        convert_weight(A->in[I_WDOWN] + (size_t)layer * FF * D, nullptr, FF, D, D, (bf16*)(ws + WS_WDN), scrw, gw, ngw, lane);
    }
    if (which & 2) {
        convert_weight(A->in[I_WGATE] + (size_t)layer * D * D, A->in[I_PLE_NORM] + layer * D, D, D, D, (bf16*)(ws + WS_WG), scrw, gw, ngw, lane);
        convert_weight(A->in[I_WPLE] + (size_t)layer * PLE * D, nullptr, PLE, D, D, (bf16*)(ws + WS_WPL), scrw, gw, ngw, lane);
    }
}
__device__ __forceinline__ void phase_prologue(LAS unsigned char* lds) {
    KArgs A = kargs(); TID_VARS; unsigned char* ws = A->ws;
    float2* rope32 = (float2*)(ws + WS_ROPE32); float2* rope16 = (float2*)(ws + WS_ROPE16);
    const int gt = bx * NTHR + tid, ngt = G * NTHR;
    for (int i = gt; i < SEQ * 16; i += ngt) { const int pos = i >> 4, k = i & 15; const float inv = exp2f(-(float)k * (1.f / 16.f) * 18.931568569324174f);
        const float ang = (float)pos * inv; float s, c; sincosf(ang, &s, &c); rope32[i] = make_float2(c, s); }
    for (int i = gt; i < SEQ * 8; i += ngt) { const int pos = i >> 3, k = i & 7; const float inv = exp2f(-(float)k * (1.f / 8.f) * 18.931568569324174f);
        const float ang = (float)pos * inv; float s, c; sincosf(ang, &s, &c); rope16[i] = make_float2(c, s); }
    const f32x4* p4 = (const f32x4*)A->in[I_P]; u32x2* pb2 = (u32x2*)(ws + WS_PB);
    for (size_t i = gt; i < (size_t)DEPTH * M * PLE / 4; i += ngt) { const f32x4 v = p4[i]; pb2[i] = (u32x2){cvtpk(v.x, v.y), cvtpk(v.z, v.w)}; }
    x_rows(A->in[I_X], (bf16*)(ws + WS_HB0), (float*)(ws + WS_SSP_IN), gw, ngw, lane);
    convert_layer(A, ws, (LAS float*)(lds + RING_OFF + wave * 8448), 0, 1, gw, ngw, lane);
}
__device__ __forceinline__ void phase_inproj(LAS unsigned char* lds, int layer) {
    KArgs A = kargs(); TID_VARS; unsigned char* ws = A->ws; const LayerCfg L = layer_cfg(layer);
    pg8::Gemm g{(const bf16*)(ws + ((layer & 1) ? WS_HB1 : WS_HB0)), (const bf16*)(ws + WS_WIN), M, L.npad, D}; pg8::StaticOrder S; S.init(M, L.npad, G, bx, WGM_IN);
    { const float* ssp = (const float*)(ws + WS_SSP_IN); float* rv = (float*)(ws + WS_RSTD);
      for (int r = gw; r < M; r += ngw) { float v = lane < 32 ? ssp[(size_t)r * 32 + lane] : 0.f; v = wave_sum(v); if (lane == 0) rv[r] = 1.f / sqrtf(v * (1.f / 2048.f) + RMS_EPS); } }
    pg8::EpiStore<0, false> E{(bf16*)(ws + WS_PROJ), L.npad, nullptr};
    pg8::gemm_phase<pg8::EpiStore<0, false>, pg8::StaticOrder, PG_ALIGN, PG_SP2>(lds + RING_OFF, g, S, E);
}
__device__ __forceinline__ float zbound2(const float* gq, const float* gk, int lane) {
    const float a = wave_max(fmaxf(fabsf(gq[lane]), fabsf(gq[lane + 64]))), bq = wave_max(fmaxf(fabsf(gk[lane]), fabsf(gk[lane + 64])));
    return a * bq * 11.313708498984761f * LOG2E * 1.02f;
}
__device__ __forceinline__ void phase_postproj_dense(LAS unsigned char* lds, int layer) {
    KArgs A = kargs(); TID_VARS; unsigned char* ws = A->ws; const LayerCfg L = layer_cfg(layer);
    bf16* PROJ = (bf16*)(ws + WS_PROJ); LAS float* scrw = (LAS float*)(lds + RING_OFF + wave * 8448);
    const float* gq = L.kind == 0 ? A->in[I_A_QN] + L.jk * HD : A->in[I_C_QN]; const float* gk = L.kind == 0 ? A->in[I_A_KN] + L.jk * HD : A->in[I_C_KN];
    const int npad = L.npad;
    const int nscan = L.kind == 2 ? BATCH * 128 : 0, nvt = BATCH * 256 * 16, total = nscan + nvt + M;
    for (int it = gw; it < total; it += ngw) {
        if (it < nscan) { cumchunk_item(PROJ, npad, (const float*)(ws + WS_RSTD), A->in[I_C_BF], (float*)(ws + WS_CUM), (float*)(ws + WS_TOT), it, lane); continue; }
        int r = it - nscan;
        if (r < nvt) { vt_item(PROJ, npad, 2 * D, (const float*)(ws + WS_RSTD), (bf16*)(ws + WS_VT), (LAS unsigned char*)scrw, r, lane); continue; }
        r -= nvt;
        bf16* base = PROJ + (size_t)r * npad + 8 * lane;
        u32x4 raw[4];
#pragma unroll
        for (int j = 0; j < 4; ++j) raw[j] = *(const u32x4*)(base + D + 512 * j);
        const float ar = ((const float*)(ws + WS_RSTD))[r];
#pragma unroll
        for (int j = 0; j < 4; ++j) head128_norm<false>(base + D + 512 * j, raw[j], ar, gk, 1.f, nullptr, lane);
    }
    convert_layer(A, ws, scrw, layer, 2, gw, ngw, lane);
}
__device__ __forceinline__ void phase_postproj_dsa(LAS unsigned char* lds, int layer) {
    KArgs A = kargs(); TID_VARS; unsigned char* ws = A->ws;
    bf16* PROJ = (bf16*)(ws + WS_PROJ); const float2* rope32 = (const float2*)(ws + WS_ROPE32); const float2* rope16 = (const float2*)(ws + WS_ROPE16);
    const float* gq = A->in[I_B_QN]; const float* gk = A->in[I_B_KN]; const float* gi = A->in[I_B_IKN];
    constexpr int npad = NB_PAD;
    for (int r = gw; r < M; r += ngw) { const int pos = r & (SEQ - 1);
        bf16* base = PROJ + (size_t)r * npad;
        const float2* r32 = rope32 + pos * 16; const float2* r16 = rope16 + pos * 8;
        u32x4 raw[8]; u32x4 rawi, raww;
#pragma unroll
        for (int j = 0; j < 5; ++j) raw[j] = *(const u32x4*)(base + 512 * j + 8 * lane);
        raw[5] = *(const u32x4*)(base + B_QI + 8 * lane); raw[6] = *(const u32x4*)(base + B_QI + 512 + 8 * lane);
        rawi = *(const u32x4*)(base + B_KI + 8 * (lane & 7)); raww = *(const u32x4*)(base + B_WI + 8 * (lane & 1));
        const float ar = ((const float*)(ws + WS_RSTD))[r];
        unsigned char* q8 = ws + WS_Q8 + (size_t)r * 2048 + 8 * lane; unsigned char* k8 = ws + WS_K8 + (size_t)r * 512 + 8 * lane; unsigned char* v8 = ws + WS_V8 + (size_t)r * 512 + 8 * lane;
#pragma unroll
        for (int j = 0; j < 4; ++j) head128_norm<true>(base + 512 * j + 8 * lane, raw[j], ar, gq, QSCALE * 8.f, r32, lane, q8 + 512 * j);
        head128_norm<true>(base + B_K + 8 * lane, raw[4], ar, gk, 1.f, r32, lane, k8);
        { const u32x4 rv = *(const u32x4*)(base + B_V + 8 * lane); int w0 = 0, w1 = 0;
          w0 = __builtin_amdgcn_cvt_pk_fp8_f32(bflo(rv.x) * ar, bfhi(rv.x) * ar, w0, false); w0 = __builtin_amdgcn_cvt_pk_fp8_f32(bflo(rv.y) * ar, bfhi(rv.y) * ar, w0, true);
          w1 = __builtin_amdgcn_cvt_pk_fp8_f32(bflo(rv.z) * ar, bfhi(rv.z) * ar, w1, false); w1 = __builtin_amdgcn_cvt_pk_fp8_f32(bflo(rv.w) * ar, bfhi(rv.w) * ar, w1, true);
          *(u32x2*)v8 = (u32x2){(unsigned)w0, (unsigned)w1}; }
#pragma unroll
        for (int j = 0; j < 2; ++j) head64_rope<false>(base + B_QI + 512 * j + 8 * lane, raw[5 + j], ar, nullptr, r16, lane, true);
        head64_rope<true>(base + B_KI + 8 * (lane & 7), rawi, ar, gi, r16, lane, lane < 8);
        if (lane < 2) { bf16* wp = base + B_WI + 8 * lane; const u32x4 raw = raww;
            const float sw = 0.03125f * ar;
            u32x4 w; w.x = cvtpk(bflo(raw.x) * sw, bfhi(raw.x) * sw); w.y = cvtpk(bflo(raw.y) * sw, bfhi(raw.y) * sw);
            w.z = cvtpk(bflo(raw.z) * sw, bfhi(raw.z) * sw); w.w = cvtpk(bflo(raw.w) * sw, bfhi(raw.w) * sw); *(u32x4*)wp = w; }
    }
    convert_layer(A, ws, (LAS float*)(lds + RING_OFF + wave * 8448), layer, 2, gw, ngw, lane);
}
template <int MODE>
__device__ __forceinline__ void phase_attn_dense(LAS unsigned char* lds, int layer, int rep) {
    KArgs A = kargs(); TID_VARS; unsigned char* ws = A->ws; const LayerCfg L = layer_cfg(layer);
    const float* gq = L.kind == 0 ? A->in[I_A_QN] + L.jk * HD : A->in[I_C_QN]; const float* gk = L.kind == 0 ? A->in[I_A_KN] + L.jk * HD : A->in[I_C_KN];
    const float zb2 = zbound2(gq, gk, lane);
    gu32* qhead = (gu32*)(ws + WS_CTL) + CW_QUEUE + 64 * layer + 16 * rep;
    volatile LAS unsigned* uw = (volatile LAS unsigned*)(lds + RING_OFF + A2_CTRL);
    for (;;) { if (tid == 0) uw[0] = __hip_atomic_fetch_add(qhead, 1u, RLX_AGENT); __syncthreads(); const unsigned it = uw[0]; __syncthreads();
        if (it >= 32u * 64u) break;
        const int grp = 31 - (int)(it >> 6), bh = (int)(it & 63u);
        attn2_unit<MODE>((const bf16*)(ws + WS_PROJ), L.npad, (const bf16*)(ws + WS_VT), (const float*)(ws + WS_CUM), (const float*)(ws + WS_TOT), gq, (const float*)(ws + WS_RSTD), (bf16*)(ws + WS_MIX), zb2, grp, bh, lds + RING_OFF, tid); }
}
__device__ __forceinline__ void phase_attn_dsa(LAS unsigned char* lds, int layer, int rep) {
    KArgs A = kargs(); TID_VARS; unsigned char* ws = A->ws;
    gu32* qhead = (gu32*)(ws + WS_CTL) + CW_QUEUE + 64 * layer + 16 * rep;
    float* scr = (float*)(ws + (bx < 128 ? WS_SCR_A + (size_t)bx * MiB : WS_SCR_B + (size_t)(bx - 128) * MiB));
    volatile LAS unsigned* uw = (volatile LAS unsigned*)(lds + RING_OFF + DL_MISC + 128);
    for (;;) { if (tid == 0) uw[0] = __hip_atomic_fetch_add(qhead, 1u, RLX_AGENT); __syncthreads(); const unsigned u = uw[0]; __syncthreads();
        if (u >= 1024u) break; dsa_unit((const bf16*)(ws + WS_PROJ), ws + WS_Q8, ws + WS_K8, ws + WS_V8, (bf16*)(ws + WS_MIX), scr, lds + RING_OFF, (int)u, tid); }
}
__device__ __forceinline__ void phase_wo(LAS unsigned char* lds, int layer) {
    KArgs A = kargs(); TID_VARS; unsigned char* ws = A->ws;
    pg8::Gemm g{(const bf16*)(ws + WS_MIX), (const bf16*)(ws + WS_WO), M, D, D}; pg8::StaticOrder S; S.init(M, D, G, bx, WGM_WO);
    bf16* hb = (bf16*)(ws + ((layer & 1) ? WS_HB1 : WS_HB0));
    pg8::EpiH<false, false> E{hb, hb, (float*)(ws + WS_SSP_WO), nullptr, nullptr, nullptr};
    pg8::gemm_phase<pg8::EpiH<false, false>, pg8::StaticOrder, PG_ALIGN, PG_SP2>(lds + RING_OFF, g, S, E);
}
__device__ __forceinline__ void phase_pp(LAS unsigned char* lds, int layer) {
    KArgs A = kargs(); TID_VARS; unsigned char* ws = A->ws;
    int kpl = PLE; asm volatile("" : "+s"(kpl));
    pg8::Gemm g{(const bf16*)(ws + WS_PB) + (size_t)layer * M * PLE, (const bf16*)(ws + WS_WPL), M, D, kpl}; pg8::StaticOrder S; S.init(M, D, G, bx, WGM_PP);
    pg8::EpiStore<0, false> E{(bf16*)(ws + WS_PP), D, nullptr};
    pg8::gemm_phase<pg8::EpiStore<0, false>, pg8::StaticOrder, PG_ALIGN, PG_SP2>(lds + RING_OFF, g, S, E);
}
__device__ __forceinline__ void phase_up(LAS unsigned char* lds, int layer) {
    KArgs A = kargs(); TID_VARS; unsigned char* ws = A->ws;
    pg8::Gemm g{(const bf16*)(ws + ((layer & 1) ? WS_HB1 : WS_HB0)), (const bf16*)(ws + WS_WUP), M, FF, D}; pg8::StaticOrder S; S.init(M, FF, G, bx, WGM_UP);
    pg8::EpiStore<1, false> E{(bf16*)(ws + WS_HID), FF, nullptr};
    pg8::gemm_phase<pg8::EpiStore<1, false>, pg8::StaticOrder, PG_ALIGN, PG_SP2>(lds + RING_OFF, g, S, E);
}
__device__ __forceinline__ void phase_down(LAS unsigned char* lds, int layer) {
    KArgs A = kargs(); TID_VARS; unsigned char* ws = A->ws;
    pg8::Gemm g{(const bf16*)(ws + WS_HID), (const bf16*)(ws + WS_WDN), M, D, FF}; pg8::StaticOrder S; S.init(M, D, G, bx, WGM_DN);
    bf16* hb = (bf16*)(ws + ((layer & 1) ? WS_HB1 : WS_HB0));
    pg8::EpiH<false, false, true> E{hb, hb, (float*)(ws + WS_SSP_DN), nullptr, (const float*)(ws + WS_SSP_WO), nullptr};
    pg8::gemm_phase<pg8::EpiH<false, false, true>, pg8::StaticOrder, PG_ALIGN, PG_SP2>(lds + RING_OFF, g, S, E);
}
template <bool FINAL>
__device__ __forceinline__ void phase_gate(LAS unsigned char* lds, int layer) {
    KArgs A = kargs(); TID_VARS; unsigned char* ws = A->ws;
    pg8::Gemm g{(const bf16*)(ws + ((layer & 1) ? WS_HB1 : WS_HB0)), (const bf16*)(ws + WS_WG), M, D, D}; pg8::StaticOrder S; S.init(M, D, G, bx, WGM_GT);
    pg8::EpiH<true, FINAL> E{(const bf16*)(ws + ((layer & 1) ? WS_HB1 : WS_HB0)), (bf16*)(ws + ((layer & 1) ? WS_HB0 : WS_HB1)), (float*)(ws + WS_SSP_IN), (const bf16*)(ws + WS_PP), (const float*)(ws + WS_SSP_DN), A->out};
    pg8::gemm_phase<pg8::EpiH<true, FINAL>, pg8::StaticOrder, PG_ALIGN, PG_SP2>(lds + RING_OFF, g, S, E);
}
__device__ __forceinline__ void phase_convert_next(LAS unsigned char* lds, int layer) {
    KArgs A = kargs(); TID_VARS; unsigned char* ws = A->ws;
    convert_layer(A, ws, (LAS float*)(lds + RING_OFF + wave * 8448), layer, 1, gw, ngw, lane);
}

__global__ void __launch_bounds__(NTHR, 2) trunk_fwd(Args args) {
    extern __shared__ __attribute__((aligned(16))) unsigned char lds_raw[];
    LAS unsigned char* lds = (LAS unsigned char*)lds_raw;
    for (int u = threadIdx.x; u < (LDS_BYTES - LDSCTL_OFF) / 4; u += NTHR) ((LAS unsigned*)(lds + LDSCTL_OFF))[u] = 0u;
    __syncthreads();
    { KArgs A = kargs(); (void)xcd_barrier_post((unsigned*)(A->ws + WS_CTL) + CW_BAR, (volatile LAS unsigned*)(lds + MISC_OFF) + 8); }
#ifdef PROBE_MASK
    unsigned long long pt_acc = 0ull, pt_last = __builtin_amdgcn_s_memrealtime();
#define PT(cls) do { const unsigned long long now_ = __builtin_amdgcn_s_memrealtime(); if ((PROBE_MASK >> (cls)) & 1) pt_acc += now_ - pt_last; pt_last = now_; } while (0)
#else
#define PT(cls) do { } while (0)
#endif
    phase_prologue(lds);
    grid_bar(lds); PT(7);
    for (int layer = 0; layer < DEPTH; ++layer) {
        const int kind = layer % 3;
        phase_inproj(lds, layer);
        grid_bar(lds); PT(0);
        if (kind != 1) phase_postproj_dense(lds, layer); else phase_postproj_dsa(lds, layer);
        grid_bar(lds); PT(1);
        if (kind == 0) phase_attn_dense<0>(lds, layer, 0);
        else if (kind == 2) phase_attn_dense<1>(lds, layer, 0);
        else phase_attn_dsa(lds, layer, 0);
        grid_bar(lds); PT(kind == 0 ? 2 : (kind == 1 ? 8 : 9));
        phase_wo(lds, layer);
        phase_pp(lds, layer);
        grid_bar(lds); PT(3);
        phase_up(lds, layer);
        grid_bar(lds); PT(4);
        phase_down(lds, layer);
        grid_bar(lds); PT(5);
        if (layer + 1 < DEPTH) { phase_gate<false>(lds, layer); __syncthreads(); phase_convert_next(lds, layer + 1); }
        else phase_gate<true>(lds, layer);
        grid_bar(lds); PT(6);
    }
#ifdef PROBE_MASK
#if defined(PROBE_EPI) || defined(PROBE_DSA)
    pt_acc = *(volatile LAS unsigned long long*)(lds + MISC_OFF + 64);
#endif
    if (blockIdx.x == 0 && threadIdx.x == 0) { const unsigned long long until = __builtin_amdgcn_s_memrealtime() + (unsigned long long)PROBE_AMP * pt_acc;
        while (__builtin_amdgcn_s_memrealtime() < until) __builtin_amdgcn_s_sleep(32); }
#endif
}

extern "C" void kernel_launch(void* const* d_in, const int* in_sizes, int n_in, void* d_out, int out_size, void* d_ws, size_t ws_size, hipStream_t stream) {
    static int grid = 0;
    if (grid == 0) {
        if (n_in != 21 || out_size != M * D || ws_size < WS_END2) { fprintf(stderr, "kernel_launch: unexpected shapes (n_in %d, out %d, ws %zu)\n", n_in, out_size, ws_size); grid = -1; return; }
        int dev = 0, cus = 0, per_cu = 0;
        if (hipGetDevice(&dev) != hipSuccess || hipDeviceGetAttribute(&cus, hipDeviceAttributeMultiprocessorCount, dev) != hipSuccess) { grid = -1; return; }
        if (hipFuncSetAttribute((const void*)trunk_fwd, hipFuncAttributeMaxDynamicSharedMemorySize, LDS_BYTES) != hipSuccess) { fprintf(stderr, "kernel_launch: hipFuncSetAttribute failed\n"); grid = -1; return; }
        if (hipOccupancyMaxActiveBlocksPerMultiprocessor(&per_cu, (const void*)trunk_fwd, NTHR, LDS_BYTES) != hipSuccess || per_cu < 1) { fprintf(stderr, "kernel_launch: occupancy query says %d\n", per_cu); }
        (void)hipGetLastError();
        grid = cus > 256 ? 256 : cus;
    }
    if (grid < 0) return;
    if (hipMemsetAsync((char*)d_ws + WS_CTL, 0, CTL_ZERO_BYTES, stream) != hipSuccess) return;
    Args a{};
    for (int i = 0; i < 21; ++i) a.in[i] = (const float*)d_in[i];
    a.out = (float*)d_out; a.ws = (unsigned char*)d_ws;
    hipLaunchKernelGGL(trunk_fwd, dim3(grid), dim3(NTHR), LDS_BYTES, stream, a);
}
```

```cpp
#include <hip/hip_runtime.h>
#include <cstdio>
#include <cstdint>
namespace pg8 {
#define PG8_LAS __attribute__((address_space(3)))
typedef unsigned short bf16_t;
typedef short bf16x8 __attribute__((ext_vector_type(8)));
typedef float f32x4 __attribute__((ext_vector_type(4)));
typedef unsigned u32x4 __attribute__((ext_vector_type(4)));
constexpr int BM = 256, BK = 64, HALF = 128, HTB = HALF * BK * 2  , STAGE_BYTES = 8 * HTB, NXCD = 8, WGM = 8;

__host__ __device__ __forceinline__ int lds_byte(int r, int c) { const int st = (r >> 4) * 2 + (c >> 5), rr = r & 15, cc = c & 31, ob = rr * 64 + cc * 2; return st * 1024 + (ob ^ (((ob >> 9) & 1) << 5)); }
__host__ __device__ __forceinline__ void stage_rc(int b, int& R, int& C) { const int st = b / 1024, sb = b % 1024, swz = sb ^ (((sb >> 9) & 1) << 5); R = (st >> 1) * 16 + swz / 64; C = (st & 1) * 32 + (swz % 64) / 2; }
__host__ __device__ __forceinline__ int perm32(int rho) { const int n = rho >> 4, i = rho & 15; return 8 * (i >> 2) + 4 * n + (i & 3); }

struct Unit { int pm, pn; };
struct Gemm { const bf16_t* A; const bf16_t* Bt; int M, N, K; };

struct StaticOrder {
    int nM, nN, nwg, G, c, wgm;
    __host__ __device__ void init(int M, int N, int G_, int c_, int wgm_ = 4) { nM = M / BM; nN = N / BM; nwg = nM * nN; G = G_; c = c_; wgm = wgm_; }
    __host__ __device__ bool next(int i, Unit& u) const {
        const long L = (long)i * G + c; if (L >= nwg) return false;
        int wgid = (int)L; { const int q = nwg / NXCD, r = nwg % NXCD, xcd = wgid % NXCD, off = wgid / NXCD; wgid = (xcd < r ? xcd * (q + 1) : r * (q + 1) + (xcd - r) * q) + off; }
        const int nig = wgm * nN, gid = wgid / nig, fm = gid * wgm, gsz = (nM - fm) < wgm ? (nM - fm) : wgm;
        u.pm = fm + ((wgid % nig) % gsz); u.pn = (wgid % nig) / gsz; return true;
    }
    __device__ __forceinline__ void a_ready(const Unit&) const {}
    __device__ __forceinline__ void done(const Unit&) const {}
};

__device__ __forceinline__ unsigned cvt_pk_bf16(float lo, float hi) { unsigned r; asm volatile("v_cvt_pk_bf16_f32 %0, %1, %2" : "=v"(r) : "v"(lo), "v"(hi)); return r; }
typedef float f32x2 __attribute__((ext_vector_type(2)));
template <class Epi, class Sched, bool ALIGN_EPI = false, bool SP2 = false>
__device__ __forceinline__ void gemm_phase(PG8_LAS unsigned char* lds, const Gemm g, const Sched& S, const Epi& E) {
    int tid_l = threadIdx.x; asm volatile("" : "+v"(tid_l));
    const int tid = tid_l, wid = __builtin_amdgcn_readfirstlane(tid >> 6), lane = tid & 63, wr = wid >> 2, wc = wid & 3, fr = lane & 15, fq = lane >> 4;
    const int K = g.K, nt = K / BK;
    unsigned voffA[2], voffB[2];
#pragma unroll
    for (int i = 0; i < 2; ++i) { int R, C; stage_rc(tid * 16 + i * 8192, R, C); const int Rb = Epi::PERM ? ((R & ~31) + perm32(R & 31)) : R;
        voffA[i] = (unsigned)(R * K + C) * 2u; voffB[i] = (unsigned)(Rb * K + C) * 2u; }
    const size_t kstep = (size_t)(BK * 2);
    const size_t hstep = (size_t)HALF * K * 2;
    const size_t tstep = 2 * hstep;
    const unsigned ldsw = (unsigned)wid * 1024u;
    const int aoff = lds_byte(wr * 64 + fr, fq * 8), boff = lds_byte(wc * 32 + fr, fq * 8);
#define PG8_SA(b, h) (((b) * 2 + (h)) * HTB)
#define PG8_SB(b, h) ((4 + (b) * 2 + (h)) * HTB)
#define PG8_STAGE(bufoff, gbase, voff) do { _Pragma("unroll") for (int _i = 0; _i < 2; ++_i) \
        __builtin_amdgcn_global_load_lds((const unsigned*)((const char*)(gbase) + (voff)[_i]), (PG8_LAS unsigned*)(lds + (bufoff) + ldsw + _i * 8192), 16, 0, 0); } while (0)
#define PG8_LDA(dst, b, h) do { _Pragma("unroll") for (int m = 0; m < 4; ++m) _Pragma("unroll") for (int k = 0; k < 2; ++k) dst[m][k] = *(const PG8_LAS bf16x8*)(lds + PG8_SA(b, h) + aoff + m * 2048 + k * 1024); } while (0)
#define PG8_LDB(dst, b, h) do { _Pragma("unroll") for (int n = 0; n < 2; ++n) _Pragma("unroll") for (int k = 0; k < 2; ++k) dst[n][k] = *(const PG8_LAS bf16x8*)(lds + PG8_SB(b, h) + boff + n * 2048 + k * 1024); } while (0)
#define PG8_MMA(ai, bj, At, Bt) do { __builtin_amdgcn_s_setprio(1); _Pragma("unroll") for (int m = 0; m < 4; ++m) _Pragma("unroll") for (int n = 0; n < 2; ++n) _Pragma("unroll") for (int k = 0; k < 2; ++k) \
        acc[ai][bj][m][n] = __builtin_amdgcn_mfma_f32_16x16x32_bf16(Bt[n][k], At[m][k], acc[ai][bj][m][n], 0, 0, 0); __builtin_amdgcn_s_setprio(0); } while (0)
#define PG8_WAIT_V(n) asm volatile("s_waitcnt vmcnt(" #n ")" ::: "memory")
#define PG8_WAIT_L(n) asm volatile("s_waitcnt lgkmcnt(" #n ")" ::: "memory")
#define PG8_BAR __builtin_amdgcn_s_barrier()
#define PG8_SCHED __builtin_amdgcn_sched_barrier(0)
    Unit cur, nxt; int ui = 0;
    if (!S.next(0, cur)) return;
    f32x4 acc[2][2][4][2];
#pragma unroll
    for (int a = 0; a < 2; ++a)
#pragma unroll
        for (int b = 0; b < 2; ++b)
#pragma unroll
            for (int m = 0; m < 4; ++m)
#pragma unroll
                for (int n = 0; n < 2; ++n) acc[a][b][m][n] = (f32x4){0.f, 0.f, 0.f, 0.f};
    bf16x8 At[4][2], B0[2][2], B1[2][2];
    const char* cA = (const char*)g.A + (size_t)cur.pm * tstep; const char* cB = (const char*)g.Bt + (size_t)cur.pn * tstep;
    S.a_ready(cur);
    if constexpr (SP2) {
        PG8_STAGE(PG8_SB(0, 0), cB, voffB); PG8_STAGE(PG8_SB(0, 1), cB + hstep, voffB); PG8_STAGE(PG8_SA(0, 0), cA, voffA); PG8_STAGE(PG8_SA(0, 1), cA + hstep, voffA);
        if (wr == 1) PG8_BAR;
        PG8_WAIT_V(2); PG8_BAR;
        PG8_STAGE(PG8_SB(1, 0), cB + kstep, voffB); PG8_STAGE(PG8_SA(1, 0), cA + kstep, voffA); PG8_STAGE(PG8_SB(1, 1), cB + hstep + kstep, voffB);
        PG8_WAIT_V(6); PG8_BAR;
    } else {
        PG8_STAGE(PG8_SB(0, 0), cB, voffB); PG8_STAGE(PG8_SA(0, 0), cA, voffA); PG8_STAGE(PG8_SB(0, 1), cB + hstep, voffB); PG8_STAGE(PG8_SA(0, 1), cA + hstep, voffA);
        if (wr == 1) PG8_BAR;
        PG8_WAIT_V(4); PG8_BAR;
        PG8_STAGE(PG8_SB(1, 0), cB + kstep, voffB); PG8_STAGE(PG8_SA(1, 0), cA + kstep, voffA); PG8_STAGE(PG8_SB(1, 1), cB + hstep + kstep, voffB);
        PG8_WAIT_V(6); PG8_BAR;
    }
    for (;;) {
        const bool has_next = S.next(ui + 1, nxt);
        const char* nA = has_next ? (const char*)g.A + (size_t)nxt.pm * tstep : cA; const char* nB = has_next ? (const char*)g.Bt + (size_t)nxt.pn * tstep : cB;
        for (int t = 0; t < nt; t += 2) {
            const bool last = (t == nt - 2);
            const char* a1 = cA + (size_t)(t + 1) * kstep;
            const char* a2 = last ? nA : cA + (size_t)(t + 2) * kstep; const char* b2 = last ? nB : cB + (size_t)(t + 2) * kstep;
            const char* a3 = a2 + kstep; const char* b3 = b2 + kstep;
            if (last && has_next) S.a_ready(nxt);
            if constexpr (SP2) {
            PG8_LDB(B0, 0, 0); PG8_LDB(B1, 0, 1); PG8_SCHED; PG8_LDA(At, 0, 0); PG8_STAGE(PG8_SA(1, 1), a1 + hstep, voffA);
            PG8_WAIT_V(8); PG8_WAIT_L(0); PG8_BAR; PG8_MMA(0, 0, At, B0); PG8_MMA(0, 1, At, B1); PG8_BAR; PG8_SCHED;
            PG8_LDA(At, 0, 1); PG8_STAGE(PG8_SB(0, 0), b2, voffB); PG8_STAGE(PG8_SB(0, 1), b2 + hstep, voffB); PG8_STAGE(PG8_SA(0, 0), a2, voffA);
            PG8_WAIT_V(8); PG8_WAIT_L(0); PG8_BAR; PG8_MMA(1, 0, At, B0); PG8_MMA(1, 1, At, B1); PG8_BAR; PG8_SCHED;
            PG8_LDB(B0, 1, 0); PG8_LDB(B1, 1, 1); PG8_SCHED; PG8_LDA(At, 1, 0); PG8_STAGE(PG8_SA(0, 1), a2 + hstep, voffA);
            PG8_WAIT_V(8); PG8_WAIT_L(0); PG8_BAR; PG8_MMA(0, 0, At, B0); PG8_MMA(0, 1, At, B1); PG8_BAR; PG8_SCHED;
            PG8_LDA(At, 1, 1); PG8_STAGE(PG8_SB(1, 0), b3, voffB); PG8_STAGE(PG8_SB(1, 1), b3 + hstep, voffB); PG8_STAGE(PG8_SA(1, 0), a3, voffA);
            PG8_WAIT_V(8); PG8_WAIT_L(0); PG8_BAR; PG8_MMA(1, 0, At, B0); PG8_MMA(1, 1, At, B1); PG8_BAR; PG8_SCHED;
            } else {
            PG8_LDB(B0, 0, 0); PG8_SCHED; PG8_LDA(At, 0, 0); PG8_STAGE(PG8_SA(1, 1), a1 + hstep, voffA);
            PG8_WAIT_L(8); PG8_BAR; PG8_WAIT_L(0); PG8_MMA(0, 0, At, B0); PG8_BAR; PG8_SCHED;
            PG8_LDB(B1, 0, 1); PG8_STAGE(PG8_SB(0, 0), b2, voffB);
            PG8_BAR; PG8_WAIT_L(0); PG8_MMA(0, 1, At, B1); PG8_BAR;
            PG8_LDA(At, 0, 1); PG8_STAGE(PG8_SA(0, 0), a2, voffA);
            PG8_BAR; PG8_WAIT_L(0); PG8_MMA(1, 0, At, B0); PG8_BAR; PG8_SCHED;
            PG8_STAGE(PG8_SB(0, 1), b2 + hstep, voffB);
            PG8_WAIT_V(6); PG8_BAR; PG8_MMA(1, 1, At, B1); PG8_BAR;
            PG8_LDB(B0, 1, 0); PG8_SCHED; PG8_LDA(At, 1, 0); PG8_STAGE(PG8_SA(0, 1), a2 + hstep, voffA);
            PG8_WAIT_L(8); PG8_BAR; PG8_WAIT_L(0); PG8_MMA(0, 0, At, B0); PG8_BAR; PG8_SCHED;
            PG8_LDB(B1, 1, 1); PG8_STAGE(PG8_SB(1, 0), b3, voffB);
            PG8_BAR; PG8_WAIT_L(0); PG8_MMA(0, 1, At, B1); PG8_BAR;
            PG8_LDA(At, 1, 1); PG8_STAGE(PG8_SA(1, 0), a3, voffA);
            PG8_BAR; PG8_WAIT_L(0); PG8_MMA(1, 0, At, B0); PG8_BAR; PG8_SCHED;
            PG8_STAGE(PG8_SB(1, 1), b3 + hstep, voffB);
            PG8_WAIT_V(6); PG8_BAR; PG8_MMA(1, 1, At, B1); PG8_BAR;
            }
        }
        if constexpr (ALIGN_EPI) { if (wr == 0) PG8_BAR; }
#ifdef PROBE_EPI
        const unsigned long long te0_ = __builtin_amdgcn_s_memrealtime();
#endif
        if constexpr (!Epi::AFTER_DRAIN) { E(acc, cur, wr, wc, fr, fq); S.done(cur); }
#ifdef PROBE_EPI
        if (tid == 0) { volatile PG8_LAS unsigned long long* pe_ = (volatile PG8_LAS unsigned long long*)(lds + 131072 + 320 + 64); pe_[0] = pe_[0] + (__builtin_amdgcn_s_memrealtime() - te0_); }
#endif
        if (!has_next) break;
#pragma unroll
        for (int a = 0; a < 2; ++a)
#pragma unroll
            for (int b = 0; b < 2; ++b)
#pragma unroll
                for (int m = 0; m < 4; ++m)
#pragma unroll
                    for (int n = 0; n < 2; ++n) acc[a][b][m][n] = (f32x4){0.f, 0.f, 0.f, 0.f};
        cur = nxt; cA = nA; cB = nB; ++ui;
        if constexpr (ALIGN_EPI) { if (wr == 1) PG8_BAR; }
    }
    PG8_WAIT_V(0);
    if constexpr (!ALIGN_EPI) { if (wr == 0) PG8_BAR; }
    PG8_BAR;
    if constexpr (Epi::AFTER_DRAIN) { E.fused(acc, cur, wr, wc, fr, fq, lds, wid, lane); S.done(cur); }
#undef PG8_SA
#undef PG8_SB
#undef PG8_STAGE
#undef PG8_LDA
#undef PG8_LDB
#undef PG8_MMA
#undef PG8_WAIT_V
#undef PG8_WAIT_L
#undef PG8_BAR
#undef PG8_SCHED
}
}
#define GAS __attribute__((address_space(1)))
#define LAS __attribute__((address_space(3)))
typedef unsigned short bf16;
typedef unsigned v4u __attribute__((ext_vector_type(4)));
typedef float f32x4 __attribute__((ext_vector_type(4)));
typedef short bf16x8 __attribute__((ext_vector_type(8)));
typedef GAS unsigned gu32;
typedef GAS unsigned long long gu64;
#define RLX_AGENT __ATOMIC_RELAXED, __HIP_MEMORY_SCOPE_AGENT
#define LDS_WAIT() asm volatile("s_waitcnt lgkmcnt(0)" ::: "memory")
#define VM_WAIT() asm volatile("s_waitcnt vmcnt(0)" ::: "memory")
__device__ __forceinline__ unsigned long long rt() { return __builtin_amdgcn_s_memrealtime(); }
__device__ __forceinline__ unsigned f2bf(float f) { unsigned u = __builtin_bit_cast(unsigned, f); return (u + 0x7fffu + ((u >> 16) & 1u)) >> 16; }
__device__ __forceinline__ unsigned pk2(float lo, float hi) { return f2bf(lo) | (f2bf(hi) << 16); }
typedef unsigned u32x4 __attribute__((ext_vector_type(4)));
#define XB_TMO      128
#define XB_XCNT(j)  (256  + 64 * (j))
#define XB_XSUB(j)  (1280 + 64 * (j))
#define XB_XGEN(j)  (2304 + 64 * (j))
#define XB_TOP      3328
#define XB_TOPGEN   3392
#define XCD_BAR_WORDS 3456
#define XB_SPIN_CAP (1u << 18)

__device__ __forceinline__ unsigned xb_ld(unsigned* p)              { return __hip_atomic_load(p, __ATOMIC_RELAXED, __HIP_MEMORY_SCOPE_AGENT); }
__device__ __forceinline__ unsigned xb_add(unsigned* p, unsigned v) { return __hip_atomic_fetch_add(p, v, __ATOMIC_RELAXED, __HIP_MEMORY_SCOPE_AGENT); }
__device__ __forceinline__ unsigned xb_xcc_id() { return (unsigned)__builtin_amdgcn_s_getreg((3 << 11) | 20) & 0xFu; }
#define XB_SPIN(cond, bar) do { unsigned _sp = 0; while (cond) { __builtin_amdgcn_s_sleep(1); \
    if ((++_sp & 255u) == 0u) { if (xb_ld(&(bar)[XB_TMO])) break; if (_sp > XB_SPIN_CAP) { atomicAdd(&(bar)[XB_TMO], 1u); break; } } } } while (0)

struct XcdBarrier {
    unsigned* bar; unsigned x;
    volatile LAS unsigned* st;
};

__device__ __forceinline__ XcdBarrier xcd_barrier_post(unsigned* bar, volatile LAS unsigned* st) {
    XcdBarrier b; b.bar = bar; b.x = xb_xcc_id(); b.st = st;
    if (threadIdx.x == 0) (void)xb_add(&bar[XB_XCNT(b.x)], 1u);
    return b;
}
__device__ __forceinline__ void xcd_barrier_complete(unsigned* bar, unsigned x, unsigned& nloc, unsigned& nx) {
    const unsigned G = gridDim.x * gridDim.y * gridDim.z;
    unsigned sum, cnt, mine, sp = 0u;
    for (;;) {
        sum = 0u; cnt = 0u; mine = 0u;
#pragma unroll
        for (unsigned j = 0; j < 16; ++j) { const unsigned c = xb_ld(&bar[XB_XCNT(j)]); sum += c; cnt += (c > 0u) ? 1u : 0u; mine = (j == x) ? c : mine; }
        if (sum == G) break;
        __builtin_amdgcn_s_sleep(1);
        if ((++sp & 255u) == 0u) { if (xb_ld(&bar[XB_TMO])) break; if (sp > XB_SPIN_CAP) { atomicAdd(&bar[XB_TMO], 1u); break; } }
    }
    nloc = mine > 0u ? mine : 1u; nx = cnt > 0u ? cnt : 1u;
}

__device__ __forceinline__ void xcd_barrier(const XcdBarrier& b) {
    asm volatile("s_waitcnt vmcnt(0)" ::: "memory");
    __syncthreads();
    if (threadIdx.x == 0) {
        unsigned* bar = b.bar;
        __builtin_amdgcn_s_waitcnt(0);
        unsigned nloc = b.st[0], nx = b.st[1];
        if (nloc == 0u) { xcd_barrier_complete(bar, b.x, nloc, nx); b.st[0] = nloc; b.st[1] = nx; }
        const unsigned old = xb_add(&bar[XB_XSUB(b.x)], 1u);
        const unsigned gen = old / nloc;
        if (old + 1u == (gen + 1u) * nloc) {
            __builtin_amdgcn_fence(__ATOMIC_RELEASE, "agent");
            asm volatile("s_waitcnt vmcnt(0)" ::: "memory");
            const unsigned og = xb_add(&bar[XB_TOP], 1u);
            const unsigned tg = og / nx;
            if (og + 1u == (tg + 1u) * nx) xb_add(&bar[XB_TOPGEN], 1u);
            else XB_SPIN(xb_ld(&bar[XB_TOPGEN]) == tg, bar);
            __builtin_amdgcn_fence(__ATOMIC_ACQUIRE, "agent");
            xb_add(&bar[XB_XGEN(b.x)], 1u);
            asm volatile("s_waitcnt vmcnt(0)" ::: "memory");
        } else {
            XB_SPIN(xb_ld(&bar[XB_XGEN(b.x)]) == gen, bar);
            __builtin_amdgcn_fence(__ATOMIC_ACQUIRE, "agent");
            asm volatile("s_waitcnt vmcnt(0)" ::: "memory");
        }
    }
    __syncthreads();
}

constexpr int NWAVES = 8, NTHR = 512;
constexpr int BATCH = 4, SEQ = 8192, M = BATCH * SEQ, D = 2048, NH = 16, HD = 128, FF = 8192, PLE = 256, DEPTH = 4;
constexpr int NA_IN = 6144, NB_IN = 4176, NB_PAD = 4352, NC_IN = 6160, NC_PAD = 6400;
constexpr int B_K = 2048, B_V = 2560, B_QI = 3072, B_KI = 4096, B_WI = 4160;
constexpr float RMS_EPS = 1e-6f, LOG2E = 1.4426950408889634f;
constexpr float QSCALE = 0.08838834764831845f * 1.4426950408889634f;
constexpr float ZERO_LOG2 = -160.f;

constexpr size_t MiB = 1u << 20;
constexpr size_t WS_CTL = 0, CTL_ZERO_BYTES = 1 * MiB;
constexpr size_t WS_ROPE32 = 1 * MiB, WS_ROPE16 = 2 * MiB, WS_CUM = 3 * MiB, WS_TOT = 5 * MiB, WS_RSTD = 6 * MiB;
constexpr size_t WS_WIN = 8 * MiB, WS_WO = 33 * MiB, WS_WUP = 41 * MiB, WS_WDN = 73 * MiB, WS_WG = 105 * MiB, WS_WPL = 113 * MiB;
constexpr size_t WS_PB = 120 * MiB, WS_HN = 184 * MiB, WS_PROJ = 312 * MiB, WS_MIX = 712 * MiB, WS_VT = 840 * MiB, WS_END = 968 * MiB;
constexpr size_t WS_HID = WS_PROJ, WS_PP = WS_VT, WS_HB0 = WS_HN, WS_HB1 = 968 * MiB, WS_SSP_IN = 1096 * MiB, WS_SSP_WO = 1100 * MiB, WS_SSP_DN = 1104 * MiB, WS_K8 = 1108 * MiB, WS_V8 = 1124 * MiB, WS_Q8 = 1140 * MiB, WS_END2 = 1204 * MiB;
constexpr size_t WS_SCR_A = WS_PROJ + 272 * MiB, WS_SCR_B = WS_VT;
static_assert(WS_HID + (size_t)M * FF * 2 <= WS_VT, "hidden overlays proj|mix");
static_assert(WS_PROJ + (size_t)M * NB_PAD * 2 <= WS_SCR_A && WS_SCR_A + 128 * MiB <= WS_MIX, "scratch A");

constexpr int CW_BAR = 4096;
constexpr int CW_QUEUE = 16384;

constexpr int RING_OFF = 0, RING_BYTES = 131072;
constexpr int LDSCTL_OFF = RING_BYTES, MISC_OFF = LDSCTL_OFF + 320;
constexpr int LDS_BYTES = 147456;

typedef float f32x16 __attribute__((ext_vector_type(16)));
typedef unsigned u32x2 __attribute__((ext_vector_type(2)));
typedef __bf16 bf16x2_t __attribute__((ext_vector_type(2)));
typedef float f32x2_t __attribute__((ext_vector_type(2)));
typedef short s16x4_t __attribute__((ext_vector_type(4)));

__device__ __forceinline__ float bf2f(unsigned short b) { return __builtin_bit_cast(float, (unsigned)b << 16); }
__device__ __forceinline__ float bflo(unsigned u) { return __builtin_bit_cast(float, u << 16); }
__device__ __forceinline__ float bfhi(unsigned u) { return __builtin_bit_cast(float, u & 0xffff0000u); }
__device__ __forceinline__ float relu_raw(float x) { const int i = __builtin_bit_cast(int, x); return __builtin_bit_cast(float, i > 0 ? i : 0); }
__device__ __forceinline__ unsigned cvtpk(float lo, float hi) { f32x2_t v = {lo, hi}; bf16x2_t b = __builtin_convertvector(v, bf16x2_t); return __builtin_bit_cast(unsigned, b); }
__device__ __forceinline__ float wave_sum(float v) {
#pragma unroll
    for (int o = 1; o < 64; o <<= 1) v += __shfl_xor(v, o);
    return v;
}
__device__ __forceinline__ float wave_max(float v) {
#pragma unroll
    for (int o = 1; o < 64; o <<= 1) v = fmaxf(v, __shfl_xor(v, o));
    return v;
}
__device__ __forceinline__ float wave_min(float v) {
#pragma unroll
    for (int o = 1; o < 64; o <<= 1) v = fminf(v, __shfl_xor(v, o));
    return v;
}
__device__ __forceinline__ float fexp2(float x) { return __builtin_amdgcn_exp2f(x); }
__device__ __forceinline__ float flog2(float x) { return __builtin_amdgcn_logf(x); }

namespace pg8 {
__device__ __forceinline__ void row_rstd(const float* ssp, int rowbase, int fr, int fq, float (&rs)[2][4]) {
    float mine[2];
#pragma unroll
    for (int t = 0; t < 2; ++t) { const int row = rowbase + (fq >> 1) * HALF + (2 * (fq & 1) + t) * 16 + fr;
        const f32x4* p = (const f32x4*)(ssp + (size_t)row * 32); float sm = 0.f;
#pragma unroll
        for (int q = 0; q < 8; ++q) { const f32x4 v = p[q]; sm += (v.x + v.y) + (v.z + v.w); }
        mine[t] = 1.f / sqrtf(sm * (1.f / 2048.f) + 1e-6f); }
#pragma unroll
    for (int ai = 0; ai < 2; ++ai)
#pragma unroll
        for (int m = 0; m < 4; ++m) { const int src = (ai * 2 + (m >> 1)) * 16 + fr; const float a = __shfl(mine[0], src), b = __shfl(mine[1], src); rs[ai][m] = (m & 1) ? b : a; }
}
template <int ACT  , bool SCALE>
struct EpiStore {
    static constexpr bool PERM = true, AFTER_DRAIN = false;
    bf16_t* O; int ldc; const float* ssp;
    __device__ __forceinline__ void operator()(const f32x4 (&acc)[2][2][4][2], const Unit& u, int wr, int wc, int fr, int fq) const {
        const int row0 = u.pm * BM + wr * 64 + fr, col0 = u.pn * BM + wc * 32 + 8 * fq;
        float rs[2][4];
        if (SCALE) row_rstd(ssp, u.pm * BM + wr * 64, fr, fq, rs);
#pragma unroll
        for (int ai = 0; ai < 2; ++ai)
#pragma unroll
            for (int m = 0; m < 4; ++m) { bf16_t* rowp = O + (size_t)(row0 + ai * HALF + m * 16) * ldc + col0; const float r = SCALE ? rs[ai][m] : 1.f;
#pragma unroll
                for (int bj = 0; bj < 2; ++bj) { f32x4 v0 = acc[ai][bj][m][0] * r, v1 = acc[ai][bj][m][1] * r;
                    if (ACT == 1) {
#pragma unroll
                        for (int e = 0; e < 4; ++e) { v0[e] = fmaxf(v0[e], 0.f); v0[e] *= v0[e]; v1[e] = fmaxf(v1[e], 0.f); v1[e] *= v1[e]; } }
                    u32x4 w; w.x = cvtpk(v0[0], v0[1]); w.y = cvtpk(v0[2], v0[3]); w.z = cvtpk(v1[0], v1[1]); w.w = cvtpk(v1[2], v1[3]);
                    *(u32x4*)(rowp + bj * HALF) = w; } }
    }
};
template <bool GATE  , bool FINAL  , bool SQ = false  >
struct EpiH {
    static constexpr bool PERM = true, AFTER_DRAIN = false;
    const bf16_t* hin; bf16_t* hout; float* sspo; const bf16_t* pp; const float* sspi; float* outf;
    __device__ __forceinline__ void operator()(const f32x4 (&acc)[2][2][4][2], const Unit& u, int wr, int wc, int fr, int fq) const {
        constexpr int ld = 2048;
        const int row0 = u.pm * BM + wr * 64 + fr, col0 = u.pn * BM + wc * 32 + 8 * fq;
        float rs[2][4];
        u32x4 rh[2][2], rp[2][2];
        { const size_t off = (size_t)row0 * ld + col0;
#pragma unroll
          for (int bj = 0; bj < 2; ++bj) { rh[0][bj] = *(const u32x4*)(hin + off + bj * HALF); if (GATE) rp[0][bj] = *(const u32x4*)(pp + off + bj * HALF); } }
        if (GATE || SQ) row_rstd(sspi, u.pm * BM + wr * 64, fr, fq, rs);
#pragma unroll
        for (int r = 0; r < 8; ++r) { const int ai = r >> 2, m = r & 3, cb = r & 1, nb = cb ^ 1;
            const int row = row0 + ai * HALF + m * 16; const size_t off = (size_t)row * ld + col0;
            if (r + 1 < 8) { const int ai2 = (r + 1) >> 2, m2 = (r + 1) & 3; const size_t off2 = (size_t)(row0 + ai2 * HALF + m2 * 16) * ld + col0;
#pragma unroll
                for (int bj = 0; bj < 2; ++bj) { rh[nb][bj] = *(const u32x4*)(hin + off2 + bj * HALF); if (GATE) rp[nb][bj] = *(const u32x4*)(pp + off2 + bj * HALF); } }
            float ss = 0.f;
#pragma unroll
            for (int bj = 0; bj < 2; ++bj) { const u32x4 hv = rh[cb][bj];
                f32x4 a = {bflo(hv.x), bfhi(hv.x), bflo(hv.y), bfhi(hv.y)}, b = {bflo(hv.z), bfhi(hv.z), bflo(hv.w), bfhi(hv.w)};
                const f32x4 v0 = acc[ai][bj][m][0], v1 = acc[ai][bj][m][1];
                if (GATE) { const u32x4 p = rp[cb][bj]; const float rr = rs[ai][m] * (-LOG2E);
                    const f32x4 p0 = {bflo(p.x), bfhi(p.x), bflo(p.y), bfhi(p.y)}, p1 = {bflo(p.z), bfhi(p.z), bflo(p.w), bfhi(p.w)};
#pragma unroll
                    for (int e = 0; e < 4; ++e) { a[e] += __builtin_amdgcn_rcpf(1.f + fexp2(rr * v0[e])) * p0[e]; b[e] += __builtin_amdgcn_rcpf(1.f + fexp2(rr * v1[e])) * p1[e]; }
                } else if (SQ) { const float r2 = rs[ai][m] * rs[ai][m]; a += v0 * r2; b += v1 * r2; }
                else { a += v0; b += v1; }
                if (FINAL) { *(f32x4*)(outf + off + bj * HALF) = a; *(f32x4*)(outf + off + bj * HALF + 4) = b; }
                else { u32x4 w; w.x = cvtpk(a[0], a[1]); w.y = cvtpk(a[2], a[3]); w.z = cvtpk(b[0], b[1]); w.w = cvtpk(b[2], b[3]);
                    *(u32x4*)(hout + off + bj * HALF) = w;
                    ss += (a[0] * a[0] + a[1] * a[1]) + (a[2] * a[2] + a[3] * a[3]) + (b[0] * b[0] + b[1] * b[1]) + (b[2] * b[2] + b[3] * b[3]); } }
            if (!FINAL) { ss += __shfl_xor(ss, 16); ss += __shfl_xor(ss, 32);
                if (fq == 0) sspo[(size_t)row * 32 + u.pn * 4 + wc] = ss; } }
    }
};
}

struct Args { const float* in[21]; float* out; unsigned char* ws; };
enum { I_X = 0, I_P, I_ATTN_NORM, I_WO, I_MLP_NORM, I_WUP, I_WDOWN, I_PLE_NORM, I_WGATE, I_WPLE, I_A_WIN, I_A_QN, I_A_KN, I_B_WIN, I_B_QN, I_B_KN, I_B_IKN, I_C_WIN, I_C_BF, I_C_QN, I_C_KN };

__device__ __forceinline__ void transpose_item(const float* W, const float* gain, int K, int N, bf16* WT, int kb, int nb, int lane) {
    const int k0 = 64 * kb, n = 64 * nb + lane; const bool ok = n < N;
    const float* src = W + (size_t)k0 * N + (ok ? n : 0);
    float v[64];
#pragma unroll
    for (int r = 0; r < 64; ++r) v[r] = src[(size_t)r * N];
    if (gain) {
#pragma unroll
        for (int r = 0; r < 64; ++r) v[r] *= gain[k0 + r];
    }
    bf16* dst = WT + (size_t)n * K + k0;
#pragma unroll
    for (int c = 0; c < 8; ++c) { v4u o;
        o.x = ok ? cvtpk(v[8 * c + 0], v[8 * c + 1]) : 0u; o.y = ok ? cvtpk(v[8 * c + 2], v[8 * c + 3]) : 0u; o.z = ok ? cvtpk(v[8 * c + 4], v[8 * c + 5]) : 0u; o.w = ok ? cvtpk(v[8 * c + 6], v[8 * c + 7]) : 0u;
        *(v4u*)(dst + 8 * c) = o; }
}
__device__ __forceinline__ void convert_weight(const float* W, const float* gain, int K, int N, int Npad, bf16* WT, LAS float* scr, int gw, int ngw, int lane) {
    const int nblk = Npad / 64, nitems = (K / 64) * nblk;
    for (int it = gw; it < nitems; it += ngw) transpose_item(W, gain, K, N, WT, it / nblk, it % nblk, lane);
}
__device__ __forceinline__ void x_rows(const float* src, bf16* hb, float* ssp, int gw, int ngw, int lane) {
    for (int m = gw; m < M; m += ngw) {
        const f32x4* xr = (const f32x4*)(src + (size_t)m * D) + lane;
        f32x4 v[8]; float ss = 0.f;
#pragma unroll
        for (int j = 0; j < 8; ++j) { v[j] = xr[64 * j]; ss += (v[j].x * v[j].x + v[j].y * v[j].y) + (v[j].z * v[j].z + v[j].w * v[j].w); }
        ss = wave_sum(ss);
        unsigned long long* o8 = (unsigned long long*)(hb + (size_t)m * D) + lane;
#pragma unroll
        for (int j = 0; j < 8; ++j) o8[64 * j] = (unsigned long long)cvtpk(v[j].x, v[j].y) | ((unsigned long long)cvtpk(v[j].z, v[j].w) << 32);
        if (lane < 32) ssp[(size_t)m * 32 + lane] = lane == 0 ? ss : 0.f;
    }
}

__device__ __forceinline__ void rmsnorm_rows(const float* src, const float* g, bf16* dst, int gw, int ngw, int lane) {
    for (int m = gw; m < M; m += ngw) {
        const f32x4* xr = (const f32x4*)(src + (size_t)m * D) + lane;
        f32x4 v[8]; float ss = 0.f;
#pragma unroll
        for (int j = 0; j < 8; ++j) { v[j] = xr[64 * j]; ss += (v[j].x * v[j].x + v[j].y * v[j].y) + (v[j].z * v[j].z + v[j].w * v[j].w); }
        const float rstd = 1.f / sqrtf(wave_sum(ss) * (1.f / D) + RMS_EPS);
        unsigned long long* o8 = (unsigned long long*)(dst + (size_t)m * D) + lane;
#pragma unroll
        for (int j = 0; j < 8; ++j) { const f32x4 gg = ((const f32x4*)g)[lane + 64 * j];
            o8[64 * j] = (unsigned long long)cvtpk(v[j].x * rstd * gg.x, v[j].y * rstd * gg.y) | ((unsigned long long)cvtpk(v[j].z * rstd * gg.z, v[j].w * rstd * gg.w) << 32); }
    }
}

template <bool ROPE>
__device__ __forceinline__ void head128_norm(bf16* p, const u32x4 raw, const float a  , const float* gain, float scale, const float2* rope, int lane, unsigned char* f8out = nullptr) {
    float x[8] = {bflo(raw.x), bfhi(raw.x), bflo(raw.y), bfhi(raw.y), bflo(raw.z), bfhi(raw.z), bflo(raw.w), bfhi(raw.w)};
    float ss = 0.f;
#pragma unroll
    for (int e = 0; e < 8; ++e) ss += x[e] * x[e];
    ss += __shfl_xor(ss, 1); ss += __shfl_xor(ss, 2); ss += __shfl_xor(ss, 4); ss += __shfl_xor(ss, 8);
    const float rstd = a / sqrtf(a * a * ss * (1.f / 128.f) + RMS_EPS);
    const int lh = lane & 15;
    const f32x4 g0 = *(const f32x4*)(gain + 8 * lh), g1 = *(const f32x4*)(gain + 8 * lh + 4);
    const float gg[8] = {g0.x, g0.y, g0.z, g0.w, g1.x, g1.y, g1.z, g1.w};
#pragma unroll
    for (int e = 0; e < 8; ++e) x[e] = x[e] * rstd * gg[e];
    if (ROPE) {
        float px[8];
#pragma unroll
        for (int e = 0; e < 8; ++e) px[e] = __shfl_xor(x[e], 2);
        if (lh < 4) {
#pragma unroll
            for (int e = 0; e < 8; ++e) { const float2 cs = rope[8 * (lh & 1) + e];
                x[e] = (lh < 2) ? (x[e] * cs.x - px[e] * cs.y) : (px[e] * cs.y + x[e] * cs.x); }
        }
    }
    if (f8out) {
        int w0 = 0, w1 = 0;
        w0 = __builtin_amdgcn_cvt_pk_fp8_f32(x[0] * scale, x[1] * scale, w0, false); w0 = __builtin_amdgcn_cvt_pk_fp8_f32(x[2] * scale, x[3] * scale, w0, true);
        w1 = __builtin_amdgcn_cvt_pk_fp8_f32(x[4] * scale, x[5] * scale, w1, false); w1 = __builtin_amdgcn_cvt_pk_fp8_f32(x[6] * scale, x[7] * scale, w1, true);
        *(u32x2*)f8out = (u32x2){(unsigned)w0, (unsigned)w1};
    } else {
        u32x4 w; w.x = cvtpk(x[0] * scale, x[1] * scale); w.y = cvtpk(x[2] * scale, x[3] * scale); w.z = cvtpk(x[4] * scale, x[5] * scale); w.w = cvtpk(x[6] * scale, x[7] * scale);
        *(u32x4*)p = w;
    }
}
template <bool NORM>
__device__ __forceinline__ void head64_rope(bf16* p, const u32x4 raw, const float a, const float* gain, const float2* rope, int lane, bool active) {
    float x[8] = {bflo(raw.x) * a, bfhi(raw.x) * a, bflo(raw.y) * a, bfhi(raw.y) * a, bflo(raw.z) * a, bfhi(raw.z) * a, bflo(raw.w) * a, bfhi(raw.w) * a};
    const int li = lane & 7;
    if (NORM) {
        float ss = 0.f;
#pragma unroll
        for (int e = 0; e < 8; ++e) ss += x[e] * x[e];
        ss += __shfl_xor(ss, 1); ss += __shfl_xor(ss, 2); ss += __shfl_xor(ss, 4);
        const float rstd = 1.f / sqrtf(ss * (1.f / 64.f) + RMS_EPS);
        const f32x4 g0 = *(const f32x4*)(gain + 8 * li), g1 = *(const f32x4*)(gain + 8 * li + 4);
        const float gg[8] = {g0.x, g0.y, g0.z, g0.w, g1.x, g1.y, g1.z, g1.w};
#pragma unroll
        for (int e = 0; e < 8; ++e) x[e] = x[e] * rstd * gg[e];
    }
    float px[8];
#pragma unroll
    for (int e = 0; e < 8; ++e) px[e] = __shfl_xor(x[e], 1);
    if (li < 2) {
#pragma unroll
        for (int e = 0; e < 8; ++e) { const float2 cs = rope[e];
            x[e] = (li == 0) ? (x[e] * cs.x - px[e] * cs.y) : (px[e] * cs.y + x[e] * cs.x); }
    }
    if (active) { u32x4 w; w.x = cvtpk(x[0], x[1]); w.y = cvtpk(x[2], x[3]); w.z = cvtpk(x[4], x[5]); w.w = cvtpk(x[6], x[7]); *(u32x4*)p = w; }
}

__device__ __forceinline__ void vt_item(const bf16* proj, int ldp, int voff, const float* rstdv, bf16* VT, LAS unsigned char* tile, int item, int lane) {
    const int h = item & 15, tc = (item >> 4) & 255, b = item >> 12;
    const size_t row0 = (size_t)b * SEQ + 32 * tc;
#pragma unroll
    for (int i = 0; i < 8; ++i) { const int tok = 4 * i + (lane >> 4), ch = lane & 15;
        const u32x4 v = *(const u32x4*)(proj + (row0 + tok) * ldp + voff + h * 128 + ch * 8); const float a = rstdv[row0 + tok];
        LAS u32x2* d = (LAS u32x2*)(tile + tok * 264 + ch * 16);
        d[0] = (u32x2){cvtpk(bflo(v.x) * a, bfhi(v.x) * a), cvtpk(bflo(v.y) * a, bfhi(v.y) * a)}; d[1] = (u32x2){cvtpk(bflo(v.z) * a, bfhi(v.z) * a), cvtpk(bflo(v.w) * a, bfhi(v.w) * a)}; }
    LDS_WAIT(); asm volatile("" ::: "memory");
#pragma unroll
    for (int i = 0; i < 8; ++i) { const int d = 16 * i + (lane >> 2), tg = lane & 3;
        const LAS unsigned short* s = (const LAS unsigned short*)(tile + (8 * tg) * 264 + d * 2);
        u32x4 w; w.x = (unsigned)s[0] | ((unsigned)s[132] << 16); w.y = (unsigned)s[2 * 132] | ((unsigned)s[3 * 132] << 16);
        w.z = (unsigned)s[4 * 132] | ((unsigned)s[5 * 132] << 16); w.w = (unsigned)s[6 * 132] | ((unsigned)s[7 * 132] << 16);
        *(u32x4*)(VT + ((size_t)(b * 16 + h) * 128 + d) * SEQ + 32 * tc + 8 * tg) = w; }
    LDS_WAIT(); asm volatile("" ::: "memory");
}

__device__ __forceinline__ void cumchunk_item(const bf16* proj, int ldp, const float* rstdv, const float* bfv, float* cum2, float* tot, int item, int lane) {
    const int b = item >> 7, ch = item & 127; const int t = 64 * ch + lane;
    const bf16* gp = proj + ((size_t)b * SEQ + t) * ldp + 3 * D;
    const u32x4 g0 = *(const u32x4*)gp, g1 = *(const u32x4*)(gp + 8);
    const float x[16] = {bflo(g0.x), bfhi(g0.x), bflo(g0.y), bfhi(g0.y), bflo(g0.z), bfhi(g0.z), bflo(g0.w), bfhi(g0.w), bflo(g1.x), bfhi(g1.x), bflo(g1.y), bfhi(g1.y), bflo(g1.z), bfhi(g1.z), bflo(g1.w), bfhi(g1.w)};
    const float a = rstdv[(size_t)b * SEQ + t];
#pragma unroll
    for (int h = 0; h < 16; ++h) { const float y = x[h] * a + bfv[h];
        float lf = -(fmaxf(-y, 0.f) + log1pf(expf(-fabsf(y)))) * LOG2E;
#pragma unroll
        for (int o = 1; o < 64; o <<= 1) { const float u = __shfl_up(lf, o); if (lane >= o) lf += u; }
        cum2[((size_t)(b * 16 + h)) * SEQ + t] = lf;
        if (lane == 63) tot[(b * 16 + h) * 128 + ch] = lf; }
}

#define MFMA32(a, b, c) __builtin_amdgcn_mfma_f32_32x32x16_bf16((a), (b), (c), 0, 0, 0)
#define MFMA16(a, b, c) __builtin_amdgcn_mfma_f32_16x16x32_bf16((a), (b), (c), 0, 0, 0)
template <int MODE>
__device__ __forceinline__ void attn_dense_item(const bf16* proj, int ldp, const bf16* VT, const float* cum2, bf16* mix, float zb2, int qt, int bh, int lane) {
    const int b = bh >> 4, h = bh & 15;
    const int n = lane & 31, hi = lane >> 5, q0 = 32 * qt;
    const size_t row0 = (size_t)b * SEQ;
    const int prow = (n & 0x13) | ((n & 4) << 1) | ((n & 8) >> 1);
    bf16x8 qf[8];
    { const bf16* qp = proj + (row0 + q0 + n) * ldp + h * 128 + hi * 8;
#pragma unroll
      for (int kk = 0; kk < 8; ++kk) qf[kk] = *(const bf16x8*)(qp + kk * 16); }
    f32x16 o[4];
#pragma unroll
    for (int d = 0; d < 4; ++d)
#pragma unroll
        for (int i = 0; i < 16; ++i) o[d][i] = 0.f;
    float R = 0.f, mrun = -1e30f, lrun = 0.f, cq = 0.f;
    const float* cb = cum2 + (size_t)bh * SEQ;
    if (MODE == 1) cq = cb[q0 + n];
    const int tq = q0 + n;
    const bf16* kbase = proj + (row0 + prow) * ldp + D + h * 128 + hi * 8;
    bf16x8 kf[8];
#pragma unroll
    for (int kk = 0; kk < 8; ++kk) kf[kk] = *(const bf16x8*)(kbase + (size_t)q0 * ldp + kk * 16);
    for (int kb = q0; kb >= 0; kb -= 32) {
        if (MODE == 0) { if (__all(R + zb2 < ZERO_LOG2)) break; }
        else { const float dmax = cb[q0] - cb[kb + 31]; if (dmax + 2.f * zb2 < ZERO_LOG2) break; }
        bf16x8 vf[4][2];
#pragma unroll
        for (int d = 0; d < 4; ++d)
#pragma unroll
            for (int s = 0; s < 2; ++s) vf[d][s] = *(const bf16x8*)(VT + ((size_t)bh * 128 + d * 32 + n) * SEQ + kb + 16 * s + 8 * hi);
        f32x16 sc;
#pragma unroll
        for (int i = 0; i < 16; ++i) sc[i] = 0.f;
#pragma unroll
        for (int kk = 0; kk < 8; ++kk) sc = MFMA32(kf[kk], qf[kk], sc);
        if (kb >= 32) {
#pragma unroll
            for (int kk = 0; kk < 8; ++kk) kf[kk] = *(const bf16x8*)(kbase + (size_t)(kb - 32) * ldp + kk * 16);
        }
        const bool diag = (kb == q0);
        float w[16];
        if (MODE == 0) {
            float L[16];
#pragma unroll
            for (int i = 0; i < 16; ++i) { const int key = kb + 16 * (i >> 3) + 8 * hi + (i & 7);
                const bool valid = !diag || (key < tq);
                L[i] = valid ? -flog2(1.f + fexp2(sc[i])) : 0.f; }
            float G0 = 0.f, G1 = 0.f;
#pragma unroll
            for (int j = 0; j < 8; ++j) { G0 += L[j]; G1 += L[8 + j]; }
            const float Gp0 = __shfl_xor(G0, 32), Gp1 = __shfl_xor(G1, 32);
            const float pre1 = hi ? R : (R + Gp1);
            const float pre0 = hi ? (R + G1 + Gp1) : (R + Gp1 + G1 + Gp0);
            float c = pre1;
#pragma unroll
            for (int j = 7; j >= 0; --j) { c += L[8 + j]; const int key = kb + 16 + 8 * hi + j; w[8 + j] = (!diag || key < tq) ? fexp2(sc[8 + j] + c) : 0.f; }
            c = pre0;
#pragma unroll
            for (int j = 7; j >= 0; --j) { c += L[j]; const int key = kb + 8 * hi + j; w[j] = (!diag || key < tq) ? fexp2(sc[j] + c) : 0.f; }
            R += (G0 + G1) + (Gp0 + Gp1);
        } else {
            float lg[16]; float bm = -3e38f;
#pragma unroll
            for (int s = 0; s < 2; ++s) { const f32x4 c0 = *(const f32x4*)(cb + kb + 16 * s + 8 * hi), c1 = *(const f32x4*)(cb + kb + 16 * s + 8 * hi + 4);
                const float ck[8] = {c0.x, c0.y, c0.z, c0.w, c1.x, c1.y, c1.z, c1.w};
#pragma unroll
                for (int j = 0; j < 8; ++j) { const int i = 8 * s + j, key = kb + 16 * s + 8 * hi + j;
                    const float v = sc[i] + (cq - ck[j]);
                    lg[i] = (!diag || key <= tq) ? v : -3e38f; bm = fmaxf(bm, lg[i]); } }
            bm = fmaxf(bm, __shfl_xor(bm, 32));
            const float mn = fmaxf(mrun, bm), alpha = fexp2(mrun - mn);
            mrun = mn;
            float ps = 0.f;
#pragma unroll
            for (int i = 0; i < 16; ++i) { w[i] = fexp2(lg[i] - mn); ps += w[i]; }
            lrun = lrun * alpha + ps;
#pragma unroll
            for (int d = 0; d < 4; ++d)
#pragma unroll
                for (int i = 0; i < 16; ++i) o[d][i] *= alpha;
        }
        bf16x8 pf[2];
#pragma unroll
        for (int s = 0; s < 2; ++s) { u32x4 t; t.x = cvtpk(w[8 * s + 0], w[8 * s + 1]); t.y = cvtpk(w[8 * s + 2], w[8 * s + 3]); t.z = cvtpk(w[8 * s + 4], w[8 * s + 5]); t.w = cvtpk(w[8 * s + 6], w[8 * s + 7]);
            pf[s] = __builtin_bit_cast(bf16x8, t); }
#pragma unroll
        for (int d = 0; d < 4; ++d)
#pragma unroll
            for (int s = 0; s < 2; ++s) o[d] = MFMA32(vf[d][s], pf[s], o[d]);
    }
    float inv = 1.f;
    if (MODE == 1) { const float lt = lrun + __shfl_xor(lrun, 32); inv = 1.f / lt; }
    bf16* op = mix + (row0 + q0 + n) * (size_t)D + h * 128 + 4 * hi;
#pragma unroll
    for (int d = 0; d < 4; ++d)
#pragma unroll
        for (int g = 0; g < 4; ++g) { u32x2 t; t.x = cvtpk(o[d][4 * g] * inv, o[d][4 * g + 1] * inv); t.y = cvtpk(o[d][4 * g + 2] * inv, o[d][4 * g + 3] * inv);
            *(u32x2*)(op + d * 32 + 8 * g) = t; }
}

constexpr int DL_SEL = 0, DL_MISC = 16384, DL_HIST = 17408, DL_CAND = DL_HIST + 8 * 8192, DL_P = DL_CAND + 8 * 512, DL_INVL = DL_P + 8 * 4096, DL_MM = DL_INVL + 8 * 16, DL_END = DL_MM + 8 * 128;
static_assert(DL_END <= RING_BYTES, "DSA LDS map");
constexpr int NBIN = 2048;

__device__ __forceinline__ int tk_bin(float x, float lo, float inv) { int bb = (int)((x - lo) * inv); return bb > NBIN - 1 ? NBIN - 1 : (bb < 0 ? 0 : bb); }
__device__ __forceinline__ void topk_row(const float* S, int c, float lo, float hi  , LAS unsigned short* sel, LAS unsigned* hist, LAS float* cval, LAS int* cidx, int lane) {
    const f32x4* S4 = (const f32x4*)S; const int c4 = c >> 2;
    int kk = 256, mc = c;
    bool usebin = false; float blo = 0.f, binv = 0.f; int bsel = 0;
    for (int level = 0; level < 48; ++level) {
        if (lo == hi || mc <= 64) break;
#pragma unroll
        for (int j = 0; j < NBIN / 64; ++j) hist[lane + 64 * j] = 0u;
        const float inv = (float)NBIN / (hi - lo);
        for (int i0 = 0; i0 < c4; i0 += 512) { f32x4 vb[8];
#pragma unroll
            for (int u = 0; u < 8; ++u) { const int i = i0 + 64 * u + lane; vb[u] = S4[i < c4 ? i : lane]; }
#pragma unroll
            for (int u = 0; u < 8; ++u) { const bool inr = (i0 + 64 * u + lane) < c4;
#pragma unroll
                for (int e = 0; e < 4; ++e) { const float x = vb[u][e]; if (inr && x >= lo && x <= hi) __hip_atomic_fetch_add(&hist[tk_bin(x, lo, inv)], 1u, __ATOMIC_RELAXED, __HIP_MEMORY_SCOPE_WORKGROUP); } } }
        LDS_WAIT(); asm volatile("" ::: "memory");
        unsigned own = 0u;
#pragma unroll
        for (int j = 0; j < 32; ++j) own += hist[32 * lane + j];
        unsigned suf = own;
#pragma unroll
        for (int o = 1; o < 64; o <<= 1) { const unsigned u = __shfl_down(suf, o); if (lane + o < 64) suf += u; }
        const unsigned long long pm = __ballot(suf >= (unsigned)kk);
        const int Ln = 63 - __builtin_clzll(pm);
        const unsigned above = __shfl(suf - own, Ln);
        const int k2 = kk - (int)above;
        int bs = 0, kn = 1, mn = 1;
        { unsigned acc = 0u; bool found = false;
          for (int j = 31; j >= 0; --j) { const unsigned hc = hist[32 * Ln + j]; if (!found && acc + hc >= (unsigned)k2) { bs = 32 * Ln + j; kn = k2 - (int)acc; mn = (int)hc; found = true; } if (!found) acc += hc; } }
        kk = kn; mc = mn;
        if (mc <= 64) { usebin = true; blo = lo; binv = inv; bsel = bs; break; }
        float nlo = 3e38f, nhi = -3e38f;
        for (int i0 = 0; i0 < c4; i0 += 256) { f32x4 vb[4];
#pragma unroll
            for (int u = 0; u < 4; ++u) { const int i = i0 + 64 * u + lane; vb[u] = S4[i < c4 ? i : lane]; }
#pragma unroll
            for (int u = 0; u < 4; ++u) { const bool inr = (i0 + 64 * u + lane) < c4;
#pragma unroll
                for (int e = 0; e < 4; ++e) { const float x = vb[u][e]; if (inr && x >= lo && x <= hi && tk_bin(x, lo, inv) == bs) { nlo = fminf(nlo, x); nhi = fmaxf(nhi, x); } } } }
        lo = wave_min(nlo); hi = wave_max(nhi);
    }
    const bool tie = !usebin && (lo == hi);
    const int base = 256 - kk;
    int nout = 0, ncand = 0;
    const unsigned long long ltmask = (1ull << lane) - 1ull;
    for (int j0 = 0; j0 < c4; j0 += 512) { f32x4 vb[8];
#pragma unroll
      for (int u = 0; u < 8; ++u) { const int i = j0 + 64 * u + lane; vb[u] = S4[i < c4 ? i : lane]; }
#pragma unroll
      for (int u = 0; u < 8; ++u) { const int i4 = j0 + 64 * u; if (i4 >= c4) break;
        bool gt[4], cd[4]; int glow = 0, clow = 0, gtot = 0, ctot = 0;
#pragma unroll
        for (int e = 0; e < 4; ++e) { const float x = vb[u][e]; const bool inr = (x >= lo) && (x <= hi);
            if (usebin) { const int bb = tk_bin(x, blo, binv); gt[e] = (x > hi) || (inr && bb > bsel); cd[e] = inr && bb == bsel; }
            else { gt[e] = x > hi; cd[e] = inr; }
            const unsigned long long gm = __ballot(gt[e]), cm = __ballot(cd[e]);
            glow += __builtin_popcountll(gm & ltmask); gtot += __builtin_popcountll(gm); clow += __builtin_popcountll(cm & ltmask); ctot += __builtin_popcountll(cm); }
        int gpos = nout + glow, cpos = ncand + clow;
#pragma unroll
        for (int e = 0; e < 4; ++e) { const int idx = 4 * (i4 + lane) + e;
            if (gt[e]) { if (gpos < 256) sel[gpos] = (unsigned short)idx; ++gpos; }
            if (cd[e]) { if (tie) { if (cpos < kk) sel[base + cpos] = (unsigned short)idx; } else if (cpos < 64) { cval[cpos] = vb[u][e]; cidx[cpos] = idx; } ++cpos; } }
        nout += gtot; ncand += ctot;
      } }
    if (!tie) {
        LDS_WAIT(); asm volatile("" ::: "memory");
        const int nc = ncand < 64 ? ncand : 64;
        const float mv = lane < nc ? cval[lane] : 0.f; const int mi = lane < nc ? cidx[lane] : 0;
        int rank = 0;
        for (int i = 0; i < nc; ++i) { const float v = cval[i]; rank += (v > mv || (v == mv && i < lane)) ? 1 : 0; }
        if (lane < nc && rank < kk) sel[base + rank] = (unsigned short)mi;
    }
    LDS_WAIT(); asm volatile("" ::: "memory");
}

__device__ __forceinline__ void dsa_unit(const bf16* proj, const unsigned char* q8, const unsigned char* k8, const unsigned char* v8, bf16* mix, float* scr, LAS unsigned char* lds, int unit, int tid) {
    constexpr int ldp = NB_PAD;
    const int lane = tid & 63, wave = __builtin_amdgcn_readfirstlane(tid >> 6);
    const int tile = 255 - (unit >> 2), b = unit & 3, t0 = 32 * tile, c = ((t0 >> 6) + 1) << 6;
    const size_t row0 = (size_t)b * SEQ;
    LAS unsigned short* sel = (LAS unsigned short*)(lds + DL_SEL);
#ifdef PROBE_DSA
    unsigned long long td0_ = __builtin_amdgcn_s_memrealtime();
#define DSA_PT(st) do { const unsigned long long n_ = __builtin_amdgcn_s_memrealtime(); if (tid == 0 && (st) == PROBE_DSA) { volatile LAS unsigned long long* pe_ = (volatile LAS unsigned long long*)(lds + MISC_OFF + 64); pe_[0] = pe_[0] + (n_ - td0_); } td0_ = n_; } while (0)
#else
#define DSA_PT(st) do { } while (0)
#endif
#ifndef DSA_NO_A
    if (c > 256) {
        int lane_a = lane; asm volatile("" : "+v"(lane_a));
        const int qg = wave & 1, kpart = wave >> 1, ql = lane_a & 15, kq = lane_a >> 4;
        const bf16* qrow = proj + (row0 + t0 + 16 * qg + ql) * ldp;
#pragma unroll 1
        for (int hp = 0; hp < 2; ++hp) {
            bf16x8 qif[8][2];
#pragma unroll
            for (int hh = 0; hh < 8; ++hh)
#pragma unroll
                for (int kk = 0; kk < 2; ++kk) qif[hh][kk] = *(const bf16x8*)(qrow + B_QI + (8 * hp + hh) * 64 + kk * 32 + kq * 8);
            float wv[8];
            { const u32x4 w0 = *(const u32x4*)(qrow + B_WI + 8 * hp);
              wv[0] = bflo(w0.x); wv[1] = bfhi(w0.x); wv[2] = bflo(w0.y); wv[3] = bfhi(w0.y); wv[4] = bflo(w0.z); wv[5] = bfhi(w0.z); wv[6] = bflo(w0.w); wv[7] = bfhi(w0.w); }
            bf16x8 kring[3][2][2]; f32x4 sring[3][2];
            const bf16* kibase = proj + (row0 + ql) * ldp + B_KI + kq * 8;
            float* sbase = scr + (size_t)(16 * qg + ql) * c + 4 * kq;
#define IDX_LOAD(SL, KB0) do { _Pragma("unroll") for (int u = 0; u < 2; ++u) { const int kb = (KB0) + 64 * u; const int kbc = kb < c ? kb : 16 * kpart; \
                    const bf16* kr = kibase + (size_t)kbc * ldp; \
                    kring[SL][u][0] = *(const bf16x8*)kr; kring[SL][u][1] = *(const bf16x8*)(kr + 32); \
                    sring[SL][u] = (f32x4){0.f, 0.f, 0.f, 0.f}; \
                    if (hp) sring[SL][u] = *(const f32x4*)(sbase + kbc); } } while (0)
#define IDX_COMP(SL, KB0) do { _Pragma("unroll") for (int u = 0; u < 2; ++u) { const int kb = (KB0) + 64 * u; \
                    if (kb < c) { f32x2_t s01 = {sring[SL][u][0], sring[SL][u][1]}, s23 = {sring[SL][u][2], sring[SL][u][3]}; \
                        _Pragma("unroll") for (int hh = 0; hh < 8; ++hh) { f32x4 d = {0.f, 0.f, 0.f, 0.f}; d = MFMA16(kring[SL][u][0], qif[hh][0], d); d = MFMA16(kring[SL][u][1], qif[hh][1], d); \
                            const f32x2_t w2 = {wv[hh], wv[hh]}; \
                            s01 = __builtin_elementwise_fma((f32x2_t){relu_raw(d[0]), relu_raw(d[1])}, w2, s01); s23 = __builtin_elementwise_fma((f32x2_t){relu_raw(d[2]), relu_raw(d[3])}, w2, s23); } \
                        const f32x4 sacc = {s01.x, s01.y, s23.x, s23.y}; \
                        *(f32x4*)(sbase + kb) = sacc; \
                        smin = fminf(smin, fminf(fminf(sacc[0], sacc[1]), fminf(sacc[2], sacc[3]))); smax = fmaxf(smax, fmaxf(fmaxf(sacc[0], sacc[1]), fmaxf(sacc[2], sacc[3]))); } } } while (0)
            float smin = 3e38f, smax = -3e38f;
            const int kbs = 16 * kpart;
            IDX_LOAD(0, kbs); IDX_LOAD(1, kbs + 128);
#pragma unroll 1
            for (int kb0 = kbs; kb0 < c; kb0 += 384) {
                IDX_LOAD(2, kb0 + 256); IDX_COMP(0, kb0);
                IDX_LOAD(0, kb0 + 384); IDX_COMP(1, kb0 + 128);
                IDX_LOAD(1, kb0 + 512); IDX_COMP(2, kb0 + 256);
            }
#undef IDX_COMP
#undef IDX_LOAD
            if (hp) {
                smin = fminf(smin, __shfl_xor(smin, 16)); smin = fminf(smin, __shfl_xor(smin, 32)); smax = fmaxf(smax, __shfl_xor(smax, 16)); smax = fmaxf(smax, __shfl_xor(smax, 32));
                if (lane < 16) { LAS float* mm = (LAS float*)(lds + DL_MM) + (wave * 16 + lane) * 2; mm[0] = smin; mm[1] = smax; }
            }
        }
    }
#endif
    __syncthreads(); DSA_PT(0);
    __builtin_amdgcn_fence(__ATOMIC_ACQUIRE, "agent");
    asm volatile("s_waitcnt vmcnt(0)" ::: "memory");
#ifndef DSA_NO_B
    LAS int* nselp = (LAS int*)(lds + DL_MISC);
    for (int qi = 0; qi < 4; ++qi) { const int ql = 4 * wave + qi;
        LAS unsigned short* s = sel + ql * 256;
        if (c > 256) { const LAS float* mm = (const LAS float*)(lds + DL_MM);
            float lo = 3e38f, hi = -3e38f;
#pragma unroll
            for (int kp = 0; kp < 4; ++kp) { const int w2 = (ql >> 4) + 2 * kp; lo = fminf(lo, mm[(w2 * 16 + (ql & 15)) * 2]); hi = fmaxf(hi, mm[(w2 * 16 + (ql & 15)) * 2 + 1]); }
            topk_row(scr + (size_t)ql * c, c, lo, hi, s, (LAS unsigned*)(lds + DL_HIST + wave * 8192), (LAS float*)(lds + DL_CAND + wave * 512), (LAS int*)(lds + DL_CAND + wave * 512 + 256), lane); }
        else { for (int i = lane; i < c; i += 64) s[i] = (unsigned short)i; }
    }
#endif
    const int nsel = c > 256 ? 256 : c;
    LDS_WAIT(); asm volatile("" ::: "memory"); DSA_PT(1);
#ifndef DSA_NO_C
    LAS unsigned short* Pb = (LAS unsigned short*)(lds + DL_P + wave * 4096);
    LAS unsigned char* vt = lds + DL_HIST + wave * 8192;
    LAS float* invl = (LAS float*)(lds + DL_INVL + wave * 16);
    for (int pi = 0; pi < 16; ++pi) { const int pr = 16 * wave + pi, ql = pr >> 2, g = pr & 3;
        const LAS unsigned short* s = sel + ql * 256;
        const size_t qrow = row0 + t0 + ql;
        int lane_c = lane; asm volatile("" : "+v"(lane_c));
        const int r = lane_c & 15, kq = lane_c >> 4;
        long qf[4];
#pragma unroll
        for (int kk = 0; kk < 4; ++kk) { qf[kk] = 0; if (r < 4) qf[kk] = *(const long*)(q8 + qrow * 2048 + (g * 4 + r) * 128 + kq * 32 + kk * 8); }
        f32x4 lg[16]; float mx = -3e38f;
#pragma unroll
        for (int g8 = 0; g8 < 2; ++g8) {
            if (g8 * 128 < nsel) {
                long kfr[8][4];
#pragma unroll
                for (int u = 0; u < 8; ++u) { const int key = ((g8 * 128 + u * 16) < nsel) ? s[g8 * 128 + u * 16 + r] : 0;
                    const unsigned char* kr = k8 + (row0 + key) * 512 + g * 128 + kq * 32;
                    const u32x4 ka = *(const u32x4*)kr, kb2 = *(const u32x4*)(kr + 16);
                    kfr[u][0] = (long)(((unsigned long long)ka.y << 32) | ka.x); kfr[u][1] = (long)(((unsigned long long)ka.w << 32) | ka.z);
                    kfr[u][2] = (long)(((unsigned long long)kb2.y << 32) | kb2.x); kfr[u][3] = (long)(((unsigned long long)kb2.w << 32) | kb2.z); }
#pragma unroll
                for (int u = 0; u < 8; ++u) { f32x4 d = {0.f, 0.f, 0.f, 0.f};
#pragma unroll
                    for (int kk = 0; kk < 4; ++kk) d = __builtin_amdgcn_mfma_f32_16x16x32_fp8_fp8(kfr[u][kk], qf[kk], d, 0, 0, 0);
                    const bool live = (g8 * 128 + u * 16) < nsel;
                    if (!live) d = (f32x4){-3e38f, -3e38f, -3e38f, -3e38f};
                    lg[g8 * 8 + u] = d; mx = fmaxf(mx, fmaxf(fmaxf(d[0], d[1]), fmaxf(d[2], d[3]))); }
            } else {
#pragma unroll
                for (int u = 0; u < 8; ++u) lg[g8 * 8 + u] = (f32x4){-3e38f, -3e38f, -3e38f, -3e38f};
            }
        }
        mx = fmaxf(mx, __shfl_xor(mx, 16)); mx = fmaxf(mx, __shfl_xor(mx, 32));
        const int ks = lane_c >> 4, dc = lane_c & 15;
        u32x2 vn[16];
#define DSA_LOADV(I0) do { _Pragma("unroll") for (int u = 0; u < 16; ++u) { const int key = s[4 * ((I0) + u) + ks]; vn[u] = *(const u32x2*)(v8 + (row0 + key) * 512 + g * 128 + dc * 8); } } while (0)
        DSA_LOADV(0);
        float ls = 0.f;
#pragma unroll
        for (int blk = 0; blk < 16; ++blk) {
            if (blk * 16 < nsel) {
#pragma unroll
                for (int e = 0; e < 4; ++e) { const float p = fexp2((lg[blk][e] - mx) * 0.125f); ls += p; if (r < 4) Pb[r * 256 + blk * 16 + 4 * kq + e] = (unsigned short)(cvtpk(p, p) & 0xffffu); } }
        }
        ls += __shfl_xor(ls, 16); ls += __shfl_xor(ls, 32);
        if (lane < 4) invl[lane] = 1.f / ls;
        LDS_WAIT(); asm volatile("" ::: "memory");
        f32x4 oacc[8];
#pragma unroll
        for (int cb = 0; cb < 8; ++cb) oacc[cb] = (f32x4){0.f, 0.f, 0.f, 0.f};
        const unsigned tq_ = (unsigned)(lane_c & 15) >> 2, tp_ = (unsigned)lane_c & 3u;
        for (int i0 = 0; i0 < nsel / 4; i0 += 16) {
            u32x2 v[16];
#pragma unroll
            for (int u = 0; u < 16; ++u) v[u] = vn[u];
            if (i0 + 16 < nsel / 4) DSA_LOADV(i0 + 16);
#pragma unroll
            for (int half = 0; half < 2; ++half) {
#pragma unroll
                for (int uu = 0; uu < 8; ++uu) { const int u = 8 * half + uu; const unsigned row = 4u * uu + (unsigned)ks;
                    const f32x2_t a0 = __builtin_amdgcn_cvt_pk_f32_fp8((int)v[u].x, false), a1 = __builtin_amdgcn_cvt_pk_f32_fp8((int)v[u].x, true), a2 = __builtin_amdgcn_cvt_pk_f32_fp8((int)v[u].y, false), a3 = __builtin_amdgcn_cvt_pk_f32_fp8((int)v[u].y, true);
                    u32x4 w; w.x = cvtpk(a0.x, a0.y); w.y = cvtpk(a1.x, a1.y); w.z = cvtpk(a2.x, a2.y); w.w = cvtpk(a3.x, a3.y);
                    *(LAS u32x4*)(vt + 256u * row + 16u * ((unsigned)dc ^ (((row & 3u) << 2) | ((row >> 2) & 3u)))) = w; }
                asm volatile("" ::: "memory");
                bf16x8 af = (bf16x8){0, 0, 0, 0, 0, 0, 0, 0};
                if (r < 4) af = *(const LAS bf16x8*)(Pb + r * 256 + 4 * i0 + 32 * half + 8 * kq);
#pragma unroll
                for (int cb = 0; cb < 8; ++cb) {
                    s16x4_t bq[2];
#pragma unroll
                    for (int t = 0; t < 2; ++t) { const unsigned trow = 8u * (unsigned)ks + 4u * t + tq_, tch = 2u * cb + (tp_ >> 1);
                        const unsigned ta = 256u * trow + 16u * (tch ^ (((trow & 3u) << 2) | ((trow >> 2) & 3u))) + 8u * (tp_ & 1u);
                        bq[t] = __builtin_amdgcn_ds_read_tr16_b64_v4i16((LAS s16x4_t*)(vt + ta)); }
                    const bf16x8 bfrag = {bq[0][0], bq[0][1], bq[0][2], bq[0][3], bq[1][0], bq[1][1], bq[1][2], bq[1][3]};
                    oacc[cb] = MFMA16(af, bfrag, oacc[cb]); }
                asm volatile("" ::: "memory");
            }
        }
        if (ks == 0) {
#pragma unroll
            for (int hd = 0; hd < 4; ++hd) { const float il = invl[hd];
#pragma unroll
                for (int cb = 0; cb < 8; ++cb) mix[qrow * D + (g * 4 + hd) * 128 + 16 * cb + dc] = (unsigned short)(cvtpk(oacc[cb][hd] * il, 0.f) & 0xffffu); }
        }
        LDS_WAIT(); asm volatile("" ::: "memory");
    }
#endif
    __syncthreads(); DSA_PT(2);
}


constexpr int A2_SLOT = 40960, A2_NSLOT = 3, A2_CTRL = A2_SLOT * A2_NSLOT;
static_assert(A2_CTRL + 256 <= RING_BYTES, "attention LDS map");
#define A2_WAIT_V(n) asm volatile("s_waitcnt vmcnt(" #n ")" ::: "memory")
template <int MODE>
__device__ __forceinline__ void attn2_stage(LAS unsigned char* slot, const bf16* kbase  ,
                                            const bf16* vbase  , const float* cbase  , int ldp, int kb, int wave) {
#pragma unroll
    for (int i = 0; i < 2; ++i) { const int f = wave + 8 * i, sb = f >> 3, kk = f & 7;
        __builtin_amdgcn_global_load_lds((const unsigned*)(kbase + (size_t)(kb + 32 * sb) * ldp + kk * 16), (LAS unsigned*)(slot + f * 1024), 16, 0, 0); }
#pragma unroll
    for (int i = 0; i < 2; ++i) { const int f = wave + 8 * i, sb = f >> 3, d = (f >> 1) & 3, s = f & 1;
        __builtin_amdgcn_global_load_lds((const unsigned*)(vbase + (size_t)(d * 32) * SEQ + kb + 32 * sb + 16 * s), (LAS unsigned*)(slot + 16384 + f * 1024), 16, 0, 0); }
    if (MODE == 1) __builtin_amdgcn_global_load_lds((const unsigned*)(cbase + kb), (LAS unsigned*)(slot + 32768 + wave * 1024), 16, 0, 0);
}
template <int MODE>
__device__ __forceinline__ void attn2_unit(const bf16* proj, int ldp, const bf16* VT, const float* cum2, const float* tot, const float* gq, const float* rstdv, bf16* mix, float zb2, int grp, int bh, LAS unsigned char* lds, int tid) {
    const int lane = tid & 63, wave = __builtin_amdgcn_readfirstlane(tid >> 6);
    const int b = bh >> 4, h = bh & 15, n = lane & 31, hi = lane >> 5;
    const int q_base = 256 * grp, q0 = q_base + 32 * wave, tq = q0 + n;
    const size_t row0 = (size_t)b * SEQ;
    const int prow = (n & 0x13) | ((n & 4) << 1) | ((n & 8) >> 1);
    const bf16* kbase = proj + (row0 + prow) * ldp + D + h * 128 + hi * 8;
    const bf16* vbase = VT + ((size_t)bh * 128 + n) * SEQ + 8 * hi;
    const float* cb = cum2 + (size_t)bh * SEQ;
    const float* cbase = cb + 4 * (lane & 15);
    volatile LAS unsigned* flags = (volatile LAS unsigned*)(lds + A2_CTRL + 64);
    bf16x8 qf[8];
    {
      const bf16* qp = proj + (row0 + q0 + n) * ldp + h * 128 + hi * 8;
      u32x4 raw[8];
#pragma unroll
      for (int kk = 0; kk < 8; ++kk) raw[kk] = *(const u32x4*)(qp + kk * 16);
      float ss = 0.f;
#pragma unroll
      for (int kk = 0; kk < 8; ++kk) { const float x0 = bflo(raw[kk].x), x1 = bfhi(raw[kk].x), x2 = bflo(raw[kk].y), x3 = bfhi(raw[kk].y), x4 = bflo(raw[kk].z), x5 = bfhi(raw[kk].z), x6 = bflo(raw[kk].w), x7 = bfhi(raw[kk].w);
          ss += x0 * x0 + x1 * x1 + x2 * x2 + x3 * x3 + x4 * x4 + x5 * x5 + x6 * x6 + x7 * x7; }
      ss += __shfl_xor(ss, 32);
      const float ar = rstdv[row0 + q0 + n];
      const float rstd = ar / sqrtf(ar * ar * ss * (1.f / 128.f) + RMS_EPS);
#pragma unroll
      for (int kk = 0; kk < 8; ++kk) { const f32x4 g0 = *(const f32x4*)(gq + kk * 16 + hi * 8), g1 = *(const f32x4*)(gq + kk * 16 + hi * 8 + 4);
          u32x4 w; w.x = cvtpk(bflo(raw[kk].x) * rstd * g0.x * QSCALE, bfhi(raw[kk].x) * rstd * g0.y * QSCALE); w.y = cvtpk(bflo(raw[kk].y) * rstd * g0.z * QSCALE, bfhi(raw[kk].y) * rstd * g0.w * QSCALE);
          w.z = cvtpk(bflo(raw[kk].z) * rstd * g1.x * QSCALE, bfhi(raw[kk].z) * rstd * g1.y * QSCALE); w.w = cvtpk(bflo(raw[kk].w) * rstd * g1.z * QSCALE, bfhi(raw[kk].w) * rstd * g1.w * QSCALE);
          qf[kk] = __builtin_bit_cast(bf16x8, w); } }
    float cq = 0.f, c_low = 0.f, Pe = 0.f, Po = 0.f, Pq = 0.f, Plow = 0.f;
    if (MODE == 1) { cq = cb[tq]; c_low = cb[q_base];
        const float te = tot[bh * 128 + 2 * lane], to = tot[bh * 128 + 2 * lane + 1]; float sc2 = te + to;
#pragma unroll
        for (int o = 1; o < 64; o <<= 1) { const float u = __shfl_up(sc2, o); if (lane >= o) sc2 += u; }
        Pe = sc2 - (te + to); Po = Pe + te;
        { const int cw = q0 >> 6; Pq = (cw & 1) ? __shfl(Po, cw >> 1) : __shfl(Pe, cw >> 1); }
        { const int cl = q_base >> 6; Plow = (cl & 1) ? __shfl(Po, cl >> 1) : __shfl(Pe, cl >> 1); } }
    f32x16 o[4];
#pragma unroll
    for (int d = 0; d < 4; ++d)
#pragma unroll
        for (int i = 0; i < 16; ++i) o[d][i] = 0.f;
    float R = 0.f, mrun = -1e30f, lrun = 0.f;
    const int nsteps = (q_base + 256) >> 6, kb_top = q_base + 192;
    if (wave < 4) __builtin_amdgcn_s_setprio(2); else __builtin_amdgcn_s_setprio(0);
    if (MODE == 0 && tid < 16) flags[tid] = 0u;
    asm volatile("s_waitcnt vmcnt(0)" ::: "memory");
    attn2_stage<MODE>(lds, kbase, vbase, cbase, ldp, kb_top, wave);
    if (nsteps > 1) attn2_stage<MODE>(lds + A2_SLOT, kbase, vbase, cbase, ldp, kb_top - 64, wave);
    bool mydone = false;
    for (int j = 0; j < nsteps; ++j) {
        const int kb = kb_top - 64 * j;
        if (j + 1 < nsteps) { if (MODE == 1) A2_WAIT_V(5); else A2_WAIT_V(4); } else A2_WAIT_V(0);
        __builtin_amdgcn_s_barrier();
        __builtin_amdgcn_sched_barrier(0); asm volatile("" ::: "memory");
        LAS unsigned char* slot = lds + (j % A2_NSLOT) * A2_SLOT;
        float dq = 0.f;
        if (MODE == 1) { const int ck_ = kb >> 6; const float Pk = (ck_ & 1) ? __shfl(Po, ck_ >> 1) : __shfl(Pe, ck_ >> 1);
            dq = Pq - Pk;
            const float ck63 = *(const LAS float*)(slot + 32768 + wave * 1024 + 63 * 4);
            if ((c_low + (Plow - Pk) - ck63) + 2.f * zb2 < ZERO_LOG2) break; }
        else if (j > 0) { const volatile LAS unsigned* fl = flags + 8 * ((j - 1) & 1); unsigned all = 1u;
#pragma unroll
            for (int w2 = 0; w2 < 8; ++w2) all &= fl[w2];
            if (all) break; }
        if (j + 2 < nsteps) attn2_stage<MODE>(lds + ((j + 2) % A2_NSLOT) * A2_SLOT, kbase, vbase, cbase, ldp, kb - 128, wave);
#pragma unroll
        for (int sbi = 0; sbi < 2; ++sbi) { const int sb = 1 - sbi, kk0 = kb + 32 * sb;
            if (kk0 > q0 || mydone) continue;
            if (MODE == 1) { const float ck31 = *(const LAS float*)(slot + 32768 + wave * 1024 + (32 * sb + 31) * 4);
                const float cq0 = __shfl(cq, 0); if ((cq0 + dq - ck31) + 2.f * zb2 < ZERO_LOG2) { mydone = true; continue; } }
            bf16x8 kf[8];
#pragma unroll
            for (int kk = 0; kk < 8; ++kk) kf[kk] = *(const LAS bf16x8*)(slot + (sb * 8 + kk) * 1024 + lane * 16);
            f32x16 sc;
#pragma unroll
            for (int i = 0; i < 16; ++i) sc[i] = 0.f;
#pragma unroll
            for (int kk = 0; kk < 8; ++kk) sc = MFMA32(kf[kk], qf[kk], sc);
            bf16x8 vf[4][2];
#pragma unroll
            for (int d = 0; d < 4; ++d)
#pragma unroll
                for (int s = 0; s < 2; ++s) vf[d][s] = *(const LAS bf16x8*)(slot + 16384 + (sb * 8 + d * 2 + s) * 1024 + lane * 16);
            const bool diag = (kk0 == q0);
            float w[16];
            if (MODE == 0) {
                float L[16];
#pragma unroll
                for (int i = 0; i < 16; ++i) L[i] = flog2(1.f + fexp2(sc[i]));
                if (diag) {
#pragma unroll
                    for (int i = 0; i < 16; ++i) { const int key = kk0 + 16 * (i >> 3) + 8 * hi + (i & 7); if (key >= tq) { L[i] = 0.f; sc[i] = -3e38f; } }
                }
                const float G0 = -(((L[0] + L[1]) + (L[2] + L[3])) + ((L[4] + L[5]) + (L[6] + L[7]))), G1 = -(((L[8] + L[9]) + (L[10] + L[11])) + ((L[12] + L[13]) + (L[14] + L[15])));
                const float Gp0 = __shfl_xor(G0, 32), Gp1 = __shfl_xor(G1, 32);
                const float pre1 = hi ? R : (R + Gp1);
                const float pre0 = hi ? (R + G1 + Gp1) : (R + Gp1 + G1 + Gp0);
                float c = pre1;
#pragma unroll
                for (int jj = 7; jj >= 0; --jj) { c -= L[8 + jj]; w[8 + jj] = fexp2(sc[8 + jj] + c); }
                c = pre0;
#pragma unroll
                for (int jj = 7; jj >= 0; --jj) { c -= L[jj]; w[jj] = fexp2(sc[jj] + c); }
                R += (G0 + G1) + (Gp0 + Gp1);
                if (__all(R + zb2 < ZERO_LOG2)) mydone = true;
            } else {
                f32x2_t v2[8]; const f32x2_t cq2 = {cq + dq, cq + dq};
#pragma unroll
                for (int s = 0; s < 2; ++s) { const LAS f32x4* cp = (const LAS f32x4*)(slot + 32768 + wave * 1024 + (32 * sb + 16 * s + 8 * hi) * 4);
                    const f32x4 c0 = cp[0], c1 = cp[1];
                    v2[4 * s + 0] = (f32x2_t){sc[8 * s + 0], sc[8 * s + 1]} - (f32x2_t){c0.x, c0.y};
                    v2[4 * s + 1] = (f32x2_t){sc[8 * s + 2], sc[8 * s + 3]} - (f32x2_t){c0.z, c0.w};
                    v2[4 * s + 2] = (f32x2_t){sc[8 * s + 4], sc[8 * s + 5]} - (f32x2_t){c1.x, c1.y};
                    v2[4 * s + 3] = (f32x2_t){sc[8 * s + 6], sc[8 * s + 7]} - (f32x2_t){c1.z, c1.w}; }
                if (diag) {
#pragma unroll
                    for (int p = 0; p < 8; ++p) { const int key = kk0 + 16 * (p >> 2) + 8 * hi + 2 * (p & 3);
                        if (key > tq) v2[p].x = -3e38f; if (key + 1 > tq) v2[p].y = -3e38f; }
                }
#pragma unroll
                for (int p = 0; p < 8; ++p) v2[p] += cq2;
                float bm = fmaxf(fmaxf(v2[0].x, v2[0].y), fmaxf(v2[1].x, v2[1].y));
#pragma unroll
                for (int p = 2; p < 8; p += 2) bm = fmaxf(bm, fmaxf(fmaxf(v2[p].x, v2[p].y), fmaxf(v2[p + 1].x, v2[p + 1].y)));
                bm = fmaxf(bm, __shfl_xor(bm, 32));
                const float mn = fmaxf(mrun, bm), alpha = fexp2(mrun - mn);
                mrun = mn;
                const f32x2_t nmn2 = {-mn, -mn}; f32x2_t ps2 = {0.f, 0.f};
#pragma unroll
                for (int p = 0; p < 8; ++p) { const f32x2_t d2 = v2[p] + nmn2; f32x2_t e2; e2.x = fexp2(d2.x); e2.y = fexp2(d2.y); w[2 * p] = e2.x; w[2 * p + 1] = e2.y; ps2 += e2; }
                lrun = lrun * alpha + (ps2.x + ps2.y);
                if (__any(alpha != 1.f)) {
#pragma unroll
                    for (int d = 0; d < 4; ++d)
#pragma unroll
                        for (int i = 0; i < 16; ++i) o[d][i] *= alpha;
                }
            }
            bf16x8 pf[2];
#pragma unroll
            for (int s = 0; s < 2; ++s) { u32x4 t; t.x = cvtpk(w[8 * s + 0], w[8 * s + 1]); t.y = cvtpk(w[8 * s + 2], w[8 * s + 3]); t.z = cvtpk(w[8 * s + 4], w[8 * s + 5]); t.w = cvtpk(w[8 * s + 6], w[8 * s + 7]);
                pf[s] = __builtin_bit_cast(bf16x8, t); }
#pragma unroll
            for (int d = 0; d < 4; ++d)
#pragma unroll
                for (int s = 0; s < 2; ++s) o[d] = MFMA32(vf[d][s], pf[s], o[d]);
        }
        if (MODE == 0) { if (lane == 0) flags[8 * (j & 1) + wave] = (mydone || kb == 0) ? 1u : 0u; }
    }
    A2_WAIT_V(0);
    __builtin_amdgcn_s_setprio(0);
    float inv = 1.f;
    if (MODE == 1) { const float lt = lrun + __shfl_xor(lrun, 32); inv = 1.f / lt; }
    bf16* op = mix + (row0 + q0 + n) * (size_t)D + h * 128 + 4 * hi;
#pragma unroll
    for (int d = 0; d < 4; ++d)
#pragma unroll
        for (int g = 0; g < 4; ++g) { u32x2 t; t.x = cvtpk(o[d][4 * g] * inv, o[d][4 * g + 1] * inv); t.y = cvtpk(o[d][4 * g + 2] * inv, o[d][4 * g + 3] * inv);
            *(u32x2*)(op + d * 32 + 8 * g) = t; }
    asm volatile("s_waitcnt vmcnt(0) lgkmcnt(0)" ::: "memory");
    __builtin_amdgcn_s_barrier();
}

typedef const __attribute__((address_space(4))) Args* KArgs;
__device__ __forceinline__ KArgs kargs() { auto p = __builtin_amdgcn_kernarg_segment_ptr(); asm volatile("" : "+s"(p)); return (KArgs)p; }
#define TID_VARS int tid_l = threadIdx.x; asm volatile("" : "+v"(tid_l)); const int tid = tid_l, lane = tid & 63, wave = __builtin_amdgcn_readfirstlane(tid >> 6); const int G = gridDim.x, bx = blockIdx.x; const int gw = bx * NWAVES + wave, ngw = G * NWAVES; (void)gw; (void)ngw; (void)lane; (void)G
#ifndef WGM_IN
#define WGM_IN 4
#endif
#ifndef WGM_WO
#define WGM_WO 4
#endif
#ifndef WGM_PP
#define WGM_PP 4
#endif
#ifndef WGM_UP
#define WGM_UP 4
#endif
#ifndef WGM_DN
#define WGM_DN 4
#endif
#ifndef WGM_GT
#define WGM_GT 4
#endif
#ifndef PG_ALIGN
#define PG_ALIGN true
#endif
#ifndef PG_SP2
#define PG_SP2 true
#endif
#ifndef PHMASK
#define PHMASK 0xFFFF
#endif
#define PH(k) ((PHMASK >> (k)) & 1)
#ifndef REP_GEMM
#define REP_GEMM 1
#endif
#ifndef REP_ATTN
#define REP_ATTN 1
#endif
#ifndef REP_LIGHT
#define REP_LIGHT 1
#endif
#ifndef REP_A
#define REP_A REP_ATTN
#endif
#ifndef REP_B
#define REP_B REP_ATTN
#endif
#ifndef REP_C
#define REP_C REP_ATTN
#endif

#ifndef REP_BAR
#define REP_BAR 1
#endif
__device__ __forceinline__ void grid_bar(LAS unsigned char* lds) {
  for (int rb = 0; rb < REP_BAR; ++rb) {
    KArgs A = kargs(); XcdBarrier b; b.bar = (unsigned*)(A->ws + WS_CTL) + CW_BAR; b.x = xb_xcc_id(); b.st = (volatile LAS unsigned*)(lds + MISC_OFF) + 8;
    xcd_barrier(b);
  }
}
struct LayerCfg { int kind, jk, nin, npad; };
__device__ __forceinline__ LayerCfg layer_cfg(int layer) { LayerCfg c; c.kind = layer % 3; c.jk = layer / 3; c.nin = c.kind == 0 ? NA_IN : (c.kind == 1 ? NB_IN : NC_IN); c.npad = c.kind == 0 ? NA_IN : (c.kind == 1 ? NB_PAD : NC_PAD); return c; }

__device__ __forceinline__ void convert_layer(KArgs A, unsigned char* ws, LAS float* scrw, int layer, int which, int gw, int ngw, int lane) {
    const LayerCfg L = layer_cfg(layer);
    if (which & 1) {
        const float* w_in = L.kind == 0 ? A->in[I_A_WIN] + (size_t)L.jk * D * NA_IN : (L.kind == 1 ? A->in[I_B_WIN] : A->in[I_C_WIN]);
        convert_weight(w_in, A->in[I_ATTN_NORM] + layer * D, D, L.nin, L.npad, (bf16*)(ws + WS_WIN), scrw, gw, ngw, lane);
        convert_weight(A->in[I_WO] + (size_t)layer * D * D, nullptr, D, D, D, (bf16*)(ws + WS_WO), scrw, gw, ngw, lane);
        convert_weight(A->in[I_WUP] + (size_t)layer * D * FF, A->in[I_MLP_NORM] + layer * D, D, FF, FF, (bf16*)(ws + WS_WUP), scrw, gw, ngw, lane);
        convert_weight(A->in[I_WDOWN] + (size_t)layer * FF * D, nullptr, FF, D, D, (bf16*)(ws + WS_WDN), scrw, gw, ngw, lane);
    }
    if (which & 2) {
        convert_weight(A->in[I_WGATE] + (size_t)layer * D * D, A->in[I_PLE_NORM] + layer * D, D, D, D, (bf16*)(ws + WS_WG), scrw, gw, ngw, lane);
        convert_weight(A->in[I_WPLE] + (size_t)layer * PLE * D, nullptr, PLE, D, D, (bf16*)(ws + WS_WPL), scrw, gw, ngw, lane);
    }
}
__device__ __forceinline__ void phase_prologue(LAS unsigned char* lds) {
    KArgs A = kargs(); TID_VARS; unsigned char* ws = A->ws;
    float2* rope32 = (float2*)(ws + WS_ROPE32); float2* rope16 = (float2*)(ws + WS_ROPE16);
    const int gt = bx * NTHR + tid, ngt = G * NTHR;
    for (int i = gt; i < SEQ * 16; i += ngt) { const int pos = i >> 4, k = i & 15; const float inv = exp2f(-(float)k * (1.f / 16.f) * 18.931568569324174f);
        const float ang = (float)pos * inv; float s, c; sincosf(ang, &s, &c); rope32[i] = make_float2(c, s); }
    for (int i = gt; i < SEQ * 8; i += ngt) { const int pos = i >> 3, k = i & 7; const float inv = exp2f(-(float)k * (1.f / 8.f) * 18.931568569324174f);
        const float ang = (float)pos * inv; float s, c; sincosf(ang, &s, &c); rope16[i] = make_float2(c, s); }
    const f32x4* p4 = (const f32x4*)A->in[I_P]; u32x2* pb2 = (u32x2*)(ws + WS_PB);
    for (size_t i = gt; i < (size_t)DEPTH * M * PLE / 4; i += ngt) { const f32x4 v = p4[i]; pb2[i] = (u32x2){cvtpk(v.x, v.y), cvtpk(v.z, v.w)}; }
    x_rows(A->in[I_X], (bf16*)(ws + WS_HB0), (float*)(ws + WS_SSP_IN), gw, ngw, lane);
    convert_layer(A, ws, (LAS float*)(lds + RING_OFF + wave * 8448), 0, 1, gw, ngw, lane);
}
__device__ __forceinline__ void phase_inproj(LAS unsigned char* lds, int layer) {
    KArgs A = kargs(); TID_VARS; unsigned char* ws = A->ws; const LayerCfg L = layer_cfg(layer);
    pg8::Gemm g{(const bf16*)(ws + ((layer & 1) ? WS_HB1 : WS_HB0)), (const bf16*)(ws + WS_WIN), M, L.npad, D}; pg8::StaticOrder S; S.init(M, L.npad, G, bx, WGM_IN);
    { const float* ssp = (const float*)(ws + WS_SSP_IN); float* rv = (float*)(ws + WS_RSTD);
      for (int r = gw; r < M; r += ngw) { float v = lane < 32 ? ssp[(size_t)r * 32 + lane] : 0.f; v = wave_sum(v); if (lane == 0) rv[r] = 1.f / sqrtf(v * (1.f / 2048.f) + RMS_EPS); } }
    pg8::EpiStore<0, false> E{(bf16*)(ws + WS_PROJ), L.npad, nullptr};
    pg8::gemm_phase<pg8::EpiStore<0, false>, pg8::StaticOrder, PG_ALIGN, PG_SP2>(lds + RING_OFF, g, S, E);
}
__device__ __forceinline__ float zbound2(const float* gq, const float* gk, int lane) {
    const float a = wave_max(fmaxf(fabsf(gq[lane]), fabsf(gq[lane + 64]))), bq = wave_max(fmaxf(fabsf(gk[lane]), fabsf(gk[lane + 64])));
    return a * bq * 11.313708498984761f * LOG2E * 1.02f;
}
__device__ __forceinline__ void phase_postproj_dense(LAS unsigned char* lds, int layer) {
    KArgs A = kargs(); TID_VARS; unsigned char* ws = A->ws; const LayerCfg L = layer_cfg(layer);
    bf16* PROJ = (bf16*)(ws + WS_PROJ); LAS float* scrw = (LAS float*)(lds + RING_OFF + wave * 8448);
    const float* gq = L.kind == 0 ? A->in[I_A_QN] + L.jk * HD : A->in[I_C_QN]; const float* gk = L.kind == 0 ? A->in[I_A_KN] + L.jk * HD : A->in[I_C_KN];
    const int npad = L.npad;
    const int nscan = L.kind == 2 ? BATCH * 128 : 0, nvt = BATCH * 256 * 16, total = nscan + nvt + M;
    for (int it = gw; it < total; it += ngw) {
        if (it < nscan) { cumchunk_item(PROJ, npad, (const float*)(ws + WS_RSTD), A->in[I_C_BF], (float*)(ws + WS_CUM), (float*)(ws + WS_TOT), it, lane); continue; }
        int r = it - nscan;
        if (r < nvt) { vt_item(PROJ, npad, 2 * D, (const float*)(ws + WS_RSTD), (bf16*)(ws + WS_VT), (LAS unsigned char*)scrw, r, lane); continue; }
        r -= nvt;
        bf16* base = PROJ + (size_t)r * npad + 8 * lane;
        u32x4 raw[4];
#pragma unroll
        for (int j = 0; j < 4; ++j) raw[j] = *(const u32x4*)(base + D + 512 * j);
        const float ar = ((const float*)(ws + WS_RSTD))[r];
#pragma unroll
        for (int j = 0; j < 4; ++j) head128_norm<false>(base + D + 512 * j, raw[j], ar, gk, 1.f, nullptr, lane);
    }
    convert_layer(A, ws, scrw, layer, 2, gw, ngw, lane);
}
__device__ __forceinline__ void phase_postproj_dsa(LAS unsigned char* lds, int layer) {
    KArgs A = kargs(); TID_VARS; unsigned char* ws = A->ws;
    bf16* PROJ = (bf16*)(ws + WS_PROJ); const float2* rope32 = (const float2*)(ws + WS_ROPE32); const float2* rope16 = (const float2*)(ws + WS_ROPE16);
    const float* gq = A->in[I_B_QN]; const float* gk = A->in[I_B_KN]; const float* gi = A->in[I_B_IKN];
    constexpr int npad = NB_PAD;
    for (int r = gw; r < M; r += ngw) { const int pos = r & (SEQ - 1);
        bf16* base = PROJ + (size_t)r * npad;
        const float2* r32 = rope32 + pos * 16; const float2* r16 = rope16 + pos * 8;
        u32x4 raw[8]; u32x4 rawi, raww;
#pragma unroll
        for (int j = 0; j < 5; ++j) raw[j] = *(const u32x4*)(base + 512 * j + 8 * lane);
        raw[5] = *(const u32x4*)(base + B_QI + 8 * lane); raw[6] = *(const u32x4*)(base + B_QI + 512 + 8 * lane);
        rawi = *(const u32x4*)(base + B_KI + 8 * (lane & 7)); raww = *(const u32x4*)(base + B_WI + 8 * (lane & 1));
        const float ar = ((const float*)(ws + WS_RSTD))[r];
        unsigned char* q8 = ws + WS_Q8 + (size_t)r * 2048 + 8 * lane; unsigned char* k8 = ws + WS_K8 + (size_t)r * 512 + 8 * lane; unsigned char* v8 = ws + WS_V8 + (size_t)r * 512 + 8 * lane;
#pragma unroll
        for (int j = 0; j < 4; ++j) head128_norm<true>(base + 512 * j + 8 * lane, raw[j], ar, gq, QSCALE * 8.f, r32, lane, q8 + 512 * j);
        head128_norm<true>(base + B_K + 8 * lane, raw[4], ar, gk, 1.f, r32, lane, k8);
        { const u32x4 rv = *(const u32x4*)(base + B_V + 8 * lane); int w0 = 0, w1 = 0;
          w0 = __builtin_amdgcn_cvt_pk_fp8_f32(bflo(rv.x) * ar, bfhi(rv.x) * ar, w0, false); w0 = __builtin_amdgcn_cvt_pk_fp8_f32(bflo(rv.y) * ar, bfhi(rv.y) * ar, w0, true);
          w1 = __builtin_amdgcn_cvt_pk_fp8_f32(bflo(rv.z) * ar, bfhi(rv.z) * ar, w1, false); w1 = __builtin_amdgcn_cvt_pk_fp8_f32(bflo(rv.w) * ar, bfhi(rv.w) * ar, w1, true);
          *(u32x2*)v8 = (u32x2){(unsigned)w0, (unsigned)w1}; }
#pragma unroll
        for (int j = 0; j < 2; ++j) head64_rope<false>(base + B_QI + 512 * j + 8 * lane, raw[5 + j], ar, nullptr, r16, lane, true);
        head64_rope<true>(base + B_KI + 8 * (lane & 7), rawi, ar, gi, r16, lane, lane < 8);
        if (lane < 2) { bf16* wp = base + B_WI + 8 * lane; const u32x4 raw = raww;
            const float sw = 0.03125f * ar;
            u32x4 w; w.x = cvtpk(bflo(raw.x) * sw, bfhi(raw.x) * sw); w.y = cvtpk(bflo(raw.y) * sw, bfhi(raw.y) * sw);
            w.z = cvtpk(bflo(raw.z) * sw, bfhi(raw.z) * sw); w.w = cvtpk(bflo(raw.w) * sw, bfhi(raw.w) * sw); *(u32x4*)wp = w; }
    }
    convert_layer(A, ws, (LAS float*)(lds + RING_OFF + wave * 8448), layer, 2, gw, ngw, lane);
}
template <int MODE>
__device__ __forceinline__ void phase_attn_dense(LAS unsigned char* lds, int layer, int rep) {
    KArgs A = kargs(); TID_VARS; unsigned char* ws = A->ws; const LayerCfg L = layer_cfg(layer);
    const float* gq = L.kind == 0 ? A->in[I_A_QN] + L.jk * HD : A->in[I_C_QN]; const float* gk = L.kind == 0 ? A->in[I_A_KN] + L.jk * HD : A->in[I_C_KN];
    const float zb2 = zbound2(gq, gk, lane);
    gu32* qhead = (gu32*)(ws + WS_CTL) + CW_QUEUE + 64 * layer + 16 * rep;
    volatile LAS unsigned* uw = (volatile LAS unsigned*)(lds + RING_OFF + A2_CTRL);
    for (;;) { if (tid == 0) uw[0] = __hip_atomic_fetch_add(qhead, 1u, RLX_AGENT); __syncthreads(); const unsigned it = uw[0]; __syncthreads();
        if (it >= 32u * 64u) break;
        const int grp = 31 - (int)(it >> 6), bh = (int)(it & 63u);
        attn2_unit<MODE>((const bf16*)(ws + WS_PROJ), L.npad, (const bf16*)(ws + WS_VT), (const float*)(ws + WS_CUM), (const float*)(ws + WS_TOT), gq, (const float*)(ws + WS_RSTD), (bf16*)(ws + WS_MIX), zb2, grp, bh, lds + RING_OFF, tid); }
}
__device__ __forceinline__ void phase_attn_dsa(LAS unsigned char* lds, int layer, int rep) {
    KArgs A = kargs(); TID_VARS; unsigned char* ws = A->ws;
    gu32* qhead = (gu32*)(ws + WS_CTL) + CW_QUEUE + 64 * layer + 16 * rep;
    float* scr = (float*)(ws + (bx < 128 ? WS_SCR_A + (size_t)bx * MiB : WS_SCR_B + (size_t)(bx - 128) * MiB));
    volatile LAS unsigned* uw = (volatile LAS unsigned*)(lds + RING_OFF + DL_MISC + 128);
    for (;;) { if (tid == 0) uw[0] = __hip_atomic_fetch_add(qhead, 1u, RLX_AGENT); __syncthreads(); const unsigned u = uw[0]; __syncthreads();
        if (u >= 1024u) break; dsa_unit((const bf16*)(ws + WS_PROJ), ws + WS_Q8, ws + WS_K8, ws + WS_V8, (bf16*)(ws + WS_MIX), scr, lds + RING_OFF, (int)u, tid); }
}
__device__ __forceinline__ void phase_wo(LAS unsigned char* lds, int layer) {
    KArgs A = kargs(); TID_VARS; unsigned char* ws = A->ws;
    pg8::Gemm g{(const bf16*)(ws + WS_MIX), (const bf16*)(ws + WS_WO), M, D, D}; pg8::StaticOrder S; S.init(M, D, G, bx, WGM_WO);
    bf16* hb = (bf16*)(ws + ((layer & 1) ? WS_HB1 : WS_HB0));
    pg8::EpiH<false, false> E{hb, hb, (float*)(ws + WS_SSP_WO), nullptr, nullptr, nullptr};
    pg8::gemm_phase<pg8::EpiH<false, false>, pg8::StaticOrder, PG_ALIGN, PG_SP2>(lds + RING_OFF, g, S, E);
}
__device__ __forceinline__ void phase_pp(LAS unsigned char* lds, int layer) {
    KArgs A = kargs(); TID_VARS; unsigned char* ws = A->ws;
    int kpl = PLE; asm volatile("" : "+s"(kpl));
    pg8::Gemm g{(const bf16*)(ws + WS_PB) + (size_t)layer * M * PLE, (const bf16*)(ws + WS_WPL), M, D, kpl}; pg8::StaticOrder S; S.init(M, D, G, bx, WGM_PP);
    pg8::EpiStore<0, false> E{(bf16*)(ws + WS_PP), D, nullptr};
    pg8::gemm_phase<pg8::EpiStore<0, false>, pg8::StaticOrder, PG_ALIGN, PG_SP2>(lds + RING_OFF, g, S, E);
}
__device__ __forceinline__ void phase_up(LAS unsigned char* lds, int layer) {
    KArgs A = kargs(); TID_VARS; unsigned char* ws = A->ws;
    pg8::Gemm g{(const bf16*)(ws + ((layer & 1) ? WS_HB1 : WS_HB0)), (const bf16*)(ws + WS_WUP), M, FF, D}; pg8::StaticOrder S; S.init(M, FF, G, bx, WGM_UP);
    pg8::EpiStore<1, false> E{(bf16*)(ws + WS_HID), FF, nullptr};
    pg8::gemm_phase<pg8::EpiStore<1, false>, pg8::StaticOrder, PG_ALIGN, PG_SP2>(lds + RING_OFF, g, S, E);
}
__device__ __forceinline__ void phase_down(LAS unsigned char* lds, int layer) {
    KArgs A = kargs(); TID_VARS; unsigned char* ws = A->ws;
    pg8::Gemm g{(const bf16*)(ws + WS_HID), (const bf16*)(ws + WS_WDN), M, D, FF}; pg8::StaticOrder S; S.init(M, D, G, bx, WGM_DN);
    bf16* hb = (bf16*)(ws + ((layer & 1) ? WS_HB1 : WS_HB0));
    pg8::EpiH<false, false, true> E{hb, hb, (float*)(ws + WS_SSP_DN), nullptr, (const float*)(ws + WS_SSP_WO), nullptr};
    pg8::gemm_phase<pg8::EpiH<false, false, true>, pg8::StaticOrder, PG_ALIGN, PG_SP2>(lds + RING_OFF, g, S, E);
}
template <bool FINAL>
__device__ __forceinline__ void phase_gate(LAS unsigned char* lds, int layer) {
    KArgs A = kargs(); TID_VARS; unsigned char* ws = A->ws;
    pg8::Gemm g{(const bf16*)(ws + ((layer & 1) ? WS_HB1 : WS_HB0)), (const bf16*)(ws + WS_WG), M, D, D}; pg8::StaticOrder S; S.init(M, D, G, bx, WGM_GT);
    pg8::EpiH<true, FINAL> E{(const bf16*)(ws + ((layer & 1) ? WS_HB1 : WS_HB0)), (bf16*)(ws + ((layer & 1) ? WS_HB0 : WS_HB1)), (float*)(ws + WS_SSP_IN), (const bf16*)(ws + WS_PP), (const float*)(ws + WS_SSP_DN), A->out};
    pg8::gemm_phase<pg8::EpiH<true, FINAL>, pg8::StaticOrder, PG_ALIGN, PG_SP2>(lds + RING_OFF, g, S, E);
}
__device__ __forceinline__ void phase_convert_next(LAS unsigned char* lds, int layer) {
    KArgs A = kargs(); TID_VARS; unsigned char* ws = A->ws;
    convert_layer(A, ws, (LAS float*)(lds + RING_OFF + wave * 8448), layer, 1, gw, ngw, lane);
}

__global__ void __launch_bounds__(NTHR, 2) trunk_fwd(Args args) {
    extern __shared__ __attribute__((aligned(16))) unsigned char lds_raw[];
    LAS unsigned char* lds = (LAS unsigned char*)lds_raw;
    for (int u = threadIdx.x; u < (LDS_BYTES - LDSCTL_OFF) / 4; u += NTHR) ((LAS unsigned*)(lds + LDSCTL_OFF))[u] = 0u;
    __syncthreads();
    { KArgs A = kargs(); (void)xcd_barrier_post((unsigned*)(A->ws + WS_CTL) + CW_BAR, (volatile LAS unsigned*)(lds + MISC_OFF) + 8); }
#ifdef PROBE_MASK
    unsigned long long pt_acc = 0ull, pt_last = __builtin_amdgcn_s_memrealtime();
#define PT(cls) do { const unsigned long long now_ = __builtin_amdgcn_s_memrealtime(); if ((PROBE_MASK >> (cls)) & 1) pt_acc += now_ - pt_last; pt_last = now_; } while (0)
#else
#define PT(cls) do { } while (0)
#endif
    phase_prologue(lds);
    grid_bar(lds); PT(7);
    for (int layer = 0; layer < DEPTH; ++layer) {
        const int kind = layer % 3;
        phase_inproj(lds, layer);
        grid_bar(lds); PT(0);
        if (kind != 1) phase_postproj_dense(lds, layer); else phase_postproj_dsa(lds, layer);
        grid_bar(lds); PT(1);
        if (kind == 0) phase_attn_dense<0>(lds, layer, 0);
        else if (kind == 2) phase_attn_dense<1>(lds, layer, 0);
        else phase_attn_dsa(lds, layer, 0);
        grid_bar(lds); PT(kind == 0 ? 2 : (kind == 1 ? 8 : 9));
        phase_wo(lds, layer);
        phase_pp(lds, layer);
        grid_bar(lds); PT(3);
        phase_up(lds, layer);
        grid_bar(lds); PT(4);
        phase_down(lds, layer);
        grid_bar(lds); PT(5);
        if (layer + 1 < DEPTH) { phase_gate<false>(lds, layer); __syncthreads(); phase_convert_next(lds, layer + 1); }
        else phase_gate<true>(lds, layer);
        grid_bar(lds); PT(6);
    }
#ifdef PROBE_MASK
#if defined(PROBE_EPI) || defined(PROBE_DSA)
    pt_acc = *(volatile LAS unsigned long long*)(lds + MISC_OFF + 64);
#endif
    if (blockIdx.x == 0 && threadIdx.x == 0) { const unsigned long long until = __builtin_amdgcn_s_memrealtime() + (unsigned long long)PROBE_AMP * pt_acc;
        while (__builtin_amdgcn_s_memrealtime() < until) __builtin_amdgcn_s_sleep(32); }
#endif
}

extern "C" void kernel_launch(void* const* d_in, const int* in_sizes, int n_in, void* d_out, int out_size, void* d_ws, size_t ws_size, hipStream_t stream) {
    static int grid = 0;
    if (grid == 0) {
        if (n_in != 21 || out_size != M * D || ws_size < WS_END2) { fprintf(stderr, "kernel_launch: unexpected shapes (n_in %d, out %d, ws %zu)\n", n_in, out_size, ws_size); grid = -1; return; }
        int dev = 0, cus = 0, per_cu = 0;
        if (hipGetDevice(&dev) != hipSuccess || hipDeviceGetAttribute(&cus, hipDeviceAttributeMultiprocessorCount, dev) != hipSuccess) { grid = -1; return; }
        if (hipFuncSetAttribute((const void*)trunk_fwd, hipFuncAttributeMaxDynamicSharedMemorySize, LDS_BYTES) != hipSuccess) { fprintf(stderr, "kernel_launch: hipFuncSetAttribute failed\n"); grid = -1; return; }
        if (hipOccupancyMaxActiveBlocksPerMultiprocessor(&per_cu, (const void*)trunk_fwd, NTHR, LDS_BYTES) != hipSuccess || per_cu < 1) { fprintf(stderr, "kernel_launch: occupancy query says %d\n", per_cu); }
        (void)hipGetLastError();
        grid = cus > 256 ? 256 : cus;
    }
    if (grid < 0) return;
    if (hipMemsetAsync((char*)d_ws + WS_CTL, 0, CTL_ZERO_BYTES, stream) != hipSuccess) return;
    Args a{};
    for (int i = 0; i < 21; ++i) a.in[i] = (const float*)d_in[i];
    a.out = (float*)d_out; a.ws = (unsigned char*)d_ws;
    hipLaunchKernelGGL(trunk_fwd, dim3(grid), dim3(NTHR), LDS_BYTES, stream, a);
}
```

```cpp
#include <hip/hip_runtime.h>
#include <cstdio>
#include <cstdint>
namespace pg8 {
#define PG8_LAS __attribute__((address_space(3)))
typedef unsigned short bf16_t;
typedef short bf16x8 __attribute__((ext_vector_type(8)));
typedef float f32x4 __attribute__((ext_vector_type(4)));
typedef unsigned u32x4 __attribute__((ext_vector_type(4)));
constexpr int BM = 256, BK = 64, HALF = 128, HTB = HALF * BK * 2  , STAGE_BYTES = 8 * HTB, NXCD = 8, WGM = 8;

__host__ __device__ __forceinline__ int lds_byte(int r, int c) { const int st = (r >> 4) * 2 + (c >> 5), rr = r & 15, cc = c & 31, ob = rr * 64 + cc * 2; return st * 1024 + (ob ^ (((ob >> 9) & 1) << 5)); }
__host__ __device__ __forceinline__ void stage_rc(int b, int& R, int& C) { const int st = b / 1024, sb = b % 1024, swz = sb ^ (((sb >> 9) & 1) << 5); R = (st >> 1) * 16 + swz / 64; C = (st & 1) * 32 + (swz % 64) / 2; }
__host__ __device__ __forceinline__ int perm32(int rho) { const int n = rho >> 4, i = rho & 15; return 8 * (i >> 2) + 4 * n + (i & 3); }

struct Unit { int pm, pn; };
struct Gemm { const bf16_t* A; const bf16_t* Bt; int M, N, K; };

struct StaticOrder {
    int nM, nN, nwg, G, c, wgm;
    __host__ __device__ void init(int M, int N, int G_, int c_, int wgm_ = 4) { nM = M / BM; nN = N / BM; nwg = nM * nN; G = G_; c = c_; wgm = wgm_; }
    __host__ __device__ bool next(int i, Unit& u) const {
        const long L = (long)i * G + c; if (L >= nwg) return false;
        int wgid = (int)L; { const int q = nwg / NXCD, r = nwg % NXCD, xcd = wgid % NXCD, off = wgid / NXCD; wgid = (xcd < r ? xcd * (q + 1) : r * (q + 1) + (xcd - r) * q) + off; }
        const int nig = wgm * nN, gid = wgid / nig, fm = gid * wgm, gsz = (nM - fm) < wgm ? (nM - fm) : wgm;
        u.pm = fm + ((wgid % nig) % gsz); u.pn = (wgid % nig) / gsz; return true;
    }
    __device__ __forceinline__ void a_ready(const Unit&) const {}
    __device__ __forceinline__ void done(const Unit&) const {}
};

__device__ __forceinline__ unsigned cvt_pk_bf16(float lo, float hi) { unsigned r; asm volatile("v_cvt_pk_bf16_f32 %0, %1, %2" : "=v"(r) : "v"(lo), "v"(hi)); return r; }
typedef float f32x2 __attribute__((ext_vector_type(2)));
template <class Epi, class Sched, bool ALIGN_EPI = false, bool SP2 = false>
__device__ __forceinline__ void gemm_phase(PG8_LAS unsigned char* lds, const Gemm g, const Sched& S, const Epi& E) {
    int tid_l = threadIdx.x; asm volatile("" : "+v"(tid_l));
    const int tid = tid_l, wid = __builtin_amdgcn_readfirstlane(tid >> 6), lane = tid & 63, wr = wid >> 2, wc = wid & 3, fr = lane & 15, fq = lane >> 4;
    const int K = g.K, nt = K / BK;
    unsigned voffA[2], voffB[2];
#pragma unroll
    for (int i = 0; i < 2; ++i) { int R, C; stage_rc(tid * 16 + i * 8192, R, C); const int Rb = Epi::PERM ? ((R & ~31) + perm32(R & 31)) : R;
        voffA[i] = (unsigned)(R * K + C) * 2u; voffB[i] = (unsigned)(Rb * K + C) * 2u; }
    const size_t kstep = (size_t)(BK * 2);
    const size_t hstep = (size_t)HALF * K * 2;
    const size_t tstep = 2 * hstep;
    const unsigned ldsw = (unsigned)wid * 1024u;
    const int aoff = lds_byte(wr * 64 + fr, fq * 8), boff = lds_byte(wc * 32 + fr, fq * 8);
#define PG8_SA(b, h) (((b) * 2 + (h)) * HTB)
#define PG8_SB(b, h) ((4 + (b) * 2 + (h)) * HTB)
#define PG8_STAGE(bufoff, gbase, voff) do { _Pragma("unroll") for (int _i = 0; _i < 2; ++_i) \
        __builtin_amdgcn_global_load_lds((const unsigned*)((const char*)(gbase) + (voff)[_i]), (PG8_LAS unsigned*)(lds + (bufoff) + ldsw + _i * 8192), 16, 0, 0); } while (0)
#define PG8_LDA(dst, b, h) do { _Pragma("unroll") for (int m = 0; m < 4; ++m) _Pragma("unroll") for (int k = 0; k < 2; ++k) dst[m][k] = *(const PG8_LAS bf16x8*)(lds + PG8_SA(b, h) + aoff + m * 2048 + k * 1024); } while (0)
#define PG8_LDB(dst, b, h) do { _Pragma("unroll") for (int n = 0; n < 2; ++n) _Pragma("unroll") for (int k = 0; k < 2; ++k) dst[n][k] = *(const PG8_LAS bf16x8*)(lds + PG8_SB(b, h) + boff + n * 2048 + k * 1024); } while (0)
#define PG8_MMA(ai, bj, At, Bt) do { __builtin_amdgcn_s_setprio(1); _Pragma("unroll") for (int m = 0; m < 4; ++m) _Pragma("unroll") for (int n = 0; n < 2; ++n) _Pragma("unroll") for (int k = 0; k < 2; ++k) \
        acc[ai][bj][m][n] = __builtin_amdgcn_mfma_f32_16x16x32_bf16(Bt[n][k], At[m][k], acc[ai][bj][m][n], 0, 0, 0); __builtin_amdgcn_s_setprio(0); } while (0)
#define PG8_WAIT_V(n) asm volatile("s_waitcnt vmcnt(" #n ")" ::: "memory")
#define PG8_WAIT_L(n) asm volatile("s_waitcnt lgkmcnt(" #n ")" ::: "memory")
#define PG8_BAR __builtin_amdgcn_s_barrier()
#define PG8_SCHED __builtin_amdgcn_sched_barrier(0)
    Unit cur, nxt; int ui = 0;
    if (!S.next(0, cur)) return;
    f32x4 acc[2][2][4][2];
#pragma unroll
    for (int a = 0; a < 2; ++a)
#pragma unroll
        for (int b = 0; b < 2; ++b)
#pragma unroll
            for (int m = 0; m < 4; ++m)
#pragma unroll
                for (int n = 0; n < 2; ++n) acc[a][b][m][n] = (f32x4){0.f, 0.f, 0.f, 0.f};
    bf16x8 At[4][2], B0[2][2], B1[2][2];
    const char* cA = (const char*)g.A + (size_t)cur.pm * tstep; const char* cB = (const char*)g.Bt + (size_t)cur.pn * tstep;
    S.a_ready(cur);
    if constexpr (SP2) {
        PG8_STAGE(PG8_SB(0, 0), cB, voffB); PG8_STAGE(PG8_SB(0, 1), cB + hstep, voffB); PG8_STAGE(PG8_SA(0, 0), cA, voffA); PG8_STAGE(PG8_SA(0, 1), cA + hstep, voffA);
        if (wr == 1) PG8_BAR;
        PG8_WAIT_V(2); PG8_BAR;
        PG8_STAGE(PG8_SB(1, 0), cB + kstep, voffB); PG8_STAGE(PG8_SA(1, 0), cA + kstep, voffA); PG8_STAGE(PG8_SB(1, 1), cB + hstep + kstep, voffB);
        PG8_WAIT_V(6); PG8_BAR;
    } else {
        PG8_STAGE(PG8_SB(0, 0), cB, voffB); PG8_STAGE(PG8_SA(0, 0), cA, voffA); PG8_STAGE(PG8_SB(0, 1), cB + hstep, voffB); PG8_STAGE(PG8_SA(0, 1), cA + hstep, voffA);
        if (wr == 1) PG8_BAR;
        PG8_WAIT_V(4); PG8_BAR;
        PG8_STAGE(PG8_SB(1, 0), cB + kstep, voffB); PG8_STAGE(PG8_SA(1, 0), cA + kstep, voffA); PG8_STAGE(PG8_SB(1, 1), cB + hstep + kstep, voffB);
        PG8_WAIT_V(6); PG8_BAR;
    }
    for (;;) {
        const bool has_next = S.next(ui + 1, nxt);
        const char* nA = has_next ? (const char*)g.A + (size_t)nxt.pm * tstep : cA; const char* nB = has_next ? (const char*)g.Bt + (size_t)nxt.pn * tstep : cB;
        for (int t = 0; t < nt; t += 2) {
            const bool last = (t == nt - 2);
            const char* a1 = cA + (size_t)(t + 1) * kstep;
            const char* a2 = last ? nA : cA + (size_t)(t + 2) * kstep; const char* b2 = last ? nB : cB + (size_t)(t + 2) * kstep;
            const char* a3 = a2 + kstep; const char* b3 = b2 + kstep;
            if (last && has_next) S.a_ready(nxt);
            if constexpr (SP2) {
            PG8_LDB(B0, 0, 0); PG8_LDB(B1, 0, 1); PG8_SCHED; PG8_LDA(At, 0, 0); PG8_STAGE(PG8_SA(1, 1), a1 + hstep, voffA);
            PG8_WAIT_V(8); PG8_WAIT_L(0); PG8_BAR; PG8_MMA(0, 0, At, B0); PG8_MMA(0, 1, At, B1); PG8_BAR; PG8_SCHED;
            PG8_LDA(At, 0, 1); PG8_STAGE(PG8_SB(0, 0), b2, voffB); PG8_STAGE(PG8_SB(0, 1), b2 + hstep, voffB); PG8_STAGE(PG8_SA(0, 0), a2, voffA);
            PG8_WAIT_V(8); PG8_WAIT_L(0); PG8_BAR; PG8_MMA(1, 0, At, B0); PG8_MMA(1, 1, At, B1); PG8_BAR; PG8_SCHED;
            PG8_LDB(B0, 1, 0); PG8_LDB(B1, 1, 1); PG8_SCHED; PG8_LDA(At, 1, 0); PG8_STAGE(PG8_SA(0, 1), a2 + hstep, voffA);
            PG8_WAIT_V(8); PG8_WAIT_L(0); PG8_BAR; PG8_MMA(0, 0, At, B0); PG8_MMA(0, 1, At, B1); PG8_BAR; PG8_SCHED;
            PG8_LDA(At, 1, 1); PG8_STAGE(PG8_SB(1, 0), b3, voffB); PG8_STAGE(PG8_SB(1, 1), b3 + hstep, voffB); PG8_STAGE(PG8_SA(1, 0), a3, voffA);
            PG8_WAIT_V(8); PG8_WAIT_L(0); PG8_BAR; PG8_MMA(1, 0, At, B0); PG8_MMA(1, 1, At, B1); PG8_BAR; PG8_SCHED;
            } else {
            PG8_LDB(B0, 0, 0); PG8_SCHED; PG8_LDA(At, 0, 0); PG8_STAGE(PG8_SA(1, 1), a1 + hstep, voffA);
            PG8_WAIT_L(8); PG8_BAR; PG8_WAIT_L(0); PG8_MMA(0, 0, At, B0); PG8_BAR; PG8_SCHED;
            PG8_LDB(B1, 0, 1); PG8_STAGE(PG8_SB(0, 0), b2, voffB);
            PG8_BAR; PG8_WAIT_L(0); PG8_MMA(0, 1, At, B1); PG8_BAR;
            PG8_LDA(At, 0, 1); PG8_STAGE(PG8_SA(0, 0), a2, voffA);
            PG8_BAR; PG8_WAIT_L(0); PG8_MMA(1, 0, At, B0); PG8_BAR; PG8_SCHED;
            PG8_STAGE(PG8_SB(0, 1), b2 + hstep, voffB);
            PG8_WAIT_V(6); PG8_BAR; PG8_MMA(1, 1, At, B1); PG8_BAR;
            PG8_LDB(B0, 1, 0); PG8_SCHED; PG8_LDA(At, 1, 0); PG8_STAGE(PG8_SA(0, 1), a2 + hstep, voffA);
            PG8_WAIT_L(8); PG8_BAR; PG8_WAIT_L(0); PG8_MMA(0, 0, At, B0); PG8_BAR; PG8_SCHED;
            PG8_LDB(B1, 1, 1); PG8_STAGE(PG8_SB(1, 0), b3, voffB);
            PG8_BAR; PG8_WAIT_L(0); PG8_MMA(0, 1, At, B1); PG8_BAR;
            PG8_LDA(At, 1, 1); PG8_STAGE(PG8_SA(1, 0), a3, voffA);
            PG8_BAR; PG8_WAIT_L(0); PG8_MMA(1, 0, At, B0); PG8_BAR; PG8_SCHED;
            PG8_STAGE(PG8_SB(1, 1), b3 + hstep, voffB);
            PG8_WAIT_V(6); PG8_BAR; PG8_MMA(1, 1, At, B1); PG8_BAR;
            }
        }
        if constexpr (ALIGN_EPI) { if (wr == 0) PG8_BAR; }
#ifdef PROBE_EPI
        const unsigned long long te0_ = __builtin_amdgcn_s_memrealtime();
#endif
        if constexpr (!Epi::AFTER_DRAIN) { E(acc, cur, wr, wc, fr, fq); S.done(cur); }
#ifdef PROBE_EPI
        if (tid == 0) { volatile PG8_LAS unsigned long long* pe_ = (volatile PG8_LAS unsigned long long*)(lds + 131072 + 320 + 64); pe_[0] = pe_[0] + (__builtin_amdgcn_s_memrealtime() - te0_); }
#endif
        if (!has_next) break;
#pragma unroll
        for (int a = 0; a < 2; ++a)
#pragma unroll
            for (int b = 0; b < 2; ++b)
#pragma unroll
                for (int m = 0; m < 4; ++m)
#pragma unroll
                    for (int n = 0; n < 2; ++n) acc[a][b][m][n] = (f32x4){0.f, 0.f, 0.f, 0.f};
        cur = nxt; cA = nA; cB = nB; ++ui;
        if constexpr (ALIGN_EPI) { if (wr == 1) PG8_BAR; }
    }
    PG8_WAIT_V(0);
    if constexpr (!ALIGN_EPI) { if (wr == 0) PG8_BAR; }
    PG8_BAR;
    if constexpr (Epi::AFTER_DRAIN) { E.fused(acc, cur, wr, wc, fr, fq, lds, wid, lane); S.done(cur); }
#undef PG8_SA
#undef PG8_SB
#undef PG8_STAGE
#undef PG8_LDA
#undef PG8_LDB
#undef PG8_MMA
#undef PG8_WAIT_V
#undef PG8_WAIT_L
#undef PG8_BAR
#undef PG8_SCHED
}
}
#define GAS __attribute__((address_space(1)))
#define LAS __attribute__((address_space(3)))
typedef unsigned short bf16;
typedef unsigned v4u __attribute__((ext_vector_type(4)));
typedef float f32x4 __attribute__((ext_vector_type(4)));
typedef short bf16x8 __attribute__((ext_vector_type(8)));
typedef GAS unsigned gu32;
typedef GAS unsigned long long gu64;
#define RLX_AGENT __ATOMIC_RELAXED, __HIP_MEMORY_SCOPE_AGENT
#define LDS_WAIT() asm volatile("s_waitcnt lgkmcnt(0)" ::: "memory")
#define VM_WAIT() asm volatile("s_waitcnt vmcnt(0)" ::: "memory")
__device__ __forceinline__ unsigned long long rt() { return __builtin_amdgcn_s_memrealtime(); }
__device__ __forceinline__ unsigned f2bf(float f) { unsigned u = __builtin_bit_cast(unsigned, f); return (u + 0x7fffu + ((u >> 16) & 1u)) >> 16; }
__device__ __forceinline__ unsigned pk2(float lo, float hi) { return f2bf(lo) | (f2bf(hi) << 16); }
typedef unsigned u32x4 __attribute__((ext_vector_type(4)));
#define XB_TMO      128
#define XB_XCNT(j)  (256  + 64 * (j))
#define XB_XSUB(j)  (1280 + 64 * (j))
#define XB_XGEN(j)  (2304 + 64 * (j))
#define XB_TOP      3328
#define XB_TOPGEN   3392
#define XCD_BAR_WORDS 3456
#define XB_SPIN_CAP (1u << 18)

__device__ __forceinline__ unsigned xb_ld(unsigned* p)              { return __hip_atomic_load(p, __ATOMIC_RELAXED, __HIP_MEMORY_SCOPE_AGENT); }
__device__ __forceinline__ unsigned xb_add(unsigned* p, unsigned v) { return __hip_atomic_fetch_add(p, v, __ATOMIC_RELAXED, __HIP_MEMORY_SCOPE_AGENT); }
__device__ __forceinline__ unsigned xb_xcc_id() { return (unsigned)__builtin_amdgcn_s_getreg((3 << 11) | 20) & 0xFu; }
#define XB_SPIN(cond, bar) do { unsigned _sp = 0; while (cond) { __builtin_amdgcn_s_sleep(1); \
    if ((++_sp & 255u) == 0u) { if (xb_ld(&(bar)[XB_TMO])) break; if (_sp > XB_SPIN_CAP) { atomicAdd(&(bar)[XB_TMO], 1u); break; } } } } while (0)

struct XcdBarrier {
    unsigned* bar; unsigned x;
    volatile LAS unsigned* st;
};

__device__ __forceinline__ XcdBarrier xcd_barrier_post(unsigned* bar, volatile LAS unsigned* st) {
    XcdBarrier b; b.bar = bar; b.x = xb_xcc_id(); b.st = st;
    if (threadIdx.x == 0) (void)xb_add(&bar[XB_XCNT(b.x)], 1u);
    return b;
}
__device__ __forceinline__ void xcd_barrier_complete(unsigned* bar, unsigned x, unsigned& nloc, unsigned& nx) {
    const unsigned G = gridDim.x * gridDim.y * gridDim.z;
    unsigned sum, cnt, mine, sp = 0u;
    for (;;) {
        sum = 0u; cnt = 0u; mine = 0u;
#pragma unroll
        for (unsigned j = 0; j < 16; ++j) { const unsigned c = xb_ld(&bar[XB_XCNT(j)]); sum += c; cnt += (c > 0u) ? 1u : 0u; mine = (j == x) ? c : mine; }
        if (sum == G) break;
        __builtin_amdgcn_s_sleep(1);
        if ((++sp & 255u) == 0u) { if (xb_ld(&bar[XB_TMO])) break; if (sp > XB_SPIN_CAP) { atomicAdd(&bar[XB_TMO], 1u); break; } }
    }
    nloc = mine > 0u ? mine : 1u; nx = cnt > 0u ? cnt : 1u;
}

__device__ __forceinline__ void xcd_barrier(const XcdBarrier& b) {
    asm volatile("s_waitcnt vmcnt(0)" ::: "memory");
    __syncthreads();
    if (threadIdx.x == 0) {
        unsigned* bar = b.bar;
        __builtin_amdgcn_s_waitcnt(0);
        unsigned nloc = b.st[0], nx = b.st[1];
        if (nloc == 0u) { xcd_barrier_complete(bar, b.x, nloc, nx); b.st[0] = nloc; b.st[1] = nx; }
        const unsigned old = xb_add(&bar[XB_XSUB(b.x)], 1u);
        const unsigned gen = old / nloc;
        if (old + 1u == (gen + 1u) * nloc) {
            __builtin_amdgcn_fence(__ATOMIC_RELEASE, "agent");
            asm volatile("s_waitcnt vmcnt(0)" ::: "memory");
            const unsigned og = xb_add(&bar[XB_TOP], 1u);
            const unsigned tg = og / nx;
            if (og + 1u == (tg + 1u) * nx) xb_add(&bar[XB_TOPGEN], 1u);
            else XB_SPIN(xb_ld(&bar[XB_TOPGEN]) == tg, bar);
            __builtin_amdgcn_fence(__ATOMIC_ACQUIRE, "agent");
            xb_add(&bar[XB_XGEN(b.x)], 1u);
            asm volatile("s_waitcnt vmcnt(0)" ::: "memory");
        } else {
            XB_SPIN(xb_ld(&bar[XB_XGEN(b.x)]) == gen, bar);
            __builtin_amdgcn_fence(__ATOMIC_ACQUIRE, "agent");
            asm volatile("s_waitcnt vmcnt(0)" ::: "memory");
        }
    }
    __syncthreads();
}

constexpr int NWAVES = 8, NTHR = 512;
constexpr int BATCH = 4, SEQ = 8192, M = BATCH * SEQ, D = 2048, NH = 16, HD = 128, FF = 8192, PLE = 256, DEPTH = 4;
constexpr int NA_IN = 6144, NB_IN = 4176, NB_PAD = 4352, NC_IN = 6160, NC_PAD = 6400;
constexpr int B_K = 2048, B_V = 2560, B_QI = 3072, B_KI = 4096, B_WI = 4160;
constexpr float RMS_EPS = 1e-6f, LOG2E = 1.4426950408889634f;
constexpr float QSCALE = 0.08838834764831845f * 1.4426950408889634f;
constexpr float ZERO_LOG2 = -160.f;

constexpr size_t MiB = 1u << 20;
constexpr size_t WS_CTL = 0, CTL_ZERO_BYTES = 1 * MiB;
constexpr size_t WS_ROPE32 = 1 * MiB, WS_ROPE16 = 2 * MiB, WS_CUM = 3 * MiB, WS_TOT = 5 * MiB, WS_RSTD = 6 * MiB;
constexpr size_t WS_WIN = 8 * MiB, WS_WO = 33 * MiB, WS_WUP = 41 * MiB, WS_WDN = 73 * MiB, WS_WG = 105 * MiB, WS_WPL = 113 * MiB;
constexpr size_t WS_PB = 120 * MiB, WS_HN = 184 * MiB, WS_PROJ = 312 * MiB, WS_MIX = 712 * MiB, WS_VT = 840 * MiB, WS_END = 968 * MiB;
constexpr size_t WS_HID = WS_PROJ, WS_PP = WS_VT, WS_HB0 = WS_HN, WS_HB1 = 968 * MiB, WS_SSP_IN = 1096 * MiB, WS_SSP_WO = 1100 * MiB, WS_SSP_DN = 1104 * MiB, WS_K8 = 1108 * MiB, WS_V8 = 1124 * MiB, WS_Q8 = 1140 * MiB, WS_END2 = 1204 * MiB;
constexpr size_t WS_SCR_A = WS_PROJ + 272 * MiB, WS_SCR_B = WS_VT;
static_assert(WS_HID + (size_t)M * FF * 2 <= WS_VT, "hidden overlays proj|mix");
static_assert(WS_PROJ + (size_t)M * NB_PAD * 2 <= WS_SCR_A && WS_SCR_A + 128 * MiB <= WS_MIX, "scratch A");

constexpr int CW_BAR = 4096;
constexpr int CW_QUEUE = 16384;

constexpr int RING_OFF = 0, RING_BYTES = 131072;
constexpr int LDSCTL_OFF = RING_BYTES, MISC_OFF = LDSCTL_OFF + 320;
constexpr int LDS_BYTES = 147456;

typedef float f32x16 __attribute__((ext_vector_type(16)));
typedef unsigned u32x2 __attribute__((ext_vector_type(2)));
typedef __bf16 bf16x2_t __attribute__((ext_vector_type(2)));
typedef float f32x2_t __attribute__((ext_vector_type(2)));
typedef short s16x4_t __attribute__((ext_vector_type(4)));

__device__ __forceinline__ float bf2f(unsigned short b) { return __builtin_bit_cast(float, (unsigned)b << 16); }
__device__ __forceinline__ float bflo(unsigned u) { return __builtin_bit_cast(float, u << 16); }
__device__ __forceinline__ float bfhi(unsigned u) { return __builtin_bit_cast(float, u & 0xffff0000u); }
__device__ __forceinline__ float relu_raw(float x) { const int i = __builtin_bit_cast(int, x); return __builtin_bit_cast(float, i > 0 ? i : 0); }
__device__ __forceinline__ unsigned cvtpk(float lo, float hi) { f32x2_t v = {lo, hi}; bf16x2_t b = __builtin_convertvector(v, bf16x2_t); return __builtin_bit_cast(unsigned, b); }
__device__ __forceinline__ float wave_sum(float v) {
#pragma unroll
    for (int o = 1; o < 64; o <<= 1) v += __shfl_xor(v, o);
    return v;
}
__device__ __forceinline__ float wave_max(float v) {
#pragma unroll
    for (int o = 1; o < 64; o <<= 1) v = fmaxf(v, __shfl_xor(v, o));
    return v;
}
__device__ __forceinline__ float wave_min(float v) {
#pragma unroll
    for (int o = 1; o < 64; o <<= 1) v = fminf(v, __shfl_xor(v, o));
    return v;
}
__device__ __forceinline__ float fexp2(float x) { return __builtin_amdgcn_exp2f(x); }
__device__ __forceinline__ float flog2(float x) { return __builtin_amdgcn_logf(x); }

namespace pg8 {
__device__ __forceinline__ void row_rstd(const float* ssp, int rowbase, int fr, int fq, float (&rs)[2][4]) {
    float mine[2];
#pragma unroll
    for (int t = 0; t < 2; ++t) { const int row = rowbase + (fq >> 1) * HALF + (2 * (fq & 1) + t) * 16 + fr;
        const f32x4* p = (const f32x4*)(ssp + (size_t)row * 32); float sm = 0.f;
#pragma unroll
        for (int q = 0; q < 8; ++q) { const f32x4 v = p[q]; sm += (v.x + v.y) + (v.z + v.w); }
        mine[t] = 1.f / sqrtf(sm * (1.f / 2048.f) + 1e-6f); }
#pragma unroll
    for (int ai = 0; ai < 2; ++ai)
#pragma unroll
        for (int m = 0; m < 4; ++m) { const int src = (ai * 2 + (m >> 1)) * 16 + fr; const float a = __shfl(mine[0], src), b = __shfl(mine[1], src); rs[ai][m] = (m & 1) ? b : a; }
}
template <int ACT  , bool SCALE>
struct EpiStore {
    static constexpr bool PERM = true, AFTER_DRAIN = false;
    bf16_t* O; int ldc; const float* ssp;
    __device__ __forceinline__ void operator()(const f32x4 (&acc)[2][2][4][2], const Unit& u, int wr, int wc, int fr, int fq) const {
        const int row0 = u.pm * BM + wr * 64 + fr, col0 = u.pn * BM + wc * 32 + 8 * fq;
        float rs[2][4];
        if (SCALE) row_rstd(ssp, u.pm * BM + wr * 64, fr, fq, rs);
#pragma unroll
        for (int ai = 0; ai < 2; ++ai)
#pragma unroll
            for (int m = 0; m < 4; ++m) { bf16_t* rowp = O + (size_t)(row0 + ai * HALF + m * 16) * ldc + col0; const float r = SCALE ? rs[ai][m] : 1.f;
#pragma unroll
                for (int bj = 0; bj < 2; ++bj) { f32x4 v0 = acc[ai][bj][m][0] * r, v1 = acc[ai][bj][m][1] * r;
                    if (ACT == 1) {
#pragma unroll
                        for (int e = 0; e < 4; ++e) { v0[e] = fmaxf(v0[e], 0.f); v0[e] *= v0[e]; v1[e] = fmaxf(v1[e], 0.f); v1[e] *= v1[e]; } }
                    u32x4 w; w.x = cvtpk(v0[0], v0[1]); w.y = cvtpk(v0[2], v0[3]); w.z = cvtpk(v1[0], v1[1]); w.w = cvtpk(v1[2], v1[3]);
                    *(u32x4*)(rowp + bj * HALF) = w; } }
    }
};
template <bool GATE  , bool FINAL  , bool SQ = false  >
struct EpiH {
    static constexpr bool PERM = true, AFTER_DRAIN = false;
    const bf16_t* hin; bf16_t* hout; float* sspo; const bf16_t* pp; const float* sspi; float* outf;
    __device__ __forceinline__ void operator()(const f32x4 (&acc)[2][2][4][2], const Unit& u, int wr, int wc, int fr, int fq) const {
        constexpr int ld = 2048;
        const int row0 = u.pm * BM + wr * 64 + fr, col0 = u.pn * BM + wc * 32 + 8 * fq;
        float rs[2][4];
        u32x4 rh[2][2], rp[2][2];
        { const size_t off = (size_t)row0 * ld + col0;
#pragma unroll
          for (int bj = 0; bj < 2; ++bj) { rh[0][bj] = *(const u32x4*)(hin + off + bj * HALF); if (GATE) rp[0][bj] = *(const u32x4*)(pp + off + bj * HALF); } }
        if (GATE || SQ) row_rstd(sspi, u.pm * BM + wr * 64, fr, fq, rs);
#pragma unroll
        for (int r = 0; r < 8; ++r) { const int ai = r >> 2, m = r & 3, cb = r & 1, nb = cb ^ 1;
            const int row = row0 + ai * HALF + m * 16; const size_t off = (size_t)row * ld + col0;
            if (r + 1 < 8) { const int ai2 = (r + 1) >> 2, m2 = (r + 1) & 3; const size_t off2 = (size_t)(row0 + ai2 * HALF + m2 * 16) * ld + col0;
#pragma unroll
                for (int bj = 0; bj < 2; ++bj) { rh[nb][bj] = *(const u32x4*)(hin + off2 + bj * HALF); if (GATE) rp[nb][bj] = *(const u32x4*)(pp + off2 + bj * HALF); } }
            float ss = 0.f;
#pragma unroll
            for (int bj = 0; bj < 2; ++bj) { const u32x4 hv = rh[cb][bj];
                f32x4 a = {bflo(hv.x), bfhi(hv.x), bflo(hv.y), bfhi(hv.y)}, b = {bflo(hv.z), bfhi(hv.z), bflo(hv.w), bfhi(hv.w)};
                const f32x4 v0 = acc[ai][bj][m][0], v1 = acc[ai][bj][m][1];
                if (GATE) { const u32x4 p = rp[cb][bj]; const float rr = rs[ai][m] * (-LOG2E);
                    const f32x4 p0 = {bflo(p.x), bfhi(p.x), bflo(p.y), bfhi(p.y)}, p1 = {bflo(p.z), bfhi(p.z), bflo(p.w), bfhi(p.w)};
#pragma unroll
                    for (int e = 0; e < 4; ++e) { a[e] += __builtin_amdgcn_rcpf(1.f + fexp2(rr * v0[e])) * p0[e]; b[e] += __builtin_amdgcn_rcpf(1.f + fexp2(rr * v1[e])) * p1[e]; }
                } else if (SQ) { const float r2 = rs[ai][m] * rs[ai][m]; a += v0 * r2; b += v1 * r2; }
                else { a += v0; b += v1; }
                if (FINAL) { *(f32x4*)(outf + off + bj * HALF) = a; *(f32x4*)(outf + off + bj * HALF + 4) = b; }
                else { u32x4 w; w.x = cvtpk(a[0], a[1]); w.y = cvtpk(a[2], a[3]); w.z = cvtpk(b[0], b[1]); w.w = cvtpk(b[2], b[3]);
                    *(u32x4*)(hout + off + bj * HALF) = w;
                    ss += (a[0] * a[0] + a[1] * a[1]) + (a[2] * a[2] + a[3] * a[3]) + (b[0] * b[0] + b[1] * b[1]) + (b[2] * b[2] + b[3] * b[3]); } }
            if (!FINAL) { ss += __shfl_xor(ss, 16); ss += __shfl_xor(ss, 32);
                if (fq == 0) sspo[(size_t)row * 32 + u.pn * 4 + wc] = ss; } }
    }
};
}

struct Args { const float* in[21]; float* out; unsigned char* ws; };
enum { I_X = 0, I_P, I_ATTN_NORM, I_WO, I_MLP_NORM, I_WUP, I_WDOWN, I_PLE_NORM, I_WGATE, I_WPLE, I_A_WIN, I_A_QN, I_A_KN, I_B_WIN, I_B_QN, I_B_KN, I_B_IKN, I_C_WIN, I_C_BF, I_C_QN, I_C_KN };

__device__ __forceinline__ void transpose_item(const float* W, const float* gain, int K, int N, bf16* WT, int kb, int nb, int lane) {
    const int k0 = 64 * kb, n = 64 * nb + lane; const bool ok = n < N;
    const float* src = W + (size_t)k0 * N + (ok ? n : 0);
    float v[64];
#pragma unroll
    for (int r = 0; r < 64; ++r) v[r] = src[(size_t)r * N];
    if (gain) {
#pragma unroll
        for (int r = 0; r < 64; ++r) v[r] *= gain[k0 + r];
    }
    bf16* dst = WT + (size_t)n * K + k0;
#pragma unroll
    for (int c = 0; c < 8; ++c) { v4u o;
        o.x = ok ? cvtpk(v[8 * c + 0], v[8 * c + 1]) : 0u; o.y = ok ? cvtpk(v[8 * c + 2], v[8 * c + 3]) : 0u; o.z = ok ? cvtpk(v[8 * c + 4], v[8 * c + 5]) : 0u; o.w = ok ? cvtpk(v[8 * c + 6], v[8 * c + 7]) : 0u;
        *(v4u*)(dst + 8 * c) = o; }
}
__device__ __forceinline__ void convert_weight(const float* W, const float* gain, int K, int N, int Npad, bf16* WT, LAS float* scr, int gw, int ngw, int lane) {
    const int nblk = Npad / 64, nitems = (K / 64) * nblk;
    for (int it = gw; it < nitems; it += ngw) transpose_item(W, gain, K, N, WT, it / nblk, it % nblk, lane);
}
__device__ __forceinline__ void x_rows(const float* src, bf16* hb, float* ssp, int gw, int ngw, int lane) {
    for (int m = gw; m < M; m += ngw) {
        const f32x4* xr = (const f32x4*)(src + (size_t)m * D) + lane;
        f32x4 v[8]; float ss = 0.f;
#pragma unroll
        for (int j = 0; j < 8; ++j) { v[j] = xr[64 * j]; ss += (v[j].x * v[j].x + v[j].y * v[j].y) + (v[j].z * v[j].z + v[j].w * v[j].w); }
        ss = wave_sum(ss);
        unsigned long long* o8 = (unsigned long long*)(hb + (size_t)m * D) + lane;
#pragma unroll
        for (int j = 0; j < 8; ++j) o8[64 * j] = (unsigned long long)cvtpk(v[j].x, v[j].y) | ((unsigned long long)cvtpk(v[j].z, v[j].w) << 32);
        if (lane < 32) ssp[(size_t)m * 32 + lane] = lane == 0 ? ss : 0.f;
    }
}

__device__ __forceinline__ void rmsnorm_rows(const float* src, const float* g, bf16* dst, int gw, int ngw, int lane) {
    for (int m = gw; m < M; m += ngw) {
        const f32x4* xr = (const f32x4*)(src + (size_t)m * D) + lane;
        f32x4 v[8]; float ss = 0.f;
#pragma unroll
        for (int j = 0; j < 8; ++j) { v[j] = xr[64 * j]; ss += (v[j].x * v[j].x + v[j].y * v[j].y) + (v[j].z * v[j].z + v[j].w * v[j].w); }
        const float rstd = 1.f / sqrtf(wave_sum(ss) * (1.f / D) + RMS_EPS);
        unsigned long long* o8 = (unsigned long long*)(dst + (size_t)m * D) + lane;
#pragma unroll
        for (int j = 0; j < 8; ++j) { const f32x4 gg = ((const f32x4*)g)[lane + 64 * j];
            o8[64 * j] = (unsigned long long)cvtpk(v[j].x * rstd * gg.x, v[j].y * rstd * gg.y) | ((unsigned long long)cvtpk(v[j].z * rstd * gg.z, v[j].w * rstd * gg.w) << 32); }
    }
}

template <bool ROPE>
__device__ __forceinline__ void head128_norm(bf16* p, const u32x4 raw, const float a  , const float* gain, float scale, const float2* rope, int lane, unsigned char* f8out = nullptr) {
    float x[8] = {bflo(raw.x), bfhi(raw.x), bflo(raw.y), bfhi(raw.y), bflo(raw.z), bfhi(raw.z), bflo(raw.w), bfhi(raw.w)};
    float ss = 0.f;
#pragma unroll
    for (int e = 0; e < 8; ++e) ss += x[e] * x[e];
    ss += __shfl_xor(ss, 1); ss += __shfl_xor(ss, 2); ss += __shfl_xor(ss, 4); ss += __shfl_xor(ss, 8);
    const float rstd = a / sqrtf(a * a * ss * (1.f / 128.f) + RMS_EPS);
    const int lh = lane & 15;
    const f32x4 g0 = *(const f32x4*)(gain + 8 * lh), g1 = *(const f32x4*)(gain + 8 * lh + 4);
    const float gg[8] = {g0.x, g0.y, g0.z, g0.w, g1.x, g1.y, g1.z, g1.w};
#pragma unroll
    for (int e = 0; e < 8; ++e) x[e] = x[e] * rstd * gg[e];
    if (ROPE) {
        float px[8];
#pragma unroll
        for (int e = 0; e < 8; ++e) px[e] = __shfl_xor(x[e], 2);
        if (lh < 4) {
#pragma unroll
            for (int e = 0; e < 8; ++e) { const float2 cs = rope[8 * (lh & 1) + e];
                x[e] = (lh < 2) ? (x[e] * cs.x - px[e] * cs.y) : (px[e] * cs.y + x[e] * cs.x); }
        }
    }
    if (f8out) {
        int w0 = 0, w1 = 0;
        w0 = __builtin_amdgcn_cvt_pk_fp8_f32(x[0] * scale, x[1] * scale, w0, false); w0 = __builtin_amdgcn_cvt_pk_fp8_f32(x[2] * scale, x[3] * scale, w0, true);
        w1 = __builtin_amdgcn_cvt_pk_fp8_f32(x[4] * scale, x[5] * scale, w1, false); w1 = __builtin_amdgcn_cvt_pk_fp8_f32(x[6] * scale, x[7] * scale, w1, true);
        *(u32x2*)f8out = (u32x2){(unsigned)w0, (unsigned)w1};
    } else {
        u32x4 w; w.x = cvtpk(x[0] * scale, x[1] * scale); w.y = cvtpk(x[2] * scale, x[3] * scale); w.z = cvtpk(x[4] * scale, x[5] * scale); w.w = cvtpk(x[6] * scale, x[7] * scale);
        *(u32x4*)p = w;
    }
}
template <bool NORM>
__device__ __forceinline__ void head64_rope(bf16* p, const u32x4 raw, const float a, const float* gain, const float2* rope, int lane, bool active) {
    float x[8] = {bflo(raw.x) * a, bfhi(raw.x) * a, bflo(raw.y) * a, bfhi(raw.y) * a, bflo(raw.z) * a, bfhi(raw.z) * a, bflo(raw.w) * a, bfhi(raw.w) * a};
    const int li = lane & 7;
    if (NORM) {
        float ss = 0.f;
#pragma unroll
        for (int e = 0; e < 8; ++e) ss += x[e] * x[e];
        ss += __shfl_xor(ss, 1); ss += __shfl_xor(ss, 2); ss += __shfl_xor(ss, 4);
        const float rstd = 1.f / sqrtf(ss * (1.f / 64.f) + RMS_EPS);
        const f32x4 g0 = *(const f32x4*)(gain + 8 * li), g1 = *(const f32x4*)(gain + 8 * li + 4);
        const float gg[8] = {g0.x, g0.y, g0.z, g0.w, g1.x, g1.y, g1.z, g1.w};
#pragma unroll
        for (int e = 0; e < 8; ++e) x[e] = x[e] * rstd * gg[e];
    }
    float px[8];
#pragma unroll
    for (int e = 0; e < 8; ++e) px[e] = __shfl_xor(x[e], 1);
    if (li < 2) {
#pragma unroll
        for (int e = 0; e < 8; ++e) { const float2 cs = rope[e];
            x[e] = (li == 0) ? (x[e] * cs.x - px[e] * cs.y) : (px[e] * cs.y + x[e] * cs.x); }
    }
    if (active) { u32x4 w; w.x = cvtpk(x[0], x[1]); w.y = cvtpk(x[2], x[3]); w.z = cvtpk(x[4], x[5]); w.w = cvtpk(x[6], x[7]); *(u32x4*)p = w; }
}

__device__ __forceinline__ void vt_item(const bf16* proj, int ldp, int voff, const float* rstdv, bf16* VT, LAS unsigned char* tile, int item, int lane) {
    const int h = item & 15, tc = (item >> 4) & 255, b = item >> 12;
    const size_t row0 = (size_t)b * SEQ + 32 * tc;
#pragma unroll
    for (int i = 0; i < 8; ++i) { const int tok = 4 * i + (lane >> 4), ch = lane & 15;
        const u32x4 v = *(const u32x4*)(proj + (row0 + tok) * ldp + voff + h * 128 + ch * 8); const float a = rstdv[row0 + tok];
        LAS u32x2* d = (LAS u32x2*)(tile + tok * 264 + ch * 16);
        d[0] = (u32x2){cvtpk(bflo(v.x) * a, bfhi(v.x) * a), cvtpk(bflo(v.y) * a, bfhi(v.y) * a)}; d[1] = (u32x2){cvtpk(bflo(v.z) * a, bfhi(v.z) * a), cvtpk(bflo(v.w) * a, bfhi(v.w) * a)}; }
    LDS_WAIT(); asm volatile("" ::: "memory");
#pragma unroll
    for (int i = 0; i < 8; ++i) { const int d = 16 * i + (lane >> 2), tg = lane & 3;
        const LAS unsigned short* s = (const LAS unsigned short*)(tile + (8 * tg) * 264 + d * 2);
        u32x4 w; w.x = (unsigned)s[0] | ((unsigned)s[132] << 16); w.y = (unsigned)s[2 * 132] | ((unsigned)s[3 * 132] << 16);
        w.z = (unsigned)s[4 * 132] | ((unsigned)s[5 * 132] << 16); w.w = (unsigned)s[6 * 132] | ((unsigned)s[7 * 132] << 16);
        *(u32x4*)(VT + ((size_t)(b * 16 + h) * 128 + d) * SEQ + 32 * tc + 8 * tg) = w; }
    LDS_WAIT(); asm volatile("" ::: "memory");
}

__device__ __forceinline__ void cumchunk_item(const bf16* proj, int ldp, const float* rstdv, const float* bfv, float* cum2, float* tot, int item, int lane) {
    const int b = item >> 7, ch = item & 127; const int t = 64 * ch + lane;
    const bf16* gp = proj + ((size_t)b * SEQ + t) * ldp + 3 * D;
    const u32x4 g0 = *(const u32x4*)gp, g1 = *(const u32x4*)(gp + 8);
    const float x[16] = {bflo(g0.x), bfhi(g0.x), bflo(g0.y), bfhi(g0.y), bflo(g0.z), bfhi(g0.z), bflo(g0.w), bfhi(g0.w), bflo(g1.x), bfhi(g1.x), bflo(g1.y), bfhi(g1.y), bflo(g1.z), bfhi(g1.z), bflo(g1.w), bfhi(g1.w)};
    const float a = rstdv[(size_t)b * SEQ + t];
#pragma unroll
    for (int h = 0; h < 16; ++h) { const float y = x[h] * a + bfv[h];
        float lf = -(fmaxf(-y, 0.f) + log1pf(expf(-fabsf(y)))) * LOG2E;
#pragma unroll
        for (int o = 1; o < 64; o <<= 1) { const float u = __shfl_up(lf, o); if (lane >= o) lf += u; }
        cum2[((size_t)(b * 16 + h)) * SEQ + t] = lf;
        if (lane == 63) tot[(b * 16 + h) * 128 + ch] = lf; }
}

#define MFMA32(a, b, c) __builtin_amdgcn_mfma_f32_32x32x16_bf16((a), (b), (c), 0, 0, 0)
#define MFMA16(a, b, c) __builtin_amdgcn_mfma_f32_16x16x32_bf16((a), (b), (c), 0, 0, 0)
template <int MODE>
__device__ __forceinline__ void attn_dense_item(const bf16* proj, int ldp, const bf16* VT, const float* cum2, bf16* mix, float zb2, int qt, int bh, int lane) {
    const int b = bh >> 4, h = bh & 15;
    const int n = lane & 31, hi = lane >> 5, q0 = 32 * qt;
    const size_t row0 = (size_t)b * SEQ;
    const int prow = (n & 0x13) | ((n & 4) << 1) | ((n & 8) >> 1);
    bf16x8 qf[8];
    { const bf16* qp = proj + (row0 + q0 + n) * ldp + h * 128 + hi * 8;
#pragma unroll
      for (int kk = 0; kk < 8; ++kk) qf[kk] = *(const bf16x8*)(qp + kk * 16); }
    f32x16 o[4];
#pragma unroll
    for (int d = 0; d < 4; ++d)
#pragma unroll
        for (int i = 0; i < 16; ++i) o[d][i] = 0.f;
    float R = 0.f, mrun = -1e30f, lrun = 0.f, cq = 0.f;
    const float* cb = cum2 + (size_t)bh * SEQ;
    if (MODE == 1) cq = cb[q0 + n];
    const int tq = q0 + n;
    const bf16* kbase = proj + (row0 + prow) * ldp + D + h * 128 + hi * 8;
    bf16x8 kf[8];
#pragma unroll
    for (int kk = 0; kk < 8; ++kk) kf[kk] = *(const bf16x8*)(kbase + (size_t)q0 * ldp + kk * 16);
    for (int kb = q0; kb >= 0; kb -= 32) {
        if (MODE == 0) { if (__all(R + zb2 < ZERO_LOG2)) break; }
        else { const float dmax = cb[q0] - cb[kb + 31]; if (dmax + 2.f * zb2 < ZERO_LOG2) break; }
        bf16x8 vf[4][2];
#pragma unroll
        for (int d = 0; d < 4; ++d)
#pragma unroll
            for (int s = 0; s < 2; ++s) vf[d][s] = *(const bf16x8*)(VT + ((size_t)bh * 128 + d * 32 + n) * SEQ + kb + 16 * s + 8 * hi);
        f32x16 sc;
#pragma unroll
        for (int i = 0; i < 16; ++i) sc[i] = 0.f;
#pragma unroll
        for (int kk = 0; kk < 8; ++kk) sc = MFMA32(kf[kk], qf[kk], sc);
        if (kb >= 32) {
#pragma unroll
            for (int kk = 0; kk < 8; ++kk) kf[kk] = *(const bf16x8*)(kbase + (size_t)(kb - 32) * ldp + kk * 16);
        }
        const bool diag = (kb == q0);
        float w[16];
        if (MODE == 0) {
            float L[16];
#pragma unroll
            for (int i = 0; i < 16; ++i) { const int key = kb + 16 * (i >> 3) + 8 * hi + (i & 7);
                const bool valid = !diag || (key < tq);
                L[i] = valid ? -flog2(1.f + fexp2(sc[i])) : 0.f; }
            float G0 = 0.f, G1 = 0.f;
#pragma unroll
            for (int j = 0; j < 8; ++j) { G0 += L[j]; G1 += L[8 + j]; }
            const float Gp0 = __shfl_xor(G0, 32), Gp1 = __shfl_xor(G1, 32);
            const float pre1 = hi ? R : (R + Gp1);
            const float pre0 = hi ? (R + G1 + Gp1) : (R + Gp1 + G1 + Gp0);
            float c = pre1;
#pragma unroll
            for (int j = 7; j >= 0; --j) { c += L[8 + j]; const int key = kb + 16 + 8 * hi + j; w[8 + j] = (!diag || key < tq) ? fexp2(sc[8 + j] + c) : 0.f; }
            c = pre0;
#pragma unroll
            for (int j = 7; j >= 0; --j) { c += L[j]; const int key = kb + 8 * hi + j; w[j] = (!diag || key < tq) ? fexp2(sc[j] + c) : 0.f; }
            R += (G0 + G1) + (Gp0 + Gp1);
        } else {
            float lg[16]; float bm = -3e38f;
#pragma unroll
            for (int s = 0; s < 2; ++s) { const f32x4 c0 = *(const f32x4*)(cb + kb + 16 * s + 8 * hi), c1 = *(const f32x4*)(cb + kb + 16 * s + 8 * hi + 4);
                const float ck[8] = {c0.x, c0.y, c0.z, c0.w, c1.x, c1.y, c1.z, c1.w};
#pragma unroll
                for (int j = 0; j < 8; ++j) { const int i = 8 * s + j, key = kb + 16 * s + 8 * hi + j;
                    const float v = sc[i] + (cq - ck[j]);
                    lg[i] = (!diag || key <= tq) ? v : -3e38f; bm = fmaxf(bm, lg[i]); } }
            bm = fmaxf(bm, __shfl_xor(bm, 32));
            const float mn = fmaxf(mrun, bm), alpha = fexp2(mrun - mn);
            mrun = mn;
            float ps = 0.f;
#pragma unroll
            for (int i = 0; i < 16; ++i) { w[i] = fexp2(lg[i] - mn); ps += w[i]; }
            lrun = lrun * alpha + ps;
#pragma unroll
            for (int d = 0; d < 4; ++d)
#pragma unroll
                for (int i = 0; i < 16; ++i) o[d][i] *= alpha;
        }
        bf16x8 pf[2];
#pragma unroll
        for (int s = 0; s < 2; ++s) { u32x4 t; t.x = cvtpk(w[8 * s + 0], w[8 * s + 1]); t.y = cvtpk(w[8 * s + 2], w[8 * s + 3]); t.z = cvtpk(w[8 * s + 4], w[8 * s + 5]); t.w = cvtpk(w[8 * s + 6], w[8 * s + 7]);
            pf[s] = __builtin_bit_cast(bf16x8, t); }
#pragma unroll
        for (int d = 0; d < 4; ++d)
#pragma unroll
            for (int s = 0; s < 2; ++s) o[d] = MFMA32(vf[d][s], pf[s], o[d]);
    }
    float inv = 1.f;
    if (MODE == 1) { const float lt = lrun + __shfl_xor(lrun, 32); inv = 1.f / lt; }
    bf16* op = mix + (row0 + q0 + n) * (size_t)D + h * 128 + 4 * hi;
#pragma unroll
    for (int d = 0; d < 4; ++d)
#pragma unroll
        for (int g = 0; g < 4; ++g) { u32x2 t; t.x = cvtpk(o[d][4 * g] * inv, o[d][4 * g + 1] * inv); t.y = cvtpk(o[d][4 * g + 2] * inv, o[d][4 * g + 3] * inv);
            *(u32x2*)(op + d * 32 + 8 * g) = t; }
}

constexpr int DL_SEL = 0, DL_MISC = 16384, DL_HIST = 17408, DL_CAND = DL_HIST + 8 * 8192, DL_P = DL_CAND + 8 * 512, DL_INVL = DL_P + 8 * 4096, DL_MM = DL_INVL + 8 * 16, DL_END = DL_MM + 8 * 128;
static_assert(DL_END <= RING_BYTES, "DSA LDS map");
constexpr int NBIN = 2048;

__device__ __forceinline__ int tk_bin(float x, float lo, float inv) { int bb = (int)((x - lo) * inv); return bb > NBIN - 1 ? NBIN - 1 : (bb < 0 ? 0 : bb); }
__device__ __forceinline__ void topk_row(const float* S, int c, float lo, float hi  , LAS unsigned short* sel, LAS unsigned* hist, LAS float* cval, LAS int* cidx, int lane) {
    const f32x4* S4 = (const f32x4*)S; const int c4 = c >> 2;
    int kk = 256, mc = c;
    bool usebin = false; float blo = 0.f, binv = 0.f; int bsel = 0;
    for (int level = 0; level < 48; ++level) {
        if (lo == hi || mc <= 64) break;
#pragma unroll
        for (int j = 0; j < NBIN / 64; ++j) hist[lane + 64 * j] = 0u;
        const float inv = (float)NBIN / (hi - lo);
        f32x4 vbn[8];
#define TK_LD(I0) do { _Pragma("unroll") for (int u = 0; u < 8; ++u) { const int i = (I0) + 64 * u + lane; vbn[u] = S4[i < c4 ? i : lane]; } } while (0)
        TK_LD(0);
        for (int i0 = 0; i0 < c4; i0 += 512) { f32x4 vb[8];
#pragma unroll
            for (int u = 0; u < 8; ++u) vb[u] = vbn[u];
            if (i0 + 512 < c4) TK_LD(i0 + 512);
#pragma unroll
            for (int u = 0; u < 8; ++u) { const bool inr = (i0 + 64 * u + lane) < c4;
#pragma unroll
                for (int e = 0; e < 4; ++e) { const float x = vb[u][e]; if (inr && x >= lo && x <= hi) __hip_atomic_fetch_add(&hist[tk_bin(x, lo, inv)], 1u, __ATOMIC_RELAXED, __HIP_MEMORY_SCOPE_WORKGROUP); } } }
#undef TK_LD
        LDS_WAIT(); asm volatile("" ::: "memory");
        unsigned own = 0u;
#pragma unroll
        for (int j = 0; j < 32; ++j) own += hist[32 * lane + j];
        unsigned suf = own;
#pragma unroll
        for (int o = 1; o < 64; o <<= 1) { const unsigned u = __shfl_down(suf, o); if (lane + o < 64) suf += u; }
        const unsigned long long pm = __ballot(suf >= (unsigned)kk);
        const int Ln = 63 - __builtin_clzll(pm);
        const unsigned above = __shfl(suf - own, Ln);
        const int k2 = kk - (int)above;
        int bs = 0, kn = 1, mn = 1;
        { unsigned acc = 0u; bool found = false;
          for (int j = 31; j >= 0; --j) { const unsigned hc = hist[32 * Ln + j]; if (!found && acc + hc >= (unsigned)k2) { bs = 32 * Ln + j; kn = k2 - (int)acc; mn = (int)hc; found = true; } if (!found) acc += hc; } }
        kk = kn; mc = mn;
        if (mc <= 64) { usebin = true; blo = lo; binv = inv; bsel = bs; break; }
        float nlo = 3e38f, nhi = -3e38f;
        for (int i0 = 0; i0 < c4; i0 += 256) { f32x4 vb[4];
#pragma unroll
            for (int u = 0; u < 4; ++u) { const int i = i0 + 64 * u + lane; vb[u] = S4[i < c4 ? i : lane]; }
#pragma unroll
            for (int u = 0; u < 4; ++u) { const bool inr = (i0 + 64 * u + lane) < c4;
#pragma unroll
                for (int e = 0; e < 4; ++e) { const float x = vb[u][e]; if (inr && x >= lo && x <= hi && tk_bin(x, lo, inv) == bs) { nlo = fminf(nlo, x); nhi = fmaxf(nhi, x); } } } }
        lo = wave_min(nlo); hi = wave_max(nhi);
    }
    const bool tie = !usebin && (lo == hi);
    const int base = 256 - kk;
    int nout = 0, ncand = 0;
    const unsigned long long ltmask = (1ull << lane) - 1ull;
    for (int j0 = 0; j0 < c4; j0 += 512) { f32x4 vb[8];
#pragma unroll
      for (int u = 0; u < 8; ++u) { const int i = j0 + 64 * u + lane; vb[u] = S4[i < c4 ? i : lane]; }
#pragma unroll
      for (int u = 0; u < 8; ++u) { const int i4 = j0 + 64 * u; if (i4 >= c4) break;
        bool gt[4], cd[4]; int glow = 0, clow = 0, gtot = 0, ctot = 0;
#pragma unroll
        for (int e = 0; e < 4; ++e) { const float x = vb[u][e]; const bool inr = (x >= lo) && (x <= hi);
            if (usebin) { const int bb = tk_bin(x, blo, binv); gt[e] = (x > hi) || (inr && bb > bsel); cd[e] = inr && bb == bsel; }
            else { gt[e] = x > hi; cd[e] = inr; }
            const unsigned long long gm = __ballot(gt[e]), cm = __ballot(cd[e]);
            glow += __builtin_popcountll(gm & ltmask); gtot += __builtin_popcountll(gm); clow += __builtin_popcountll(cm & ltmask); ctot += __builtin_popcountll(cm); }
        int gpos = nout + glow, cpos = ncand + clow;
#pragma unroll
        for (int e = 0; e < 4; ++e) { const int idx = 4 * (i4 + lane) + e;
            if (gt[e]) { if (gpos < 256) sel[gpos] = (unsigned short)idx; ++gpos; }
            if (cd[e]) { if (tie) { if (cpos < kk) sel[base + cpos] = (unsigned short)idx; } else if (cpos < 64) { cval[cpos] = vb[u][e]; cidx[cpos] = idx; } ++cpos; } }
        nout += gtot; ncand += ctot;
      } }
    if (!tie) {
        LDS_WAIT(); asm volatile("" ::: "memory");
        const int nc = ncand < 64 ? ncand : 64;
        const float mv = lane < nc ? cval[lane] : 0.f; const int mi = lane < nc ? cidx[lane] : 0;
        int rank = 0;
        for (int i = 0; i < nc; ++i) { const float v = cval[i]; rank += (v > mv || (v == mv && i < lane)) ? 1 : 0; }
        if (lane < nc && rank < kk) sel[base + rank] = (unsigned short)mi;
    }
    LDS_WAIT(); asm volatile("" ::: "memory");
}

__device__ __forceinline__ void dsa_unit(const bf16* proj, const unsigned char* q8, const unsigned char* k8, const unsigned char* v8, bf16* mix, float* scr, LAS unsigned char* lds, int unit, int tid) {
    constexpr int ldp = NB_PAD;
    const int lane = tid & 63, wave = __builtin_amdgcn_readfirstlane(tid >> 6);
    const int tile = 255 - (unit >> 2), b = unit & 3, t0 = 32 * tile, c = ((t0 >> 6) + 1) << 6;
    const size_t row0 = (size_t)b * SEQ;
    LAS unsigned short* sel = (LAS unsigned short*)(lds + DL_SEL);
#ifdef PROBE_DSA
    unsigned long long td0_ = __builtin_amdgcn_s_memrealtime();
#define DSA_PT(st) do { const unsigned long long n_ = __builtin_amdgcn_s_memrealtime(); if (tid == 0 && (st) == PROBE_DSA) { volatile LAS unsigned long long* pe_ = (volatile LAS unsigned long long*)(lds + MISC_OFF + 64); pe_[0] = pe_[0] + (n_ - td0_); } td0_ = n_; } while (0)
#else
#define DSA_PT(st) do { } while (0)
#endif
#ifndef DSA_NO_A
    if (c > 256) {
        int lane_a = lane; asm volatile("" : "+v"(lane_a));
        const int qg = wave & 1, kpart = wave >> 1, ql = lane_a & 15, kq = lane_a >> 4;
        const bf16* qrow = proj + (row0 + t0 + 16 * qg + ql) * ldp;
#pragma unroll 1
        for (int hp = 0; hp < 2; ++hp) {
            bf16x8 qif[8][2];
#pragma unroll
            for (int hh = 0; hh < 8; ++hh)
#pragma unroll
                for (int kk = 0; kk < 2; ++kk) qif[hh][kk] = *(const bf16x8*)(qrow + B_QI + (8 * hp + hh) * 64 + kk * 32 + kq * 8);
            float wv[8];
            { const u32x4 w0 = *(const u32x4*)(qrow + B_WI + 8 * hp);
              wv[0] = bflo(w0.x); wv[1] = bfhi(w0.x); wv[2] = bflo(w0.y); wv[3] = bfhi(w0.y); wv[4] = bflo(w0.z); wv[5] = bfhi(w0.z); wv[6] = bflo(w0.w); wv[7] = bfhi(w0.w); }
            bf16x8 kring[3][2][2]; f32x4 sring[3][2];
            const bf16* kibase = proj + (row0 + ql) * ldp + B_KI + kq * 8;
            float* sbase = scr + (size_t)(16 * qg + ql) * c + 4 * kq;
#define IDX_LOAD(SL, KB0) do { _Pragma("unroll") for (int u = 0; u < 2; ++u) { const int kb = (KB0) + 64 * u; const int kbc = kb < c ? kb : 16 * kpart; \
                    const bf16* kr = kibase + (size_t)kbc * ldp; \
                    kring[SL][u][0] = *(const bf16x8*)kr; kring[SL][u][1] = *(const bf16x8*)(kr + 32); \
                    sring[SL][u] = (f32x4){0.f, 0.f, 0.f, 0.f}; \
                    if (hp) sring[SL][u] = *(const f32x4*)(sbase + kbc); } } while (0)
#define IDX_COMP(SL, KB0) do { _Pragma("unroll") for (int u = 0; u < 2; ++u) { const int kb = (KB0) + 64 * u; \
                    if (kb < c) { f32x2_t s01 = {sring[SL][u][0], sring[SL][u][1]}, s23 = {sring[SL][u][2], sring[SL][u][3]}; \
                        _Pragma("unroll") for (int hh = 0; hh < 8; ++hh) { f32x4 d = {0.f, 0.f, 0.f, 0.f}; d = MFMA16(kring[SL][u][0], qif[hh][0], d); d = MFMA16(kring[SL][u][1], qif[hh][1], d); \
                            const f32x2_t w2 = {wv[hh], wv[hh]}; \
                            s01 = __builtin_elementwise_fma((f32x2_t){relu_raw(d[0]), relu_raw(d[1])}, w2, s01); s23 = __builtin_elementwise_fma((f32x2_t){relu_raw(d[2]), relu_raw(d[3])}, w2, s23); } \
                        const f32x4 sacc = {s01.x, s01.y, s23.x, s23.y}; \
                        *(f32x4*)(sbase + kb) = sacc; \
                        smin = fminf(smin, fminf(fminf(sacc[0], sacc[1]), fminf(sacc[2], sacc[3]))); smax = fmaxf(smax, fmaxf(fmaxf(sacc[0], sacc[1]), fmaxf(sacc[2], sacc[3]))); } } } while (0)
            float smin = 3e38f, smax = -3e38f;
            const int kbs = 16 * kpart;
            IDX_LOAD(0, kbs); IDX_LOAD(1, kbs + 128);
#pragma unroll 1
            for (int kb0 = kbs; kb0 < c; kb0 += 384) {
                IDX_LOAD(2, kb0 + 256); IDX_COMP(0, kb0);
                IDX_LOAD(0, kb0 + 384); IDX_COMP(1, kb0 + 128);
                IDX_LOAD(1, kb0 + 512); IDX_COMP(2, kb0 + 256);
            }
#undef IDX_COMP
#undef IDX_LOAD
            if (hp) {
                smin = fminf(smin, __shfl_xor(smin, 16)); smin = fminf(smin, __shfl_xor(smin, 32)); smax = fmaxf(smax, __shfl_xor(smax, 16)); smax = fmaxf(smax, __shfl_xor(smax, 32));
                if (lane < 16) { LAS float* mm = (LAS float*)(lds + DL_MM) + (wave * 16 + lane) * 2; mm[0] = smin; mm[1] = smax; }
            }
        }
    }
#endif
    __syncthreads(); DSA_PT(0);
    __builtin_amdgcn_fence(__ATOMIC_ACQUIRE, "agent");
    asm volatile("s_waitcnt vmcnt(0)" ::: "memory");
#ifndef DSA_NO_B
    LAS int* nselp = (LAS int*)(lds + DL_MISC);
    for (int qi = 0; qi < 4; ++qi) { const int ql = 4 * wave + qi;
        LAS unsigned short* s = sel + ql * 256;
        if (c > 256) { const LAS float* mm = (const LAS float*)(lds + DL_MM);
            float lo = 3e38f, hi = -3e38f;
#pragma unroll
            for (int kp = 0; kp < 4; ++kp) { const int w2 = (ql >> 4) + 2 * kp; lo = fminf(lo, mm[(w2 * 16 + (ql & 15)) * 2]); hi = fmaxf(hi, mm[(w2 * 16 + (ql & 15)) * 2 + 1]); }
            topk_row(scr + (size_t)ql * c, c, lo, hi, s, (LAS unsigned*)(lds + DL_HIST + wave * 8192), (LAS float*)(lds + DL_CAND + wave * 512), (LAS int*)(lds + DL_CAND + wave * 512 + 256), lane); }
        else { for (int i = lane; i < c; i += 64) s[i] = (unsigned short)i; }
    }
#endif
    const int nsel = c > 256 ? 256 : c;
    LDS_WAIT(); asm volatile("" ::: "memory"); DSA_PT(1);
#ifndef DSA_NO_C
    LAS unsigned short* Pb = (LAS unsigned short*)(lds + DL_P + wave * 4096);
    LAS unsigned char* vt = lds + DL_HIST + wave * 8192;
    LAS float* invl = (LAS float*)(lds + DL_INVL + wave * 16);
    for (int pi = 0; pi < 16; ++pi) { const int pr = 16 * wave + pi, ql = pr >> 2, g = pr & 3;
        const LAS unsigned short* s = sel + ql * 256;
        const size_t qrow = row0 + t0 + ql;
        int lane_c = lane; asm volatile("" : "+v"(lane_c));
        const int r = lane_c & 15, kq = lane_c >> 4;
        long qf[4];
#pragma unroll
        for (int kk = 0; kk < 4; ++kk) { qf[kk] = 0; if (r < 4) qf[kk] = *(const long*)(q8 + qrow * 2048 + (g * 4 + r) * 128 + kq * 32 + kk * 8); }
        f32x4 lg[16]; float mx = -3e38f;
#pragma unroll
        for (int g8 = 0; g8 < 2; ++g8) {
            if (g8 * 128 < nsel) {
                long kfr[8][4];
#pragma unroll
                for (int u = 0; u < 8; ++u) { const int key = ((g8 * 128 + u * 16) < nsel) ? s[g8 * 128 + u * 16 + r] : 0;
                    const unsigned char* kr = k8 + (row0 + key) * 512 + g * 128 + kq * 32;
                    const u32x4 ka = *(const u32x4*)kr, kb2 = *(const u32x4*)(kr + 16);
                    kfr[u][0] = (long)(((unsigned long long)ka.y << 32) | ka.x); kfr[u][1] = (long)(((unsigned long long)ka.w << 32) | ka.z);
                    kfr[u][2] = (long)(((unsigned long long)kb2.y << 32) | kb2.x); kfr[u][3] = (long)(((unsigned long long)kb2.w << 32) | kb2.z); }
#pragma unroll
                for (int u = 0; u < 8; ++u) { f32x4 d = {0.f, 0.f, 0.f, 0.f};
#pragma unroll
                    for (int kk = 0; kk < 4; ++kk) d = __builtin_amdgcn_mfma_f32_16x16x32_fp8_fp8(kfr[u][kk], qf[kk], d, 0, 0, 0);
                    const bool live = (g8 * 128 + u * 16) < nsel;
                    if (!live) d = (f32x4){-3e38f, -3e38f, -3e38f, -3e38f};
                    lg[g8 * 8 + u] = d; mx = fmaxf(mx, fmaxf(fmaxf(d[0], d[1]), fmaxf(d[2], d[3]))); }
            } else {
#pragma unroll
                for (int u = 0; u < 8; ++u) lg[g8 * 8 + u] = (f32x4){-3e38f, -3e38f, -3e38f, -3e38f};
            }
        }
        mx = fmaxf(mx, __shfl_xor(mx, 16)); mx = fmaxf(mx, __shfl_xor(mx, 32));
        const int ks = lane_c >> 4, dc = lane_c & 15;
        u32x2 vn[16];
#define DSA_LOADV(I0) do { _Pragma("unroll") for (int u = 0; u < 16; ++u) { const int key = s[4 * ((I0) + u) + ks]; vn[u] = *(const u32x2*)(v8 + (row0 + key) * 512 + g * 128 + dc * 8); } } while (0)
        DSA_LOADV(0);
        float ls = 0.f;
#pragma unroll
        for (int blk = 0; blk < 16; ++blk) {
            if (blk * 16 < nsel) {
#pragma unroll
                for (int e = 0; e < 4; ++e) { const float p = fexp2((lg[blk][e] - mx) * 0.125f); ls += p; if (r < 4) Pb[r * 256 + blk * 16 + 4 * kq + e] = (unsigned short)(cvtpk(p, p) & 0xffffu); } }
        }
        ls += __shfl_xor(ls, 16); ls += __shfl_xor(ls, 32);
        if (lane < 4) invl[lane] = 1.f / ls;
        LDS_WAIT(); asm volatile("" ::: "memory");
        f32x4 oacc[8];
#pragma unroll
        for (int cb = 0; cb < 8; ++cb) oacc[cb] = (f32x4){0.f, 0.f, 0.f, 0.f};
        const unsigned tq_ = (unsigned)(lane_c & 15) >> 2, tp_ = (unsigned)lane_c & 3u;
        for (int i0 = 0; i0 < nsel / 4; i0 += 16) {
            u32x2 v[16];
#pragma unroll
            for (int u = 0; u < 16; ++u) v[u] = vn[u];
            if (i0 + 16 < nsel / 4) DSA_LOADV(i0 + 16);
#pragma unroll
            for (int half = 0; half < 2; ++half) {
#pragma unroll
                for (int uu = 0; uu < 8; ++uu) { const int u = 8 * half + uu; const unsigned row = 4u * uu + (unsigned)ks;
                    const f32x2_t a0 = __builtin_amdgcn_cvt_pk_f32_fp8((int)v[u].x, false), a1 = __builtin_amdgcn_cvt_pk_f32_fp8((int)v[u].x, true), a2 = __builtin_amdgcn_cvt_pk_f32_fp8((int)v[u].y, false), a3 = __builtin_amdgcn_cvt_pk_f32_fp8((int)v[u].y, true);
                    u32x4 w; w.x = cvtpk(a0.x, a0.y); w.y = cvtpk(a1.x, a1.y); w.z = cvtpk(a2.x, a2.y); w.w = cvtpk(a3.x, a3.y);
                    *(LAS u32x4*)(vt + 256u * row + 16u * ((unsigned)dc ^ (((row & 3u) << 2) | ((row >> 2) & 3u)))) = w; }
                asm volatile("" ::: "memory");
                bf16x8 af = (bf16x8){0, 0, 0, 0, 0, 0, 0, 0};
                if (r < 4) af = *(const LAS bf16x8*)(Pb + r * 256 + 4 * i0 + 32 * half + 8 * kq);
#pragma unroll
                for (int cb = 0; cb < 8; ++cb) {
                    s16x4_t bq[2];
#pragma unroll
                    for (int t = 0; t < 2; ++t) { const unsigned trow = 8u * (unsigned)ks + 4u * t + tq_, tch = 2u * cb + (tp_ >> 1);
                        const unsigned ta = 256u * trow + 16u * (tch ^ (((trow & 3u) << 2) | ((trow >> 2) & 3u))) + 8u * (tp_ & 1u);
                        bq[t] = __builtin_amdgcn_ds_read_tr16_b64_v4i16((LAS s16x4_t*)(vt + ta)); }
                    const bf16x8 bfrag = {bq[0][0], bq[0][1], bq[0][2], bq[0][3], bq[1][0], bq[1][1], bq[1][2], bq[1][3]};
                    oacc[cb] = MFMA16(af, bfrag, oacc[cb]); }
                asm volatile("" ::: "memory");
            }
        }
        if (ks == 0) {
#pragma unroll
            for (int hd = 0; hd < 4; ++hd) { const float il = invl[hd];
#pragma unroll
                for (int cb = 0; cb < 8; ++cb) mix[qrow * D + (g * 4 + hd) * 128 + 16 * cb + dc] = (unsigned short)(cvtpk(oacc[cb][hd] * il, 0.f) & 0xffffu); }
        }
        LDS_WAIT(); asm volatile("" ::: "memory");
    }
#endif
    __syncthreads(); DSA_PT(2);
}


constexpr int A2_SLOT = 40960, A2_NSLOT = 3, A2_CTRL = A2_SLOT * A2_NSLOT;
static_assert(A2_CTRL + 256 <= RING_BYTES, "attention LDS map");
#define A2_WAIT_V(n) asm volatile("s_waitcnt vmcnt(" #n ")" ::: "memory")
template <int MODE>
__device__ __forceinline__ void attn2_stage(LAS unsigned char* slot, const bf16* kbase  ,
                                            const bf16* vbase  , const float* cbase  , int ldp, int kb, int wave) {
#pragma unroll
    for (int i = 0; i < 2; ++i) { const int f = wave + 8 * i, sb = f >> 3, kk = f & 7;
        __builtin_amdgcn_global_load_lds((const unsigned*)(kbase + (size_t)(kb + 32 * sb) * ldp + kk * 16), (LAS unsigned*)(slot + f * 1024), 16, 0, 0); }
#pragma unroll
    for (int i = 0; i < 2; ++i) { const int f = wave + 8 * i, sb = f >> 3, d = (f >> 1) & 3, s = f & 1;
        __builtin_amdgcn_global_load_lds((const unsigned*)(vbase + (size_t)(d * 32) * SEQ + kb + 32 * sb + 16 * s), (LAS unsigned*)(slot + 16384 + f * 1024), 16, 0, 0); }
    if (MODE == 1) __builtin_amdgcn_global_load_lds((const unsigned*)(cbase + kb), (LAS unsigned*)(slot + 32768 + wave * 1024), 16, 0, 0);
}
template <int MODE>
__device__ __forceinline__ void attn2_unit(const bf16* proj, int ldp, const bf16* VT, const float* cum2, const float* tot, const float* gq, const float* rstdv, bf16* mix, float zb2, int grp, int bh, LAS unsigned char* lds, int tid) {
    const int lane = tid & 63, wave = __builtin_amdgcn_readfirstlane(tid >> 6);
    const int b = bh >> 4, h = bh & 15, n = lane & 31, hi = lane >> 5;
    const int q_base = 256 * grp, q0 = q_base + 32 * wave, tq = q0 + n;
    const size_t row0 = (size_t)b * SEQ;
    const int prow = (n & 0x13) | ((n & 4) << 1) | ((n & 8) >> 1);
    const bf16* kbase = proj + (row0 + prow) * ldp + D + h * 128 + hi * 8;
    const bf16* vbase = VT + ((size_t)bh * 128 + n) * SEQ + 8 * hi;
    const float* cb = cum2 + (size_t)bh * SEQ;
    const float* cbase = cb + 4 * (lane & 15);
    volatile LAS unsigned* flags = (volatile LAS unsigned*)(lds + A2_CTRL + 64);
    bf16x8 qf[8];
    {
      const bf16* qp = proj + (row0 + q0 + n) * ldp + h * 128 + hi * 8;
      u32x4 raw[8];
#pragma unroll
      for (int kk = 0; kk < 8; ++kk) raw[kk] = *(const u32x4*)(qp + kk * 16);
      float ss = 0.f;
#pragma unroll
      for (int kk = 0; kk < 8; ++kk) { const float x0 = bflo(raw[kk].x), x1 = bfhi(raw[kk].x), x2 = bflo(raw[kk].y), x3 = bfhi(raw[kk].y), x4 = bflo(raw[kk].z), x5 = bfhi(raw[kk].z), x6 = bflo(raw[kk].w), x7 = bfhi(raw[kk].w);
          ss += x0 * x0 + x1 * x1 + x2 * x2 + x3 * x3 + x4 * x4 + x5 * x5 + x6 * x6 + x7 * x7; }
      ss += __shfl_xor(ss, 32);
      const float ar = rstdv[row0 + q0 + n];
      const float rstd = ar / sqrtf(ar * ar * ss * (1.f / 128.f) + RMS_EPS);
#pragma unroll
      for (int kk = 0; kk < 8; ++kk) { const f32x4 g0 = *(const f32x4*)(gq + kk * 16 + hi * 8), g1 = *(const f32x4*)(gq + kk * 16 + hi * 8 + 4);
          u32x4 w; w.x = cvtpk(bflo(raw[kk].x) * rstd * g0.x * QSCALE, bfhi(raw[kk].x) * rstd * g0.y * QSCALE); w.y = cvtpk(bflo(raw[kk].y) * rstd * g0.z * QSCALE, bfhi(raw[kk].y) * rstd * g0.w * QSCALE);
          w.z = cvtpk(bflo(raw[kk].z) * rstd * g1.x * QSCALE, bfhi(raw[kk].z) * rstd * g1.y * QSCALE); w.w = cvtpk(bflo(raw[kk].w) * rstd * g1.z * QSCALE, bfhi(raw[kk].w) * rstd * g1.w * QSCALE);
          qf[kk] = __builtin_bit_cast(bf16x8, w); } }
    float cq = 0.f, c_low = 0.f, Pe = 0.f, Po = 0.f, Pq = 0.f, Plow = 0.f;
    if (MODE == 1) { cq = cb[tq]; c_low = cb[q_base];
        const float te = tot[bh * 128 + 2 * lane], to = tot[bh * 128 + 2 * lane + 1]; float sc2 = te + to;
#pragma unroll
        for (int o = 1; o < 64; o <<= 1) { const float u = __shfl_up(sc2, o); if (lane >= o) sc2 += u; }
        Pe = sc2 - (te + to); Po = Pe + te;
        { const int cw = q0 >> 6; Pq = (cw & 1) ? __shfl(Po, cw >> 1) : __shfl(Pe, cw >> 1); }
        { const int cl = q_base >> 6; Plow = (cl & 1) ? __shfl(Po, cl >> 1) : __shfl(Pe, cl >> 1); } }
    f32x16 o[4];
#pragma unroll
    for (int d = 0; d < 4; ++d)
#pragma unroll
        for (int i = 0; i < 16; ++i) o[d][i] = 0.f;
    float R = 0.f, mrun = -1e30f, lrun = 0.f;
    const int nsteps = (q_base + 256) >> 6, kb_top = q_base + 192;
    if (wave < 4) __builtin_amdgcn_s_setprio(2); else __builtin_amdgcn_s_setprio(0);
    if (MODE == 0 && tid < 16) flags[tid] = 0u;
    asm volatile("s_waitcnt vmcnt(0)" ::: "memory");
    attn2_stage<MODE>(lds, kbase, vbase, cbase, ldp, kb_top, wave);
    if (nsteps > 1) attn2_stage<MODE>(lds + A2_SLOT, kbase, vbase, cbase, ldp, kb_top - 64, wave);
    bool mydone = false;
    for (int j = 0; j < nsteps; ++j) {
        const int kb = kb_top - 64 * j;
        if (j + 1 < nsteps) { if (MODE == 1) A2_WAIT_V(5); else A2_WAIT_V(4); } else A2_WAIT_V(0);
        __builtin_amdgcn_s_barrier();
        __builtin_amdgcn_sched_barrier(0); asm volatile("" ::: "memory");
        LAS unsigned char* slot = lds + (j % A2_NSLOT) * A2_SLOT;
        float dq = 0.f;
        if (MODE == 1) { const int ck_ = kb >> 6; const float Pk = (ck_ & 1) ? __shfl(Po, ck_ >> 1) : __shfl(Pe, ck_ >> 1);
            dq = Pq - Pk;
            const float ck63 = *(const LAS float*)(slot + 32768 + wave * 1024 + 63 * 4);
            if ((c_low + (Plow - Pk) - ck63) + 2.f * zb2 < ZERO_LOG2) break; }
        else if (j > 0) { const volatile LAS unsigned* fl = flags + 8 * ((j - 1) & 1); unsigned all = 1u;
#pragma unroll
            for (int w2 = 0; w2 < 8; ++w2) all &= fl[w2];
            if (all) break; }
        if (j + 2 < nsteps) attn2_stage<MODE>(lds + ((j + 2) % A2_NSLOT) * A2_SLOT, kbase, vbase, cbase, ldp, kb - 128, wave);
#pragma unroll
        for (int sbi = 0; sbi < 2; ++sbi) { const int sb = 1 - sbi, kk0 = kb + 32 * sb;
            if (kk0 > q0 || mydone) continue;
            if (MODE == 1) { const float ck31 = *(const LAS float*)(slot + 32768 + wave * 1024 + (32 * sb + 31) * 4);
                const float cq0 = __shfl(cq, 0); if ((cq0 + dq - ck31) + 2.f * zb2 < ZERO_LOG2) { mydone = true; continue; } }
            bf16x8 kf[8];
#pragma unroll
            for (int kk = 0; kk < 8; ++kk) kf[kk] = *(const LAS bf16x8*)(slot + (sb * 8 + kk) * 1024 + lane * 16);
            f32x16 sc;
#pragma unroll
            for (int i = 0; i < 16; ++i) sc[i] = 0.f;
#pragma unroll
            for (int kk = 0; kk < 8; ++kk) sc = MFMA32(kf[kk], qf[kk], sc);
            bf16x8 vf[4][2];
#pragma unroll
            for (int d = 0; d < 4; ++d)
#pragma unroll
                for (int s = 0; s < 2; ++s) vf[d][s] = *(const LAS bf16x8*)(slot + 16384 + (sb * 8 + d * 2 + s) * 1024 + lane * 16);
            const bool diag = (kk0 == q0);
            float w[16];
            if (MODE == 0) {
                float L[16];
#pragma unroll
                for (int i = 0; i < 16; ++i) L[i] = flog2(1.f + fexp2(sc[i]));
                if (diag) {
#pragma unroll
                    for (int i = 0; i < 16; ++i) { const int key = kk0 + 16 * (i >> 3) + 8 * hi + (i & 7); if (key >= tq) { L[i] = 0.f; sc[i] = -3e38f; } }
                }
                const float G0 = -(((L[0] + L[1]) + (L[2] + L[3])) + ((L[4] + L[5]) + (L[6] + L[7]))), G1 = -(((L[8] + L[9]) + (L[10] + L[11])) + ((L[12] + L[13]) + (L[14] + L[15])));
                const float Gp0 = __shfl_xor(G0, 32), Gp1 = __shfl_xor(G1, 32);
                const float pre1 = hi ? R : (R + Gp1);
                const float pre0 = hi ? (R + G1 + Gp1) : (R + Gp1 + G1 + Gp0);
                float c = pre1;
#pragma unroll
                for (int jj = 7; jj >= 0; --jj) { c -= L[8 + jj]; w[8 + jj] = fexp2(sc[8 + jj] + c); }
                c = pre0;
#pragma unroll
                for (int jj = 7; jj >= 0; --jj) { c -= L[jj]; w[jj] = fexp2(sc[jj] + c); }
                R += (G0 + G1) + (Gp0 + Gp1);
                if (__all(R + zb2 < ZERO_LOG2)) mydone = true;
            } else {
                f32x2_t v2[8]; const f32x2_t cq2 = {cq + dq, cq + dq};
#pragma unroll
                for (int s = 0; s < 2; ++s) { const LAS f32x4* cp = (const LAS f32x4*)(slot + 32768 + wave * 1024 + (32 * sb + 16 * s + 8 * hi) * 4);
                    const f32x4 c0 = cp[0], c1 = cp[1];
                    v2[4 * s + 0] = (f32x2_t){sc[8 * s + 0], sc[8 * s + 1]} - (f32x2_t){c0.x, c0.y};
                    v2[4 * s + 1] = (f32x2_t){sc[8 * s + 2], sc[8 * s + 3]} - (f32x2_t){c0.z, c0.w};
                    v2[4 * s + 2] = (f32x2_t){sc[8 * s + 4], sc[8 * s + 5]} - (f32x2_t){c1.x, c1.y};
                    v2[4 * s + 3] = (f32x2_t){sc[8 * s + 6], sc[8 * s + 7]} - (f32x2_t){c1.z, c1.w}; }
                if (diag) {
#pragma unroll
                    for (int p = 0; p < 8; ++p) { const int key = kk0 + 16 * (p >> 2) + 8 * hi + 2 * (p & 3);
                        if (key > tq) v2[p].x = -3e38f; if (key + 1 > tq) v2[p].y = -3e38f; }
                }
#pragma unroll
                for (int p = 0; p < 8; ++p) v2[p] += cq2;
                float bm = fmaxf(fmaxf(v2[0].x, v2[0].y), fmaxf(v2[1].x, v2[1].y));
#pragma unroll
                for (int p = 2; p < 8; p += 2) bm = fmaxf(bm, fmaxf(fmaxf(v2[p].x, v2[p].y), fmaxf(v2[p + 1].x, v2[p + 1].y)));
                bm = fmaxf(bm, __shfl_xor(bm, 32));
                const float mn = fmaxf(mrun, bm), alpha = fexp2(mrun - mn);
                mrun = mn;
                const f32x2_t nmn2 = {-mn, -mn}; f32x2_t ps2 = {0.f, 0.f};
#pragma unroll
                for (int p = 0; p < 8; ++p) { const f32x2_t d2 = v2[p] + nmn2; f32x2_t e2; e2.x = fexp2(d2.x); e2.y = fexp2(d2.y); w[2 * p] = e2.x; w[2 * p + 1] = e2.y; ps2 += e2; }
                lrun = lrun * alpha + (ps2.x + ps2.y);
                if (__any(alpha != 1.f)) {
#pragma unroll
                    for (int d = 0; d < 4; ++d)
#pragma unroll
                        for (int i = 0; i < 16; ++i) o[d][i] *= alpha;
                }
            }
            bf16x8 pf[2];
#pragma unroll
            for (int s = 0; s < 2; ++s) { u32x4 t; t.x = cvtpk(w[8 * s + 0], w[8 * s + 1]); t.y = cvtpk(w[8 * s + 2], w[8 * s + 3]); t.z = cvtpk(w[8 * s + 4], w[8 * s + 5]); t.w = cvtpk(w[8 * s + 6], w[8 * s + 7]);
                pf[s] = __builtin_bit_cast(bf16x8, t); }
#pragma unroll
            for (int d = 0; d < 4; ++d)
#pragma unroll
                for (int s = 0; s < 2; ++s) o[d] = MFMA32(vf[d][s], pf[s], o[d]);
        }
        if (MODE == 0) { if (lane == 0) flags[8 * (j & 1) + wave] = (mydone || kb == 0) ? 1u : 0u; }
    }
    A2_WAIT_V(0);
    __builtin_amdgcn_s_setprio(0);
    float inv = 1.f;
    if (MODE == 1) { const float lt = lrun + __shfl_xor(lrun, 32); inv = 1.f / lt; }
    bf16* op = mix + (row0 + q0 + n) * (size_t)D + h * 128 + 4 * hi;
#pragma unroll
    for (int d = 0; d < 4; ++d)
#pragma unroll
        for (int g = 0; g < 4; ++g) { u32x2 t; t.x = cvtpk(o[d][4 * g] * inv, o[d][4 * g + 1] * inv); t.y = cvtpk(o[d][4 * g + 2] * inv, o[d][4 * g + 3] * inv);
            *(u32x2*)(op + d * 32 + 8 * g) = t; }
    asm volatile("s_waitcnt vmcnt(0) lgkmcnt(0)" ::: "memory");
    __builtin_amdgcn_s_barrier();
}

typedef const __attribute__((address_space(4))) Args* KArgs;
__device__ __forceinline__ KArgs kargs() { auto p = __builtin_amdgcn_kernarg_segment_ptr(); asm volatile("" : "+s"(p)); return (KArgs)p; }
#define TID_VARS int tid_l = threadIdx.x; asm volatile("" : "+v"(tid_l)); const int tid = tid_l, lane = tid & 63, wave = __builtin_amdgcn_readfirstlane(tid >> 6); const int G = gridDim.x, bx = blockIdx.x; const int gw = bx * NWAVES + wave, ngw = G * NWAVES; (void)gw; (void)ngw; (void)lane; (void)G
#ifndef WGM_IN
#define WGM_IN 4
#endif
#ifndef WGM_WO
#define WGM_WO 4
#endif
#ifndef WGM_PP
#define WGM_PP 4
#endif
#ifndef WGM_UP
#define WGM_UP 4
#endif
#ifndef WGM_DN
#define WGM_DN 4
#endif
#ifndef WGM_GT
#define WGM_GT 4
#endif
#ifndef PG_ALIGN
#define PG_ALIGN true
#endif
#ifndef PG_SP2
#define PG_SP2 true
#endif
#ifndef PHMASK
#define PHMASK 0xFFFF
#endif
#define PH(k) ((PHMASK >> (k)) & 1)
#ifndef REP_GEMM
#define REP_GEMM 1
#endif
#ifndef REP_ATTN
#define REP_ATTN 1
#endif
#ifndef REP_LIGHT
#define REP_LIGHT 1
#endif
#ifndef REP_A
#define REP_A REP_ATTN
#endif
#ifndef REP_B
#define REP_B REP_ATTN
#endif
#ifndef REP_C
#define REP_C REP_ATTN
#endif

#ifndef REP_BAR
#define REP_BAR 1
#endif
__device__ __forceinline__ void grid_bar(LAS unsigned char* lds) {
  for (int rb = 0; rb < REP_BAR; ++rb) {
    KArgs A = kargs(); XcdBarrier b; b.bar = (unsigned*)(A->ws + WS_CTL) + CW_BAR; b.x = xb_xcc_id(); b.st = (volatile LAS unsigned*)(lds + MISC_OFF) + 8;
    xcd_barrier(b);
  }
}
struct LayerCfg { int kind, jk, nin, npad; };
__device__ __forceinline__ LayerCfg layer_cfg(int layer) { LayerCfg c; c.kind = layer % 3; c.jk = layer / 3; c.nin = c.kind == 0 ? NA_IN : (c.kind == 1 ? NB_IN : NC_IN); c.npad = c.kind == 0 ? NA_IN : (c.kind == 1 ? NB_PAD : NC_PAD); return c; }

__device__ __forceinline__ void convert_layer(KArgs A, unsigned char* ws, LAS float* scrw, int layer, int which, int gw, int ngw, int lane) {
    const LayerCfg L = layer_cfg(layer);
    if (which & 1) {
        const float* w_in = L.kind == 0 ? A->in[I_A_WIN] + (size_t)L.jk * D * NA_IN : (L.kind == 1 ? A->in[I_B_WIN] : A->in[I_C_WIN]);
        convert_weight(w_in, A->in[I_ATTN_NORM] + layer * D, D, L.nin, L.npad, (bf16*)(ws + WS_WIN), scrw, gw, ngw, lane);
        convert_weight(A->in[I_WO] + (size_t)layer * D * D, nullptr, D, D, D, (bf16*)(ws + WS_WO), scrw, gw, ngw, lane);
        convert_weight(A->in[I_WUP] + (size_t)layer * D * FF, A->in[I_MLP_NORM] + layer * D, D, FF, FF, (bf16*)(ws + WS_WUP), scrw, gw, ngw, lane);
        convert_weight(A->in[I_WDOWN] + (size_t)layer * FF * D, nullptr, FF, D, D, (bf16*)(ws + WS_WDN), scrw, gw, ngw, lane);
    }
    if (which & 2) {
        convert_weight(A->in[I_WGATE] + (size_t)layer * D * D, A->in[I_PLE_NORM] + layer * D, D, D, D, (bf16*)(ws + WS_WG), scrw, gw, ngw, lane);
        convert_weight(A->in[I_WPLE] + (size_t)layer * PLE * D, nullptr, PLE, D, D, (bf16*)(ws + WS_WPL), scrw, gw, ngw, lane);
    }
}
__device__ __forceinline__ void phase_prologue(LAS unsigned char* lds) {
    KArgs A = kargs(); TID_VARS; unsigned char* ws = A->ws;
    float2* rope32 = (float2*)(ws + WS_ROPE32); float2* rope16 = (float2*)(ws + WS_ROPE16);
    const int gt = bx * NTHR + tid, ngt = G * NTHR;
    for (int i = gt; i < SEQ * 16; i += ngt) { const int pos = i >> 4, k = i & 15; const float inv = exp2f(-(float)k * (1.f / 16.f) * 18.931568569324174f);
        const float ang = (float)pos * inv; float s, c; sincosf(ang, &s, &c); rope32[i] = make_float2(c, s); }
    for (int i = gt; i < SEQ * 8; i += ngt) { const int pos = i >> 3, k = i & 7; const float inv = exp2f(-(float)k * (1.f / 8.f) * 18.931568569324174f);
        const float ang = (float)pos * inv; float s, c; sincosf(ang, &s, &c); rope16[i] = make_float2(c, s); }
    const f32x4* p4 = (const f32x4*)A->in[I_P]; u32x2* pb2 = (u32x2*)(ws + WS_PB);
    for (size_t i = gt; i < (size_t)DEPTH * M * PLE / 4; i += ngt) { const f32x4 v = p4[i]; pb2[i] = (u32x2){cvtpk(v.x, v.y), cvtpk(v.z, v.w)}; }
    x_rows(A->in[I_X], (bf16*)(ws + WS_HB0), (float*)(ws + WS_SSP_IN), gw, ngw, lane);
    convert_layer(A, ws, (LAS float*)(lds + RING_OFF + wave * 8448), 0, 1, gw, ngw, lane);
}
__device__ __forceinline__ void phase_inproj(LAS unsigned char* lds, int layer) {
    KArgs A = kargs(); TID_VARS; unsigned char* ws = A->ws; const LayerCfg L = layer_cfg(layer);
    pg8::Gemm g{(const bf16*)(ws + ((layer & 1) ? WS_HB1 : WS_HB0)), (const bf16*)(ws + WS_WIN), M, L.npad, D}; pg8::StaticOrder S; S.init(M, L.npad, G, bx, WGM_IN);
    { const float* ssp = (const float*)(ws + WS_SSP_IN); float* rv = (float*)(ws + WS_RSTD);
      for (int r = gw; r < M; r += ngw) { float v = lane < 32 ? ssp[(size_t)r * 32 + lane] : 0.f; v = wave_sum(v); if (lane == 0) rv[r] = 1.f / sqrtf(v * (1.f / 2048.f) + RMS_EPS); } }
    pg8::EpiStore<0, false> E{(bf16*)(ws + WS_PROJ), L.npad, nullptr};
    pg8::gemm_phase<pg8::EpiStore<0, false>, pg8::StaticOrder, PG_ALIGN, PG_SP2>(lds + RING_OFF, g, S, E);
}
__device__ __forceinline__ float zbound2(const float* gq, const float* gk, int lane) {
    const float a = wave_max(fmaxf(fabsf(gq[lane]), fabsf(gq[lane + 64]))), bq = wave_max(fmaxf(fabsf(gk[lane]), fabsf(gk[lane + 64])));
    return a * bq * 11.313708498984761f * LOG2E * 1.02f;
}
__device__ __forceinline__ void phase_postproj_dense(LAS unsigned char* lds, int layer) {
    KArgs A = kargs(); TID_VARS; unsigned char* ws = A->ws; const LayerCfg L = layer_cfg(layer);
    bf16* PROJ = (bf16*)(ws + WS_PROJ); LAS float* scrw = (LAS float*)(lds + RING_OFF + wave * 8448);
    const float* gq = L.kind == 0 ? A->in[I_A_QN] + L.jk * HD : A->in[I_C_QN]; const float* gk = L.kind == 0 ? A->in[I_A_KN] + L.jk * HD : A->in[I_C_KN];
    const int npad = L.npad;
    const int nscan = L.kind == 2 ? BATCH * 128 : 0, nvt = BATCH * 256 * 16, total = nscan + nvt + M;
    for (int it = gw; it < total; it += ngw) {
        if (it < nscan) { cumchunk_item(PROJ, npad, (const float*)(ws + WS_RSTD), A->in[I_C_BF], (float*)(ws + WS_CUM), (float*)(ws + WS_TOT), it, lane); continue; }
        int r = it - nscan;
        if (r < nvt) { vt_item(PROJ, npad, 2 * D, (const float*)(ws + WS_RSTD), (bf16*)(ws + WS_VT), (LAS unsigned char*)scrw, r, lane); continue; }
        r -= nvt;
        bf16* base = PROJ + (size_t)r * npad + 8 * lane;
        u32x4 raw[4];
#pragma unroll
        for (int j = 0; j < 4; ++j) raw[j] = *(const u32x4*)(base + D + 512 * j);
        const float ar = ((const float*)(ws + WS_RSTD))[r];
#pragma unroll
        for (int j = 0; j < 4; ++j) head128_norm<false>(base + D + 512 * j, raw[j], ar, gk, 1.f, nullptr, lane);
    }
    convert_layer(A, ws, scrw, layer, 2, gw, ngw, lane);
}
__device__ __forceinline__ void phase_postproj_dsa(LAS unsigned char* lds, int layer) {
    KArgs A = kargs(); TID_VARS; unsigned char* ws = A->ws;
    bf16* PROJ = (bf16*)(ws + WS_PROJ); const float2* rope32 = (const float2*)(ws + WS_ROPE32); const float2* rope16 = (const float2*)(ws + WS_ROPE16);
    const float* gq = A->in[I_B_QN]; const float* gk = A->in[I_B_KN]; const float* gi = A->in[I_B_IKN];
    constexpr int npad = NB_PAD;
    for (int r = gw; r < M; r += ngw) { const int pos = r & (SEQ - 1);
        bf16* base = PROJ + (size_t)r * npad;
        const float2* r32 = rope32 + pos * 16; const float2* r16 = rope16 + pos * 8;
        u32x4 raw[8]; u32x4 rawi, raww;
#pragma unroll
        for (int j = 0; j < 5; ++j) raw[j] = *(const u32x4*)(base + 512 * j + 8 * lane);
        raw[5] = *(const u32x4*)(base + B_QI + 8 * lane); raw[6] = *(const u32x4*)(base + B_QI + 512 + 8 * lane);
        rawi = *(const u32x4*)(base + B_KI + 8 * (lane & 7)); raww = *(const u32x4*)(base + B_WI + 8 * (lane & 1));
        const float ar = ((const float*)(ws + WS_RSTD))[r];
        unsigned char* q8 = ws + WS_Q8 + (size_t)r * 2048 + 8 * lane; unsigned char* k8 = ws + WS_K8 + (size_t)r * 512 + 8 * lane; unsigned char* v8 = ws + WS_V8 + (size_t)r * 512 + 8 * lane;
#pragma unroll
        for (int j = 0; j < 4; ++j) head128_norm<true>(base + 512 * j + 8 * lane, raw[j], ar, gq, QSCALE * 8.f, r32, lane, q8 + 512 * j);
        head128_norm<true>(base + B_K + 8 * lane, raw[4], ar, gk, 1.f, r32, lane, k8);
        { const u32x4 rv = *(const u32x4*)(base + B_V + 8 * lane); int w0 = 0, w1 = 0;
          w0 = __builtin_amdgcn_cvt_pk_fp8_f32(bflo(rv.x) * ar, bfhi(rv.x) * ar, w0, false); w0 = __builtin_amdgcn_cvt_pk_fp8_f32(bflo(rv.y) * ar, bfhi(rv.y) * ar, w0, true);
          w1 = __builtin_amdgcn_cvt_pk_fp8_f32(bflo(rv.z) * ar, bfhi(rv.z) * ar, w1, false); w1 = __builtin_amdgcn_cvt_pk_fp8_f32(bflo(rv.w) * ar, bfhi(rv.w) * ar, w1, true);
          *(u32x2*)v8 = (u32x2){(unsigned)w0, (unsigned)w1}; }
#pragma unroll
        for (int j = 0; j < 2; ++j) head64_rope<false>(base + B_QI + 512 * j + 8 * lane, raw[5 + j], ar, nullptr, r16, lane, true);
        head64_rope<true>(base + B_KI + 8 * (lane & 7), rawi, ar, gi, r16, lane, lane < 8);
        if (lane < 2) { bf16* wp = base + B_WI + 8 * lane; const u32x4 raw = raww;
            const float sw = 0.03125f * ar;
            u32x4 w; w.x = cvtpk(bflo(raw.x) * sw, bfhi(raw.x) * sw); w.y = cvtpk(bflo(raw.y) * sw, bfhi(raw.y) * sw);
            w.z = cvtpk(bflo(raw.z) * sw, bfhi(raw.z) * sw); w.w = cvtpk(bflo(raw.w) * sw, bfhi(raw.w) * sw); *(u32x4*)wp = w; }
    }
    convert_layer(A, ws, (LAS float*)(lds + RING_OFF + wave * 8448), layer, 2, gw, ngw, lane);
}
template <int MODE>
__device__ __forceinline__ void phase_attn_dense(LAS unsigned char* lds, int layer, int rep) {
    KArgs A = kargs(); TID_VARS; unsigned char* ws = A->ws; const LayerCfg L = layer_cfg(layer);
    const float* gq = L.kind == 0 ? A->in[I_A_QN] + L.jk * HD : A->in[I_C_QN]; const float* gk = L.kind == 0 ? A->in[I_A_KN] + L.jk * HD : A->in[I_C_KN];
    const float zb2 = zbound2(gq, gk, lane);
    gu32* qhead = (gu32*)(ws + WS_CTL) + CW_QUEUE + 64 * layer + 16 * rep;
    volatile LAS unsigned* uw = (volatile LAS unsigned*)(lds + RING_OFF + A2_CTRL);
    for (;;) { if (tid == 0) uw[0] = __hip_atomic_fetch_add(qhead, 1u, RLX_AGENT); __syncthreads(); const unsigned it = uw[0]; __syncthreads();
        if (it >= 32u * 64u) break;
        const int grp = 31 - (int)(it >> 6), bh = (int)(it & 63u);
        attn2_unit<MODE>((const bf16*)(ws + WS_PROJ), L.npad, (const bf16*)(ws + WS_VT), (const float*)(ws + WS_CUM), (const float*)(ws + WS_TOT), gq, (const float*)(ws + WS_RSTD), (bf16*)(ws + WS_MIX), zb2, grp, bh, lds + RING_OFF, tid); }
}
__device__ __forceinline__ void phase_attn_dsa(LAS unsigned char* lds, int layer, int rep) {
    KArgs A = kargs(); TID_VARS; unsigned char* ws = A->ws;
    gu32* qhead = (gu32*)(ws + WS_CTL) + CW_QUEUE + 64 * layer + 16 * rep;
    float* scr = (float*)(ws + (bx < 128 ? WS_SCR_A + (size_t)bx * MiB : WS_SCR_B + (size_t)(bx - 128) * MiB));
    volatile LAS unsigned* uw = (volatile LAS unsigned*)(lds + RING_OFF + DL_MISC + 128);
    for (;;) { if (tid == 0) uw[0] = __hip_atomic_fetch_add(qhead, 1u, RLX_AGENT); __syncthreads(); const unsigned u = uw[0]; __syncthreads();
        if (u >= 1024u) break; dsa_unit((const bf16*)(ws + WS_PROJ), ws + WS_Q8, ws + WS_K8, ws + WS_V8, (bf16*)(ws + WS_MIX), scr, lds + RING_OFF, (int)u, tid); }
}
__device__ __forceinline__ void phase_wo(LAS unsigned char* lds, int layer) {
    KArgs A = kargs(); TID_VARS; unsigned char* ws = A->ws;
    pg8::Gemm g{(const bf16*)(ws + WS_MIX), (const bf16*)(ws + WS_WO), M, D, D}; pg8::StaticOrder S; S.init(M, D, G, bx, WGM_WO);
    bf16* hb = (bf16*)(ws + ((layer & 1) ? WS_HB1 : WS_HB0));
    pg8::EpiH<false, false> E{hb, hb, (float*)(ws + WS_SSP_WO), nullptr, nullptr, nullptr};
    pg8::gemm_phase<pg8::EpiH<false, false>, pg8::StaticOrder, PG_ALIGN, PG_SP2>(lds + RING_OFF, g, S, E);
}
__device__ __forceinline__ void phase_pp(LAS unsigned char* lds, int layer) {
    KArgs A = kargs(); TID_VARS; unsigned char* ws = A->ws;
    int kpl = PLE; asm volatile("" : "+s"(kpl));
    pg8::Gemm g{(const bf16*)(ws + WS_PB) + (size_t)layer * M * PLE, (const bf16*)(ws + WS_WPL), M, D, kpl}; pg8::StaticOrder S; S.init(M, D, G, bx, WGM_PP);
    pg8::EpiStore<0, false> E{(bf16*)(ws + WS_PP), D, nullptr};
    pg8::gemm_phase<pg8::EpiStore<0, false>, pg8::StaticOrder, PG_ALIGN, PG_SP2>(lds + RING_OFF, g, S, E);
}
__device__ __forceinline__ void phase_up(LAS unsigned char* lds, int layer) {
    KArgs A = kargs(); TID_VARS; unsigned char* ws = A->ws;
    pg8::Gemm g{(const bf16*)(ws + ((layer & 1) ? WS_HB1 : WS_HB0)), (const bf16*)(ws + WS_WUP), M, FF, D}; pg8::StaticOrder S; S.init(M, FF, G, bx, WGM_UP);
    pg8::EpiStore<1, false> E{(bf16*)(ws + WS_HID), FF, nullptr};
    pg8::gemm_phase<pg8::EpiStore<1, false>, pg8::StaticOrder, PG_ALIGN, PG_SP2>(lds + RING_OFF, g, S, E);
}
__device__ __forceinline__ void phase_down(LAS unsigned char* lds, int layer) {
    KArgs A = kargs(); TID_VARS; unsigned char* ws = A->ws;
    pg8::Gemm g{(const bf16*)(ws + WS_HID), (const bf16*)(ws + WS_WDN), M, D, FF}; pg8::StaticOrder S; S.init(M, D, G, bx, WGM_DN);
    bf16* hb = (bf16*)(ws + ((layer & 1) ? WS_HB1 : WS_HB0));
    pg8::EpiH<false, false, true> E{hb, hb, (float*)(ws + WS_SSP_DN), nullptr, (const float*)(ws + WS_SSP_WO), nullptr};
    pg8::gemm_phase<pg8::EpiH<false, false, true>, pg8::StaticOrder, PG_ALIGN, PG_SP2>(lds + RING_OFF, g, S, E);
}
template <bool FINAL>
__device__ __forceinline__ void phase_gate(LAS unsigned char* lds, int layer) {
    KArgs A = kargs(); TID_VARS; unsigned char* ws = A->ws;
    pg8::Gemm g{(const bf16*)(ws + ((layer & 1) ? WS_HB1 : WS_HB0)), (const bf16*)(ws + WS_WG), M, D, D}; pg8::StaticOrder S; S.init(M, D, G, bx, WGM_GT);
    pg8::EpiH<true, FINAL> E{(const bf16*)(ws + ((layer & 1) ? WS_HB1 : WS_HB0)), (bf16*)(ws + ((layer & 1) ? WS_HB0 : WS_HB1)), (float*)(ws + WS_SSP_IN), (const bf16*)(ws + WS_PP), (const float*)(ws + WS_SSP_DN), A->out};
    pg8::gemm_phase<pg8::EpiH<true, FINAL>, pg8::StaticOrder, PG_ALIGN, PG_SP2>(lds + RING_OFF, g, S, E);
}
__device__ __forceinline__ void phase_convert_next(LAS unsigned char* lds, int layer) {
    KArgs A = kargs(); TID_VARS; unsigned char* ws = A->ws;
    convert_layer(A, ws, (LAS float*)(lds + RING_OFF + wave * 8448), layer, 1, gw, ngw, lane);
}

__global__ void __launch_bounds__(NTHR, 2) trunk_fwd(Args args) {
    extern __shared__ __attribute__((aligned(16))) unsigned char lds_raw[];
    LAS unsigned char* lds = (LAS unsigned char*)lds_raw;
    for (int u = threadIdx.x; u < (LDS_BYTES - LDSCTL_OFF) / 4; u += NTHR) ((LAS unsigned*)(lds + LDSCTL_OFF))[u] = 0u;
    __syncthreads();
    { KArgs A = kargs(); (void)xcd_barrier_post((unsigned*)(A->ws + WS_CTL) + CW_BAR, (volatile LAS unsigned*)(lds + MISC_OFF) + 8); }
#ifdef PROBE_MASK
    unsigned long long pt_acc = 0ull, pt_last = __builtin_amdgcn_s_memrealtime();
#define PT(cls) do { const unsigned long long now_ = __builtin_amdgcn_s_memrealtime(); if ((PROBE_MASK >> (cls)) & 1) pt_acc += now_ - pt_last; pt_last = now_; } while (0)
#else
#define PT(cls) do { } while (0)
#endif
    phase_prologue(lds);
    grid_bar(lds); PT(7);
    for (int layer = 0; layer < DEPTH; ++layer) {
        const int kind = layer % 3;
        phase_inproj(lds, layer);
        grid_bar(lds); PT(0);
        if (kind != 1) phase_postproj_dense(lds, layer); else phase_postproj_dsa(lds, layer);
        grid_bar(lds); PT(1);
        if (kind == 0) phase_attn_dense<0>(lds, layer, 0);
        else if (kind == 2) phase_attn_dense<1>(lds, layer, 0);
        else phase_attn_dsa(lds, layer, 0);
        grid_bar(lds); PT(kind == 0 ? 2 : (kind == 1 ? 8 : 9));
        phase_wo(lds, layer);
        phase_pp(lds, layer);
        grid_bar(lds); PT(3);
        phase_up(lds, layer);
        grid_bar(lds); PT(4);
        phase_down(lds, layer);
        grid_bar(lds); PT(5);
        if (layer + 1 < DEPTH) { phase_gate<false>(lds, layer); __syncthreads(); phase_convert_next(lds, layer + 1); }
        else phase_gate<true>(lds, layer);
        grid_bar(lds); PT(6);
    }
#ifdef PROBE_MASK
#if defined(PROBE_EPI) || defined(PROBE_DSA)
    pt_acc = *(volatile LAS unsigned long long*)(lds + MISC_OFF + 64);
#endif
    if (blockIdx.x == 0 && threadIdx.x == 0) { const unsigned long long until = __builtin_amdgcn_s_memrealtime() + (unsigned long long)PROBE_AMP * pt_acc;
        while (__builtin_amdgcn_s_memrealtime() < until) __builtin_amdgcn_s_sleep(32); }
#endif
}

extern "C" void kernel_launch(void* const* d_in, const int* in_sizes, int n_in, void* d_out, int out_size, void* d_ws, size_t ws_size, hipStream_t stream) {
    static int grid = 0;
    if (grid == 0) {
        if (n_in != 21 || out_size != M * D || ws_size < WS_END2) { fprintf(stderr, "kernel_launch: unexpected shapes (n_in %d, out %d, ws %zu)\n", n_in, out_size, ws_size); grid = -1; return; }
        int dev = 0, cus = 0, per_cu = 0;
        if (hipGetDevice(&dev) != hipSuccess || hipDeviceGetAttribute(&cus, hipDeviceAttributeMultiprocessorCount, dev) != hipSuccess) { grid = -1; return; }
        if (hipFuncSetAttribute((const void*)trunk_fwd, hipFuncAttributeMaxDynamicSharedMemorySize, LDS_BYTES) != hipSuccess) { fprintf(stderr, "kernel_launch: hipFuncSetAttribute failed\n"); grid = -1; return; }
        if (hipOccupancyMaxActiveBlocksPerMultiprocessor(&per_cu, (const void*)trunk_fwd, NTHR, LDS_BYTES) != hipSuccess || per_cu < 1) { fprintf(stderr, "kernel_launch: occupancy query says %d\n", per_cu); }
        (void)hipGetLastError();
        grid = cus > 256 ? 256 : cus;
    }
    if (grid < 0) return;
    if (hipMemsetAsync((char*)d_ws + WS_CTL, 0, CTL_ZERO_BYTES, stream) != hipSuccess) return;
    Args a{};
    for (int i = 0; i < 21; ++i) a.in[i] = (const float*)d_in[i];
    a.out = (float*)d_out; a.ws = (unsigned char*)d_ws;
    hipLaunchKernelGGL(trunk_fwd, dim3(grid), dim3(NTHR), LDS_BYTES, stream, a);
}
```

```cpp
#include <hip/hip_runtime.h>
#include <cstdio>
#include <cstdint>
namespace pg8 {
#define PG8_LAS __attribute__((address_space(3)))
typedef unsigned short bf16_t;
typedef short bf16x8 __attribute__((ext_vector_type(8)));
typedef float f32x4 __attribute__((ext_vector_type(4)));
typedef unsigned u32x4 __attribute__((ext_vector_type(4)));
constexpr int BM = 256, BK = 64, HALF = 128, HTB = HALF * BK * 2  , STAGE_BYTES = 8 * HTB, NXCD = 8, WGM = 8;

__host__ __device__ __forceinline__ int lds_byte(int r, int c) { const int st = (r >> 4) * 2 + (c >> 5), rr = r & 15, cc = c & 31, ob = rr * 64 + cc * 2; return st * 1024 + (ob ^ (((ob >> 9) & 1) << 5)); }
__host__ __device__ __forceinline__ void stage_rc(int b, int& R, int& C) { const int st = b / 1024, sb = b % 1024, swz = sb ^ (((sb >> 9) & 1) << 5); R = (st >> 1) * 16 + swz / 64; C = (st & 1) * 32 + (swz % 64) / 2; }
__host__ __device__ __forceinline__ int perm32(int rho) { const int n = rho >> 4, i = rho & 15; return 8 * (i >> 2) + 4 * n + (i & 3); }

struct Unit { int pm, pn; };
struct Gemm { const bf16_t* A; const bf16_t* Bt; int M, N, K; };

struct StaticOrder {
    int nM, nN, nwg, G, c, wgm;
    __host__ __device__ void init(int M, int N, int G_, int c_, int wgm_ = 4) { nM = M / BM; nN = N / BM; nwg = nM * nN; G = G_; c = c_; wgm = wgm_; }
    __host__ __device__ bool next(int i, Unit& u) const {
        const long L = (long)i * G + c; if (L >= nwg) return false;
        int wgid = (int)L; { const int q = nwg / NXCD, r = nwg % NXCD, xcd = wgid % NXCD, off = wgid / NXCD; wgid = (xcd < r ? xcd * (q + 1) : r * (q + 1) + (xcd - r) * q) + off; }
        const int nig = wgm * nN, gid = wgid / nig, fm = gid * wgm, gsz = (nM - fm) < wgm ? (nM - fm) : wgm;
        u.pm = fm + ((wgid % nig) % gsz); u.pn = (wgid % nig) / gsz; return true;
    }
    __device__ __forceinline__ void a_ready(const Unit&) const {}
    __device__ __forceinline__ void done(const Unit&) const {}
};

__device__ __forceinline__ unsigned cvt_pk_bf16(float lo, float hi) { unsigned r; asm volatile("v_cvt_pk_bf16_f32 %0, %1, %2" : "=v"(r) : "v"(lo), "v"(hi)); return r; }
typedef float f32x2 __attribute__((ext_vector_type(2)));
template <class Epi, class Sched, bool ALIGN_EPI = false, bool SP2 = false>
__device__ __forceinline__ void gemm_phase(PG8_LAS unsigned char* lds, const Gemm g, const Sched& S, const Epi& E) {
    int tid_l = threadIdx.x; asm volatile("" : "+v"(tid_l));
    const int tid = tid_l, wid = __builtin_amdgcn_readfirstlane(tid >> 6), lane = tid & 63, wr = wid >> 2, wc = wid & 3, fr = lane & 15, fq = lane >> 4;
    const int K = g.K, nt = K / BK;
    unsigned voffA[2], voffB[2];
#pragma unroll
    for (int i = 0; i < 2; ++i) { int R, C; stage_rc(tid * 16 + i * 8192, R, C); const int Rb = Epi::PERM ? ((R & ~31) + perm32(R & 31)) : R;
        voffA[i] = (unsigned)(R * K + C) * 2u; voffB[i] = (unsigned)(Rb * K + C) * 2u; }
    const size_t kstep = (size_t)(BK * 2);
    const size_t hstep = (size_t)HALF * K * 2;
    const size_t tstep = 2 * hstep;
    const unsigned ldsw = (unsigned)wid * 1024u;
    const int aoff = lds_byte(wr * 64 + fr, fq * 8), boff = lds_byte(wc * 32 + fr, fq * 8);
#define PG8_SA(b, h) (((b) * 2 + (h)) * HTB)
#define PG8_SB(b, h) ((4 + (b) * 2 + (h)) * HTB)
#define PG8_STAGE(bufoff, gbase, voff) do { _Pragma("unroll") for (int _i = 0; _i < 2; ++_i) \
        __builtin_amdgcn_global_load_lds((const unsigned*)((const char*)(gbase) + (voff)[_i]), (PG8_LAS unsigned*)(lds + (bufoff) + ldsw + _i * 8192), 16, 0, 0); } while (0)
#define PG8_LDA(dst, b, h) do { _Pragma("unroll") for (int m = 0; m < 4; ++m) _Pragma("unroll") for (int k = 0; k < 2; ++k) dst[m][k] = *(const PG8_LAS bf16x8*)(lds + PG8_SA(b, h) + aoff + m * 2048 + k * 1024); } while (0)
#define PG8_LDB(dst, b, h) do { _Pragma("unroll") for (int n = 0; n < 2; ++n) _Pragma("unroll") for (int k = 0; k < 2; ++k) dst[n][k] = *(const PG8_LAS bf16x8*)(lds + PG8_SB(b, h) + boff + n * 2048 + k * 1024); } while (0)
#define PG8_MMA(ai, bj, At, Bt) do { __builtin_amdgcn_s_setprio(1); _Pragma("unroll") for (int m = 0; m < 4; ++m) _Pragma("unroll") for (int n = 0; n < 2; ++n) _Pragma("unroll") for (int k = 0; k < 2; ++k) \
        acc[ai][bj][m][n] = __builtin_amdgcn_mfma_f32_16x16x32_bf16(Bt[n][k], At[m][k], acc[ai][bj][m][n], 0, 0, 0); __builtin_amdgcn_s_setprio(0); } while (0)
#define PG8_WAIT_V(n) asm volatile("s_waitcnt vmcnt(" #n ")" ::: "memory")
#define PG8_WAIT_L(n) asm volatile("s_waitcnt lgkmcnt(" #n ")" ::: "memory")
#define PG8_BAR __builtin_amdgcn_s_barrier()
#define PG8_SCHED __builtin_amdgcn_sched_barrier(0)
    Unit cur, nxt; int ui = 0;
    if (!S.next(0, cur)) return;
    f32x4 acc[2][2][4][2];
#pragma unroll
    for (int a = 0; a < 2; ++a)
#pragma unroll
        for (int b = 0; b < 2; ++b)
#pragma unroll
            for (int m = 0; m < 4; ++m)
#pragma unroll
                for (int n = 0; n < 2; ++n) acc[a][b][m][n] = (f32x4){0.f, 0.f, 0.f, 0.f};
    bf16x8 At[4][2], B0[2][2], B1[2][2];
    const char* cA = (const char*)g.A + (size_t)cur.pm * tstep; const char* cB = (const char*)g.Bt + (size_t)cur.pn * tstep;
    S.a_ready(cur);
    if constexpr (SP2) {
        PG8_STAGE(PG8_SB(0, 0), cB, voffB); PG8_STAGE(PG8_SB(0, 1), cB + hstep, voffB); PG8_STAGE(PG8_SA(0, 0), cA, voffA); PG8_STAGE(PG8_SA(0, 1), cA + hstep, voffA);
        if (wr == 1) PG8_BAR;
        PG8_WAIT_V(2); PG8_BAR;
        PG8_STAGE(PG8_SB(1, 0), cB + kstep, voffB); PG8_STAGE(PG8_SA(1, 0), cA + kstep, voffA); PG8_STAGE(PG8_SB(1, 1), cB + hstep + kstep, voffB);
        PG8_WAIT_V(6); PG8_BAR;
    } else {
        PG8_STAGE(PG8_SB(0, 0), cB, voffB); PG8_STAGE(PG8_SA(0, 0), cA, voffA); PG8_STAGE(PG8_SB(0, 1), cB + hstep, voffB); PG8_STAGE(PG8_SA(0, 1), cA + hstep, voffA);
        if (wr == 1) PG8_BAR;
        PG8_WAIT_V(4); PG8_BAR;
        PG8_STAGE(PG8_SB(1, 0), cB + kstep, voffB); PG8_STAGE(PG8_SA(1, 0), cA + kstep, voffA); PG8_STAGE(PG8_SB(1, 1), cB + hstep + kstep, voffB);
        PG8_WAIT_V(6); PG8_BAR;
    }
    for (;;) {
        const bool has_next = S.next(ui + 1, nxt);
        const char* nA = has_next ? (const char*)g.A + (size_t)nxt.pm * tstep : cA; const char* nB = has_next ? (const char*)g.Bt + (size_t)nxt.pn * tstep : cB;
        for (int t = 0; t < nt; t += 2) {
            const bool last = (t == nt - 2);
            const char* a1 = cA + (size_t)(t + 1) * kstep;
            const char* a2 = last ? nA : cA + (size_t)(t + 2) * kstep; const char* b2 = last ? nB : cB + (size_t)(t + 2) * kstep;
            const char* a3 = a2 + kstep; const char* b3 = b2 + kstep;
            if (last && has_next) S.a_ready(nxt);
            if constexpr (SP2) {
            PG8_LDB(B0, 0, 0); PG8_LDB(B1, 0, 1); PG8_SCHED; PG8_LDA(At, 0, 0); PG8_STAGE(PG8_SA(1, 1), a1 + hstep, voffA);
            PG8_WAIT_V(8); PG8_WAIT_L(0); PG8_BAR; PG8_MMA(0, 0, At, B0); PG8_MMA(0, 1, At, B1); PG8_BAR; PG8_SCHED;
            PG8_LDA(At, 0, 1); PG8_STAGE(PG8_SB(0, 0), b2, voffB); PG8_STAGE(PG8_SB(0, 1), b2 + hstep, voffB); PG8_STAGE(PG8_SA(0, 0), a2, voffA);
            PG8_WAIT_V(8); PG8_WAIT_L(0); PG8_BAR; PG8_MMA(1, 0, At, B0); PG8_MMA(1, 1, At, B1); PG8_BAR; PG8_SCHED;
            PG8_LDB(B0, 1, 0); PG8_LDB(B1, 1, 1); PG8_SCHED; PG8_LDA(At, 1, 0); PG8_STAGE(PG8_SA(0, 1), a2 + hstep, voffA);
            PG8_WAIT_V(8); PG8_WAIT_L(0); PG8_BAR; PG8_MMA(0, 0, At, B0); PG8_MMA(0, 1, At, B1); PG8_BAR; PG8_SCHED;
            PG8_LDA(At, 1, 1); PG8_STAGE(PG8_SB(1, 0), b3, voffB); PG8_STAGE(PG8_SB(1, 1), b3 + hstep, voffB); PG8_STAGE(PG8_SA(1, 0), a3, voffA);
            PG8_WAIT_V(8); PG8_WAIT_L(0); PG8_BAR; PG8_MMA(1, 0, At, B0); PG8_MMA(1, 1, At, B1); PG8_BAR; PG8_SCHED;
            } else {
            PG8_LDB(B0, 0, 0); PG8_SCHED; PG8_LDA(At, 0, 0); PG8_STAGE(PG8_SA(1, 1), a1 + hstep, voffA);
            PG8_WAIT_L(8); PG8_BAR; PG8_WAIT_L(0); PG8_MMA(0, 0, At, B0); PG8_BAR; PG8_SCHED;
            PG8_LDB(B1, 0, 1); PG8_STAGE(PG8_SB(0, 0), b2, voffB);
            PG8_BAR; PG8_WAIT_L(0); PG8_MMA(0, 1, At, B1); PG8_BAR;
            PG8_LDA(At, 0, 1); PG8_STAGE(PG8_SA(0, 0), a2, voffA);
            PG8_BAR; PG8_WAIT_L(0); PG8_MMA(1, 0, At, B0); PG8_BAR; PG8_SCHED;
            PG8_STAGE(PG8_SB(0, 1), b2 + hstep, voffB);
            PG8_WAIT_V(6); PG8_BAR; PG8_MMA(1, 1, At, B1); PG8_BAR;
            PG8_LDB(B0, 1, 0); PG8_SCHED; PG8_LDA(At, 1, 0); PG8_STAGE(PG8_SA(0, 1), a2 + hstep, voffA);
            PG8_WAIT_L(8); PG8_BAR; PG8_WAIT_L(0); PG8_MMA(0, 0, At, B0); PG8_BAR; PG8_SCHED;
            PG8_LDB(B1, 1, 1); PG8_STAGE(PG8_SB(1, 0), b3, voffB);
            PG8_BAR; PG8_WAIT_L(0); PG8_MMA(0, 1, At, B1); PG8_BAR;
            PG8_LDA(At, 1, 1); PG8_STAGE(PG8_SA(1, 0), a3, voffA);
            PG8_BAR; PG8_WAIT_L(0); PG8_MMA(1, 0, At, B0); PG8_BAR; PG8_SCHED;
            PG8_STAGE(PG8_SB(1, 1), b3 + hstep, voffB);
            PG8_WAIT_V(6); PG8_BAR; PG8_MMA(1, 1, At, B1); PG8_BAR;
            }
        }
        if constexpr (ALIGN_EPI) { if (wr == 0) PG8_BAR; }
#ifdef PROBE_EPI
        const unsigned long long te0_ = __builtin_amdgcn_s_memrealtime();
#endif
        if constexpr (!Epi::AFTER_DRAIN) { E(acc, cur, wr, wc, fr, fq); S.done(cur); }
#ifdef PROBE_EPI
        if (tid == 0) { volatile PG8_LAS unsigned long long* pe_ = (volatile PG8_LAS unsigned long long*)(lds + 131072 + 320 + 64); pe_[0] = pe_[0] + (__builtin_amdgcn_s_memrealtime() - te0_); }
#endif
        if (!has_next) break;
#pragma unroll
        for (int a = 0; a < 2; ++a)
#pragma unroll
            for (int b = 0; b < 2; ++b)
#pragma unroll
                for (int m = 0; m < 4; ++m)
#pragma unroll
                    for (int n = 0; n < 2; ++n) acc[a][b][m][n] = (f32x4){0.f, 0.f, 0.f, 0.f};
        cur = nxt; cA = nA; cB = nB; ++ui;
        if constexpr (ALIGN_EPI) { if (wr == 1) PG8_BAR; }
    }
    PG8_WAIT_V(0);
    if constexpr (!ALIGN_EPI) { if (wr == 0) PG8_BAR; }
    PG8_BAR;
    if constexpr (Epi::AFTER_DRAIN) { E.fused(acc, cur, wr, wc, fr, fq, lds, wid, lane); S.done(cur); }
#undef PG8_SA
#undef PG8_SB
#undef PG8_STAGE
#undef PG8_LDA
#undef PG8_LDB
#undef PG8_MMA
#undef PG8_WAIT_V
#undef PG8_WAIT_L
#undef PG8_BAR
#undef PG8_SCHED
}
}
#define GAS __attribute__((address_space(1)))
#define LAS __attribute__((address_space(3)))
typedef unsigned short bf16;
typedef unsigned v4u __attribute__((ext_vector_type(4)));
typedef float f32x4 __attribute__((ext_vector_type(4)));
typedef short bf16x8 __attribute__((ext_vector_type(8)));
typedef GAS unsigned gu32;
typedef GAS unsigned long long gu64;
#define RLX_AGENT __ATOMIC_RELAXED, __HIP_MEMORY_SCOPE_AGENT
#define LDS_WAIT() asm volatile("s_waitcnt lgkmcnt(0)" ::: "memory")
#define VM_WAIT() asm volatile("s_waitcnt vmcnt(0)" ::: "memory")
__device__ __forceinline__ unsigned long long rt() { return __builtin_amdgcn_s_memrealtime(); }
__device__ __forceinline__ unsigned f2bf(float f) { unsigned u = __builtin_bit_cast(unsigned, f); return (u + 0x7fffu + ((u >> 16) & 1u)) >> 16; }
__device__ __forceinline__ unsigned pk2(float lo, float hi) { return f2bf(lo) | (f2bf(hi) << 16); }
typedef unsigned u32x4 __attribute__((ext_vector_type(4)));
#define XB_TMO      128
#define XB_XCNT(j)  (256  + 64 * (j))
#define XB_XSUB(j)  (1280 + 64 * (j))
#define XB_XGEN(j)  (2304 + 64 * (j))
#define XB_TOP      3328
#define XB_TOPGEN   3392
#define XCD_BAR_WORDS 3456
#define XB_SPIN_CAP (1u << 18)

__device__ __forceinline__ unsigned xb_ld(unsigned* p)              { return __hip_atomic_load(p, __ATOMIC_RELAXED, __HIP_MEMORY_SCOPE_AGENT); }
__device__ __forceinline__ unsigned xb_add(unsigned* p, unsigned v) { return __hip_atomic_fetch_add(p, v, __ATOMIC_RELAXED, __HIP_MEMORY_SCOPE_AGENT); }
__device__ __forceinline__ unsigned xb_xcc_id() { return (unsigned)__builtin_amdgcn_s_getreg((3 << 11) | 20) & 0xFu; }
#define XB_SPIN(cond, bar) do { unsigned _sp = 0; while (cond) { __builtin_amdgcn_s_sleep(1); \
    if ((++_sp & 255u) == 0u) { if (xb_ld(&(bar)[XB_TMO])) break; if (_sp > XB_SPIN_CAP) { atomicAdd(&(bar)[XB_TMO], 1u); break; } } } } while (0)

struct XcdBarrier {
    unsigned* bar; unsigned x;
    volatile LAS unsigned* st;
};

__device__ __forceinline__ XcdBarrier xcd_barrier_post(unsigned* bar, volatile LAS unsigned* st) {
    XcdBarrier b; b.bar = bar; b.x = xb_xcc_id(); b.st = st;
    if (threadIdx.x == 0) (void)xb_add(&bar[XB_XCNT(b.x)], 1u);
    return b;
}
__device__ __forceinline__ void xcd_barrier_complete(unsigned* bar, unsigned x, unsigned& nloc, unsigned& nx) {
    const unsigned G = gridDim.x * gridDim.y * gridDim.z;
    unsigned sum, cnt, mine, sp = 0u;
    for (;;) {
        sum = 0u; cnt = 0u; mine = 0u;
#pragma unroll
        for (unsigned j = 0; j < 16; ++j) { const unsigned c = xb_ld(&bar[XB_XCNT(j)]); sum += c; cnt += (c > 0u) ? 1u : 0u; mine = (j == x) ? c : mine; }
        if (sum == G) break;
        __builtin_amdgcn_s_sleep(1);
        if ((++sp & 255u) == 0u) { if (xb_ld(&bar[XB_TMO])) break; if (sp > XB_SPIN_CAP) { atomicAdd(&bar[XB_TMO], 1u); break; } }
    }
    nloc = mine > 0u ? mine : 1u; nx = cnt > 0u ? cnt : 1u;
}

__device__ __forceinline__ void xcd_barrier(const XcdBarrier& b) {
    asm volatile("s_waitcnt vmcnt(0)" ::: "memory");
    __syncthreads();
    if (threadIdx.x == 0) {
        unsigned* bar = b.bar;
        __builtin_amdgcn_s_waitcnt(0);
        unsigned nloc = b.st[0], nx = b.st[1];
        if (nloc == 0u) { xcd_barrier_complete(bar, b.x, nloc, nx); b.st[0] = nloc; b.st[1] = nx; }
        const unsigned old = xb_add(&bar[XB_XSUB(b.x)], 1u);
        const unsigned gen = old / nloc;
        if (old + 1u == (gen + 1u) * nloc) {
            __builtin_amdgcn_fence(__ATOMIC_RELEASE, "agent");
            asm volatile("s_waitcnt vmcnt(0)" ::: "memory");
            const unsigned og = xb_add(&bar[XB_TOP], 1u);
            const unsigned tg = og / nx;
            if (og + 1u == (tg + 1u) * nx) xb_add(&bar[XB_TOPGEN], 1u);
            else XB_SPIN(xb_ld(&bar[XB_TOPGEN]) == tg, bar);
            __builtin_amdgcn_fence(__ATOMIC_ACQUIRE, "agent");
            xb_add(&bar[XB_XGEN(b.x)], 1u);
            asm volatile("s_waitcnt vmcnt(0)" ::: "memory");
        } else {
            XB_SPIN(xb_ld(&bar[XB_XGEN(b.x)]) == gen, bar);
            __builtin_amdgcn_fence(__ATOMIC_ACQUIRE, "agent");
            asm volatile("s_waitcnt vmcnt(0)" ::: "memory");
        }
    }
    __syncthreads();
}

constexpr int NWAVES = 8, NTHR = 512;
constexpr int BATCH = 4, SEQ = 8192, M = BATCH * SEQ, D = 2048, NH = 16, HD = 128, FF = 8192, PLE = 256, DEPTH = 4;
constexpr int NA_IN = 6144, NB_IN = 4176, NB_PAD = 4352, NC_IN = 6160, NC_PAD = 6400;
constexpr int B_K = 2048, B_V = 2560, B_QI = 3072, B_KI = 4096, B_WI = 4160;
constexpr float RMS_EPS = 1e-6f, LOG2E = 1.4426950408889634f;
constexpr float QSCALE = 0.08838834764831845f * 1.4426950408889634f;
constexpr float ZERO_LOG2 = -160.f;

constexpr size_t MiB = 1u << 20;
constexpr size_t WS_CTL = 0, CTL_ZERO_BYTES = 1 * MiB;
constexpr size_t WS_ROPE32 = 1 * MiB, WS_ROPE16 = 2 * MiB, WS_CUM = 3 * MiB, WS_TOT = 5 * MiB, WS_RSTD = 6 * MiB;
constexpr size_t WS_WIN = 8 * MiB, WS_WO = 33 * MiB, WS_WUP = 41 * MiB, WS_WDN = 73 * MiB, WS_WG = 105 * MiB, WS_WPL = 113 * MiB;
constexpr size_t WS_PB = 120 * MiB, WS_HN = 184 * MiB, WS_PROJ = 312 * MiB, WS_MIX = 712 * MiB, WS_VT = 840 * MiB, WS_END = 968 * MiB;
constexpr size_t WS_HID = WS_PROJ, WS_PP = WS_VT, WS_HB0 = WS_HN, WS_HB1 = 968 * MiB, WS_SSP_IN = 1096 * MiB, WS_SSP_WO = 1100 * MiB, WS_SSP_DN = 1104 * MiB, WS_K8 = 1108 * MiB, WS_V8 = 1124 * MiB, WS_Q8 = 1140 * MiB, WS_END2 = 1204 * MiB;
constexpr size_t WS_SCR_A = WS_PROJ + 272 * MiB, WS_SCR_B = WS_VT;
static_assert(WS_HID + (size_t)M * FF * 2 <= WS_VT, "hidden overlays proj|mix");
static_assert(WS_PROJ + (size_t)M * NB_PAD * 2 <= WS_SCR_A && WS_SCR_A + 128 * MiB <= WS_MIX, "scratch A");

constexpr int CW_BAR = 4096;
constexpr int CW_QUEUE = 16384;

constexpr int RING_OFF = 0, RING_BYTES = 131072;
constexpr int LDSCTL_OFF = RING_BYTES, MISC_OFF = LDSCTL_OFF + 320;
constexpr int LDS_BYTES = 147456;

typedef float f32x16 __attribute__((ext_vector_type(16)));
typedef unsigned u32x2 __attribute__((ext_vector_type(2)));
typedef __bf16 bf16x2_t __attribute__((ext_vector_type(2)));
typedef float f32x2_t __attribute__((ext_vector_type(2)));
typedef short s16x4_t __attribute__((ext_vector_type(4)));

__device__ __forceinline__ float bf2f(unsigned short b) { return __builtin_bit_cast(float, (unsigned)b << 16); }
__device__ __forceinline__ float bflo(unsigned u) { return __builtin_bit_cast(float, u << 16); }
__device__ __forceinline__ float bfhi(unsigned u) { return __builtin_bit_cast(float, u & 0xffff0000u); }
__device__ __forceinline__ float relu_raw(float x) { const int i = __builtin_bit_cast(int, x); return __builtin_bit_cast(float, i > 0 ? i : 0); }
__device__ __forceinline__ unsigned cvtpk(float lo, float hi) { f32x2_t v = {lo, hi}; bf16x2_t b = __builtin_convertvector(v, bf16x2_t); return __builtin_bit_cast(unsigned, b); }
__device__ __forceinline__ float wave_sum(float v) {
#pragma unroll
    for (int o = 1; o < 64; o <<= 1) v += __shfl_xor(v, o);
    return v;
}
__device__ __forceinline__ float wave_max(float v) {
#pragma unroll
    for (int o = 1; o < 64; o <<= 1) v = fmaxf(v, __shfl_xor(v, o));
    return v;
}
__device__ __forceinline__ float wave_min(float v) {
#pragma unroll
    for (int o = 1; o < 64; o <<= 1) v = fminf(v, __shfl_xor(v, o));
    return v;
}
__device__ __forceinline__ float fexp2(float x) { return __builtin_amdgcn_exp2f(x); }
__device__ __forceinline__ float flog2(float x) { return __builtin_amdgcn_logf(x); }

namespace pg8 {
__device__ __forceinline__ void row_rstd(const float* ssp, int rowbase, int fr, int fq, float (&rs)[2][4]) {
    float mine[2];
#pragma unroll
    for (int t = 0; t < 2; ++t) { const int row = rowbase + (fq >> 1) * HALF + (2 * (fq & 1) + t) * 16 + fr;
        const f32x4* p = (const f32x4*)(ssp + (size_t)row * 32); float sm = 0.f;
#pragma unroll
        for (int q = 0; q < 8; ++q) { const f32x4 v = p[q]; sm += (v.x + v.y) + (v.z + v.w); }
        mine[t] = 1.f / sqrtf(sm * (1.f / 2048.f) + 1e-6f); }
#pragma unroll
    for (int ai = 0; ai < 2; ++ai)
#pragma unroll
        for (int m = 0; m < 4; ++m) { const int src = (ai * 2 + (m >> 1)) * 16 + fr; const float a = __shfl(mine[0], src), b = __shfl(mine[1], src); rs[ai][m] = (m & 1) ? b : a; }
}
template <int ACT  , bool SCALE>
struct EpiStore {
    static constexpr bool PERM = true, AFTER_DRAIN = false;
    bf16_t* O; int ldc; const float* ssp;
    __device__ __forceinline__ void operator()(const f32x4 (&acc)[2][2][4][2], const Unit& u, int wr, int wc, int fr, int fq) const {
        const int row0 = u.pm * BM + wr * 64 + fr, col0 = u.pn * BM + wc * 32 + 8 * fq;
        float rs[2][4];
        if (SCALE) row_rstd(ssp, u.pm * BM + wr * 64, fr, fq, rs);
#pragma unroll
        for (int ai = 0; ai < 2; ++ai)
#pragma unroll
            for (int m = 0; m < 4; ++m) { bf16_t* rowp = O + (size_t)(row0 + ai * HALF + m * 16) * ldc + col0; const float r = SCALE ? rs[ai][m] : 1.f;
#pragma unroll
                for (int bj = 0; bj < 2; ++bj) { f32x4 v0 = acc[ai][bj][m][0] * r, v1 = acc[ai][bj][m][1] * r;
                    if (ACT == 1) {
#pragma unroll
                        for (int e = 0; e < 4; ++e) { v0[e] = fmaxf(v0[e], 0.f); v0[e] *= v0[e]; v1[e] = fmaxf(v1[e], 0.f); v1[e] *= v1[e]; } }
                    u32x4 w; w.x = cvtpk(v0[0], v0[1]); w.y = cvtpk(v0[2], v0[3]); w.z = cvtpk(v1[0], v1[1]); w.w = cvtpk(v1[2], v1[3]);
                    *(u32x4*)(rowp + bj * HALF) = w; } }
    }
};
template <bool GATE  , bool FINAL  , bool SQ = false  >
struct EpiH {
    static constexpr bool PERM = true, AFTER_DRAIN = false;
    const bf16_t* hin; bf16_t* hout; float* sspo; const bf16_t* pp; const float* sspi; float* outf;
    __device__ __forceinline__ void operator()(const f32x4 (&acc)[2][2][4][2], const Unit& u, int wr, int wc, int fr, int fq) const {
        constexpr int ld = 2048;
        const int row0 = u.pm * BM + wr * 64 + fr, col0 = u.pn * BM + wc * 32 + 8 * fq;
        float rs[2][4];
        u32x4 rh[2][2], rp[2][2];
        { const size_t off = (size_t)row0 * ld + col0;
#pragma unroll
          for (int bj = 0; bj < 2; ++bj) { rh[0][bj] = *(const u32x4*)(hin + off + bj * HALF); if (GATE) rp[0][bj] = *(const u32x4*)(pp + off + bj * HALF); } }
        if (GATE || SQ) row_rstd(sspi, u.pm * BM + wr * 64, fr, fq, rs);
#pragma unroll
        for (int r = 0; r < 8; ++r) { const int ai = r >> 2, m = r & 3, cb = r & 1, nb = cb ^ 1;
            const int row = row0 + ai * HALF + m * 16; const size_t off = (size_t)row * ld + col0;
            if (r + 1 < 8) { const int ai2 = (r + 1) >> 2, m2 = (r + 1) & 3; const size_t off2 = (size_t)(row0 + ai2 * HALF + m2 * 16) * ld + col0;
#pragma unroll
                for (int bj = 0; bj < 2; ++bj) { rh[nb][bj] = *(const u32x4*)(hin + off2 + bj * HALF); if (GATE) rp[nb][bj] = *(const u32x4*)(pp + off2 + bj * HALF); } }
            float ss = 0.f;
#pragma unroll
            for (int bj = 0; bj < 2; ++bj) { const u32x4 hv = rh[cb][bj];
                f32x4 a = {bflo(hv.x), bfhi(hv.x), bflo(hv.y), bfhi(hv.y)}, b = {bflo(hv.z), bfhi(hv.z), bflo(hv.w), bfhi(hv.w)};
                const f32x4 v0 = acc[ai][bj][m][0], v1 = acc[ai][bj][m][1];
                if (GATE) { const u32x4 p = rp[cb][bj]; const float rr = rs[ai][m] * (-LOG2E);
                    const f32x4 p0 = {bflo(p.x), bfhi(p.x), bflo(p.y), bfhi(p.y)}, p1 = {bflo(p.z), bfhi(p.z), bflo(p.w), bfhi(p.w)};
#pragma unroll
                    for (int e = 0; e < 4; ++e) { a[e] += __builtin_amdgcn_rcpf(1.f + fexp2(rr * v0[e])) * p0[e]; b[e] += __builtin_amdgcn_rcpf(1.f + fexp2(rr * v1[e])) * p1[e]; }
                } else if (SQ) { const float r2 = rs[ai][m] * rs[ai][m]; a += v0 * r2; b += v1 * r2; }
                else { a += v0; b += v1; }
                if (FINAL) { *(f32x4*)(outf + off + bj * HALF) = a; *(f32x4*)(outf + off + bj * HALF + 4) = b; }
                else { u32x4 w; w.x = cvtpk(a[0], a[1]); w.y = cvtpk(a[2], a[3]); w.z = cvtpk(b[0], b[1]); w.w = cvtpk(b[2], b[3]);
                    *(u32x4*)(hout + off + bj * HALF) = w;
                    ss += (a[0] * a[0] + a[1] * a[1]) + (a[2] * a[2] + a[3] * a[3]) + (b[0] * b[0] + b[1] * b[1]) + (b[2] * b[2] + b[3] * b[3]); } }
            if (!FINAL) { ss += __shfl_xor(ss, 16); ss += __shfl_xor(ss, 32);
                if (fq == 0) sspo[(size_t)row * 32 + u.pn * 4 + wc] = ss; } }
    }
};
}

struct Args { const float* in[21]; float* out; unsigned char* ws; };
enum { I_X = 0, I_P, I_ATTN_NORM, I_WO, I_MLP_NORM, I_WUP, I_WDOWN, I_PLE_NORM, I_WGATE, I_WPLE, I_A_WIN, I_A_QN, I_A_KN, I_B_WIN, I_B_QN, I_B_KN, I_B_IKN, I_C_WIN, I_C_BF, I_C_QN, I_C_KN };

__device__ __forceinline__ void transpose_item(const float* W, const float* gain, int K, int N, bf16* WT, int kb, int nb, int lane) {
    const int k0 = 64 * kb, n = 64 * nb + lane; const bool ok = n < N;
    const float* src = W + (size_t)k0 * N + (ok ? n : 0);
    float v[64];
#pragma unroll
    for (int r = 0; r < 64; ++r) v[r] = src[(size_t)r * N];
    if (gain) {
#pragma unroll
        for (int r = 0; r < 64; ++r) v[r] *= gain[k0 + r];
    }
    bf16* dst = WT + (size_t)n * K + k0;
#pragma unroll
    for (int c = 0; c < 8; ++c) { v4u o;
        o.x = ok ? cvtpk(v[8 * c + 0], v[8 * c + 1]) : 0u; o.y = ok ? cvtpk(v[8 * c + 2], v[8 * c + 3]) : 0u; o.z = ok ? cvtpk(v[8 * c + 4], v[8 * c + 5]) : 0u; o.w = ok ? cvtpk(v[8 * c + 6], v[8 * c + 7]) : 0u;
        *(v4u*)(dst + 8 * c) = o; }
}
__device__ __forceinline__ void convert_weight(const float* W, const float* gain, int K, int N, int Npad, bf16* WT, LAS float* scr, int gw, int ngw, int lane) {
    const int nblk = Npad / 64, nitems = (K / 64) * nblk;
    for (int it = gw; it < nitems; it += ngw) transpose_item(W, gain, K, N, WT, it / nblk, it % nblk, lane);
}
__device__ __forceinline__ void x_rows(const float* src, bf16* hb, float* ssp, int gw, int ngw, int lane) {
    for (int m = gw; m < M; m += ngw) {
        const f32x4* xr = (const f32x4*)(src + (size_t)m * D) + lane;
        f32x4 v[8]; float ss = 0.f;
#pragma unroll
        for (int j = 0; j < 8; ++j) { v[j] = xr[64 * j]; ss += (v[j].x * v[j].x + v[j].y * v[j].y) + (v[j].z * v[j].z + v[j].w * v[j].w); }
        ss = wave_sum(ss);
        unsigned long long* o8 = (unsigned long long*)(hb + (size_t)m * D) + lane;
#pragma unroll
        for (int j = 0; j < 8; ++j) o8[64 * j] = (unsigned long long)cvtpk(v[j].x, v[j].y) | ((unsigned long long)cvtpk(v[j].z, v[j].w) << 32);
        if (lane < 32) ssp[(size_t)m * 32 + lane] = lane == 0 ? ss : 0.f;
    }
}

__device__ __forceinline__ void rmsnorm_rows(const float* src, const float* g, bf16* dst, int gw, int ngw, int lane) {
    for (int m = gw; m < M; m += ngw) {
        const f32x4* xr = (const f32x4*)(src + (size_t)m * D) + lane;
        f32x4 v[8]; float ss = 0.f;
#pragma unroll
        for (int j = 0; j < 8; ++j) { v[j] = xr[64 * j]; ss += (v[j].x * v[j].x + v[j].y * v[j].y) + (v[j].z * v[j].z + v[j].w * v[j].w); }
        const float rstd = 1.f / sqrtf(wave_sum(ss) * (1.f / D) + RMS_EPS);
        unsigned long long* o8 = (unsigned long long*)(dst + (size_t)m * D) + lane;
#pragma unroll
        for (int j = 0; j < 8; ++j) { const f32x4 gg = ((const f32x4*)g)[lane + 64 * j];
            o8[64 * j] = (unsigned long long)cvtpk(v[j].x * rstd * gg.x, v[j].y * rstd * gg.y) | ((unsigned long long)cvtpk(v[j].z * rstd * gg.z, v[j].w * rstd * gg.w) << 32); }
    }
}

template <bool ROPE>
__device__ __forceinline__ void head128_norm(bf16* p, const u32x4 raw, const float a  , const float* gain, float scale, const float2* rope, int lane, unsigned char* f8out = nullptr) {
    float x[8] = {bflo(raw.x), bfhi(raw.x), bflo(raw.y), bfhi(raw.y), bflo(raw.z), bfhi(raw.z), bflo(raw.w), bfhi(raw.w)};
    float ss = 0.f;
#pragma unroll
    for (int e = 0; e < 8; ++e) ss += x[e] * x[e];
    ss += __shfl_xor(ss, 1); ss += __shfl_xor(ss, 2); ss += __shfl_xor(ss, 4); ss += __shfl_xor(ss, 8);
    const float rstd = a / sqrtf(a * a * ss * (1.f / 128.f) + RMS_EPS);
    const int lh = lane & 15;
    const f32x4 g0 = *(const f32x4*)(gain + 8 * lh), g1 = *(const f32x4*)(gain + 8 * lh + 4);
    const float gg[8] = {g0.x, g0.y, g0.z, g0.w, g1.x, g1.y, g1.z, g1.w};
#pragma unroll
    for (int e = 0; e < 8; ++e) x[e] = x[e] * rstd * gg[e];
    if (ROPE) {
        float px[8];
#pragma unroll
        for (int e = 0; e < 8; ++e) px[e] = __shfl_xor(x[e], 2);
        if (lh < 4) {
#pragma unroll
            for (int e = 0; e < 8; ++e) { const float2 cs = rope[8 * (lh & 1) + e];
                x[e] = (lh < 2) ? (x[e] * cs.x - px[e] * cs.y) : (px[e] * cs.y + x[e] * cs.x); }
        }
    }
    if (f8out) {
        int w0 = 0, w1 = 0;
        w0 = __builtin_amdgcn_cvt_pk_fp8_f32(x[0] * scale, x[1] * scale, w0, false); w0 = __builtin_amdgcn_cvt_pk_fp8_f32(x[2] * scale, x[3] * scale, w0, true);
        w1 = __builtin_amdgcn_cvt_pk_fp8_f32(x[4] * scale, x[5] * scale, w1, false); w1 = __builtin_amdgcn_cvt_pk_fp8_f32(x[6] * scale, x[7] * scale, w1, true);
        *(u32x2*)f8out = (u32x2){(unsigned)w0, (unsigned)w1};
    } else {
        u32x4 w; w.x = cvtpk(x[0] * scale, x[1] * scale); w.y = cvtpk(x[2] * scale, x[3] * scale); w.z = cvtpk(x[4] * scale, x[5] * scale); w.w = cvtpk(x[6] * scale, x[7] * scale);
        *(u32x4*)p = w;
    }
}
template <bool NORM>
__device__ __forceinline__ void head64_rope(bf16* p, const u32x4 raw, const float a, const float* gain, const float2* rope, int lane, bool active) {
    float x[8] = {bflo(raw.x) * a, bfhi(raw.x) * a, bflo(raw.y) * a, bfhi(raw.y) * a, bflo(raw.z) * a, bfhi(raw.z) * a, bflo(raw.w) * a, bfhi(raw.w) * a};
    const int li = lane & 7;
    if (NORM) {
        float ss = 0.f;
#pragma unroll
        for (int e = 0; e < 8; ++e) ss += x[e] * x[e];
        ss += __shfl_xor(ss, 1); ss += __shfl_xor(ss, 2); ss += __shfl_xor(ss, 4);
        const float rstd = 1.f / sqrtf(ss * (1.f / 64.f) + RMS_EPS);
        const f32x4 g0 = *(const f32x4*)(gain + 8 * li), g1 = *(const f32x4*)(gain + 8 * li + 4);
        const float gg[8] = {g0.x, g0.y, g0.z, g0.w, g1.x, g1.y, g1.z, g1.w};
#pragma unroll
        for (int e = 0; e < 8; ++e) x[e] = x[e] * rstd * gg[e];
    }
    float px[8];
#pragma unroll
    for (int e = 0; e < 8; ++e) px[e] = __shfl_xor(x[e], 1);
    if (li < 2) {
#pragma unroll
        for (int e = 0; e < 8; ++e) { const float2 cs = rope[e];
            x[e] = (li == 0) ? (x[e] * cs.x - px[e] * cs.y) : (px[e] * cs.y + x[e] * cs.x); }
    }
    if (active) { u32x4 w; w.x = cvtpk(x[0], x[1]); w.y = cvtpk(x[2], x[3]); w.z = cvtpk(x[4], x[5]); w.w = cvtpk(x[6], x[7]); *(u32x4*)p = w; }
}

__device__ __forceinline__ void vt_item(const bf16* proj, int ldp, int voff, const float* rstdv, bf16* VT, LAS unsigned char* tile, int item, int lane) {
    const int h = item & 15, tc = (item >> 4) & 255, b = item >> 12;
    const size_t row0 = (size_t)b * SEQ + 32 * tc;
#pragma unroll
    for (int i = 0; i < 8; ++i) { const int tok = 4 * i + (lane >> 4), ch = lane & 15;
        const u32x4 v = *(const u32x4*)(proj + (row0 + tok) * ldp + voff + h * 128 + ch * 8); const float a = rstdv[row0 + tok];
        LAS u32x2* d = (LAS u32x2*)(tile + tok * 264 + ch * 16);
        d[0] = (u32x2){cvtpk(bflo(v.x) * a, bfhi(v.x) * a), cvtpk(bflo(v.y) * a, bfhi(v.y) * a)}; d[1] = (u32x2){cvtpk(bflo(v.z) * a, bfhi(v.z) * a), cvtpk(bflo(v.w) * a, bfhi(v.w) * a)}; }
    LDS_WAIT(); asm volatile("" ::: "memory");
#pragma unroll
    for (int i = 0; i < 8; ++i) { const int d = 16 * i + (lane >> 2), tg = lane & 3;
        const LAS unsigned short* s = (const LAS unsigned short*)(tile + (8 * tg) * 264 + d * 2);
        u32x4 w; w.x = (unsigned)s[0] | ((unsigned)s[132] << 16); w.y = (unsigned)s[2 * 132] | ((unsigned)s[3 * 132] << 16);
        w.z = (unsigned)s[4 * 132] | ((unsigned)s[5 * 132] << 16); w.w = (unsigned)s[6 * 132] | ((unsigned)s[7 * 132] << 16);
        *(u32x4*)(VT + ((size_t)(b * 16 + h) * 128 + d) * SEQ + 32 * tc + 8 * tg) = w; }
    LDS_WAIT(); asm volatile("" ::: "memory");
}

__device__ __forceinline__ void cumchunk_item(const bf16* proj, int ldp, const float* rstdv, const float* bfv, float* cum2, float* tot, int item, int lane) {
    const int b = item >> 7, ch = item & 127; const int t = 64 * ch + lane;
    const bf16* gp = proj + ((size_t)b * SEQ + t) * ldp + 3 * D;
    const u32x4 g0 = *(const u32x4*)gp, g1 = *(const u32x4*)(gp + 8);
    const float x[16] = {bflo(g0.x), bfhi(g0.x), bflo(g0.y), bfhi(g0.y), bflo(g0.z), bfhi(g0.z), bflo(g0.w), bfhi(g0.w), bflo(g1.x), bfhi(g1.x), bflo(g1.y), bfhi(g1.y), bflo(g1.z), bfhi(g1.z), bflo(g1.w), bfhi(g1.w)};
    const float a = rstdv[(size_t)b * SEQ + t];
#pragma unroll
    for (int h = 0; h < 16; ++h) { const float y = x[h] * a + bfv[h];
        float lf = -(fmaxf(-y, 0.f) + log1pf(expf(-fabsf(y)))) * LOG2E;
#pragma unroll
        for (int o = 1; o < 64; o <<= 1) { const float u = __shfl_up(lf, o); if (lane >= o) lf += u; }
        cum2[((size_t)(b * 16 + h)) * SEQ + t] = lf;
        if (lane == 63) tot[(b * 16 + h) * 128 + ch] = lf; }
}

#define MFMA32(a, b, c) __builtin_amdgcn_mfma_f32_32x32x16_bf16((a), (b), (c), 0, 0, 0)
#define MFMA16(a, b, c) __builtin_amdgcn_mfma_f32_16x16x32_bf16((a), (b), (c), 0, 0, 0)
template <int MODE>
__device__ __forceinline__ void attn_dense_item(const bf16* proj, int ldp, const bf16* VT, const float* cum2, bf16* mix, float zb2, int qt, int bh, int lane) {
    const int b = bh >> 4, h = bh & 15;
    const int n = lane & 31, hi = lane >> 5, q0 = 32 * qt;
    const size_t row0 = (size_t)b * SEQ;
    const int prow = (n & 0x13) | ((n & 4) << 1) | ((n & 8) >> 1);
    bf16x8 qf[8];
    { const bf16* qp = proj + (row0 + q0 + n) * ldp + h * 128 + hi * 8;
#pragma unroll
      for (int kk = 0; kk < 8; ++kk) qf[kk] = *(const bf16x8*)(qp + kk * 16); }
    f32x16 o[4];
#pragma unroll
    for (int d = 0; d < 4; ++d)
#pragma unroll
        for (int i = 0; i < 16; ++i) o[d][i] = 0.f;
    float R = 0.f, mrun = -1e30f, lrun = 0.f, cq = 0.f;
    const float* cb = cum2 + (size_t)bh * SEQ;
    if (MODE == 1) cq = cb[q0 + n];
    const int tq = q0 + n;
    const bf16* kbase = proj + (row0 + prow) * ldp + D + h * 128 + hi * 8;
    bf16x8 kf[8];
#pragma unroll
    for (int kk = 0; kk < 8; ++kk) kf[kk] = *(const bf16x8*)(kbase + (size_t)q0 * ldp + kk * 16);
    for (int kb = q0; kb >= 0; kb -= 32) {
        if (MODE == 0) { if (__all(R + zb2 < ZERO_LOG2)) break; }
        else { const float dmax = cb[q0] - cb[kb + 31]; if (dmax + 2.f * zb2 < ZERO_LOG2) break; }
        bf16x8 vf[4][2];
#pragma unroll
        for (int d = 0; d < 4; ++d)
#pragma unroll
            for (int s = 0; s < 2; ++s) vf[d][s] = *(const bf16x8*)(VT + ((size_t)bh * 128 + d * 32 + n) * SEQ + kb + 16 * s + 8 * hi);
        f32x16 sc;
#pragma unroll
        for (int i = 0; i < 16; ++i) sc[i] = 0.f;
#pragma unroll
        for (int kk = 0; kk < 8; ++kk) sc = MFMA32(kf[kk], qf[kk], sc);
        if (kb >= 32) {
#pragma unroll
            for (int kk = 0; kk < 8; ++kk) kf[kk] = *(const bf16x8*)(kbase + (size_t)(kb - 32) * ldp + kk * 16);
        }
        const bool diag = (kb == q0);
        float w[16];
        if (MODE == 0) {
            float L[16];
#pragma unroll
            for (int i = 0; i < 16; ++i) { const int key = kb + 16 * (i >> 3) + 8 * hi + (i & 7);
                const bool valid = !diag || (key < tq);
                L[i] = valid ? -flog2(1.f + fexp2(sc[i])) : 0.f; }
            float G0 = 0.f, G1 = 0.f;
#pragma unroll
            for (int j = 0; j < 8; ++j) { G0 += L[j]; G1 += L[8 + j]; }
            const float Gp0 = __shfl_xor(G0, 32), Gp1 = __shfl_xor(G1, 32);
            const float pre1 = hi ? R : (R + Gp1);
            const float pre0 = hi ? (R + G1 + Gp1) : (R + Gp1 + G1 + Gp0);
            float c = pre1;
#pragma unroll
            for (int j = 7; j >= 0; --j) { c += L[8 + j]; const int key = kb + 16 + 8 * hi + j; w[8 + j] = (!diag || key < tq) ? fexp2(sc[8 + j] + c) : 0.f; }
            c = pre0;
#pragma unroll
            for (int j = 7; j >= 0; --j) { c += L[j]; const int key = kb + 8 * hi + j; w[j] = (!diag || key < tq) ? fexp2(sc[j] + c) : 0.f; }
            R += (G0 + G1) + (Gp0 + Gp1);
        } else {
            float lg[16]; float bm = -3e38f;
#pragma unroll
            for (int s = 0; s < 2; ++s) { const f32x4 c0 = *(const f32x4*)(cb + kb + 16 * s + 8 * hi), c1 = *(const f32x4*)(cb + kb + 16 * s + 8 * hi + 4);
                const float ck[8] = {c0.x, c0.y, c0.z, c0.w, c1.x, c1.y, c1.z, c1.w};
#pragma unroll
                for (int j = 0; j < 8; ++j) { const int i = 8 * s + j, key = kb + 16 * s + 8 * hi + j;
                    const float v = sc[i] + (cq - ck[j]);
                    lg[i] = (!diag || key <= tq) ? v : -3e38f; bm = fmaxf(bm, lg[i]); } }
            bm = fmaxf(bm, __shfl_xor(bm, 32));
            const float mn = fmaxf(mrun, bm), alpha = fexp2(mrun - mn);
            mrun = mn;
            float ps = 0.f;
#pragma unroll
            for (int i = 0; i < 16; ++i) { w[i] = fexp2(lg[i] - mn); ps += w[i]; }
            lrun = lrun * alpha + ps;
#pragma unroll
            for (int d = 0; d < 4; ++d)
#pragma unroll
                for (int i = 0; i < 16; ++i) o[d][i] *= alpha;
        }
        bf16x8 pf[2];
#pragma unroll
        for (int s = 0; s < 2; ++s) { u32x4 t; t.x = cvtpk(w[8 * s + 0], w[8 * s + 1]); t.y = cvtpk(w[8 * s + 2], w[8 * s + 3]); t.z = cvtpk(w[8 * s + 4], w[8 * s + 5]); t.w = cvtpk(w[8 * s + 6], w[8 * s + 7]);
            pf[s] = __builtin_bit_cast(bf16x8, t); }
#pragma unroll
        for (int d = 0; d < 4; ++d)
#pragma unroll
            for (int s = 0; s < 2; ++s) o[d] = MFMA32(vf[d][s], pf[s], o[d]);
    }
    float inv = 1.f;
    if (MODE == 1) { const float lt = lrun + __shfl_xor(lrun, 32); inv = 1.f / lt; }
    bf16* op = mix + (row0 + q0 + n) * (size_t)D + h * 128 + 4 * hi;
#pragma unroll
    for (int d = 0; d < 4; ++d)
#pragma unroll
        for (int g = 0; g < 4; ++g) { u32x2 t; t.x = cvtpk(o[d][4 * g] * inv, o[d][4 * g + 1] * inv); t.y = cvtpk(o[d][4 * g + 2] * inv, o[d][4 * g + 3] * inv);
            *(u32x2*)(op + d * 32 + 8 * g) = t; }
}

constexpr int DL_SEL = 0, DL_MISC = 16384, DL_HIST = 17408, DL_CAND = DL_HIST + 8 * 8192, DL_P = DL_CAND + 8 * 512, DL_INVL = DL_P + 8 * 4096, DL_MM = DL_INVL + 8 * 16, DL_END = DL_MM + 8 * 128;
static_assert(DL_END <= RING_BYTES, "DSA LDS map");
constexpr int NBIN = 2048;

__device__ __forceinline__ int tk_bin(float x, float lo, float inv) { int bb = (int)((x - lo) * inv); return bb > NBIN - 1 ? NBIN - 1 : (bb < 0 ? 0 : bb); }
__device__ __forceinline__ void topk_row(const float* S, int c, float lo, float hi  , LAS unsigned short* sel, LAS unsigned* hist, LAS float* cval, LAS int* cidx, int lane) {
    const f32x4* S4 = (const f32x4*)S; const int c4 = c >> 2;
    int kk = 256, mc = c;
    bool usebin = false; float blo = 0.f, binv = 0.f; int bsel = 0;
    for (int level = 0; level < 48; ++level) {
        if (lo == hi || mc <= 64) break;
#pragma unroll
        for (int j = 0; j < NBIN / 64; ++j) hist[lane + 64 * j] = 0u;
        const float inv = (float)NBIN / (hi - lo);
        f32x4 vbn[8];
#define TK_LD(I0) do { _Pragma("unroll") for (int u = 0; u < 8; ++u) { const int i = (I0) + 64 * u + lane; vbn[u] = S4[i < c4 ? i : lane]; } } while (0)
        TK_LD(0);
        for (int i0 = 0; i0 < c4; i0 += 512) { f32x4 vb[8];
#pragma unroll
            for (int u = 0; u < 8; ++u) vb[u] = vbn[u];
            if (i0 + 512 < c4) TK_LD(i0 + 512);
#pragma unroll
            for (int u = 0; u < 8; ++u) { const bool inr = (i0 + 64 * u + lane) < c4;
#pragma unroll
                for (int e = 0; e < 4; ++e) { const float x = vb[u][e]; if (inr && x >= lo && x <= hi) __hip_atomic_fetch_add(&hist[tk_bin(x, lo, inv)], 1u, __ATOMIC_RELAXED, __HIP_MEMORY_SCOPE_WORKGROUP); } } }
#undef TK_LD
        LDS_WAIT(); asm volatile("" ::: "memory");
        unsigned own = 0u;
#pragma unroll
        for (int j = 0; j < 32; ++j) own += hist[32 * lane + j];
        unsigned suf = own;
#pragma unroll
        for (int o = 1; o < 64; o <<= 1) { const unsigned u = __shfl_down(suf, o); if (lane + o < 64) suf += u; }
        const unsigned long long pm = __ballot(suf >= (unsigned)kk);
        const int Ln = 63 - __builtin_clzll(pm);
        const unsigned above = __shfl(suf - own, Ln);
        const int k2 = kk - (int)above;
        int bs = 0, kn = 1, mn = 1;
        { unsigned acc = 0u; bool found = false;
          for (int j = 31; j >= 0; --j) { const unsigned hc = hist[32 * Ln + j]; if (!found && acc + hc >= (unsigned)k2) { bs = 32 * Ln + j; kn = k2 - (int)acc; mn = (int)hc; found = true; } if (!found) acc += hc; } }
        kk = kn; mc = mn;
        if (mc <= 64) { usebin = true; blo = lo; binv = inv; bsel = bs; break; }
        float nlo = 3e38f, nhi = -3e38f;
        for (int i0 = 0; i0 < c4; i0 += 256) { f32x4 vb[4];
#pragma unroll
            for (int u = 0; u < 4; ++u) { const int i = i0 + 64 * u + lane; vb[u] = S4[i < c4 ? i : lane]; }
#pragma unroll
            for (int u = 0; u < 4; ++u) { const bool inr = (i0 + 64 * u + lane) < c4;
#pragma unroll
                for (int e = 0; e < 4; ++e) { const float x = vb[u][e]; if (inr && x >= lo && x <= hi && tk_bin(x, lo, inv) == bs) { nlo = fminf(nlo, x); nhi = fmaxf(nhi, x); } } } }
        lo = wave_min(nlo); hi = wave_max(nhi);
    }
    const bool tie = !usebin && (lo == hi);
    const int base = 256 - kk;
    int nout = 0, ncand = 0;
    const unsigned long long ltmask = (1ull << lane) - 1ull;
    f32x4 vfn[8];
#define TK_LDF(J0) do { _Pragma("unroll") for (int u = 0; u < 8; ++u) { const int i = (J0) + 64 * u + lane; vfn[u] = S4[i < c4 ? i : lane]; } } while (0)
    TK_LDF(0);
    for (int j0 = 0; j0 < c4; j0 += 512) { f32x4 vb[8];
#pragma unroll
      for (int u = 0; u < 8; ++u) vb[u] = vfn[u];
      if (j0 + 512 < c4) TK_LDF(j0 + 512);
#pragma unroll
      for (int u = 0; u < 8; ++u) { const int i4 = j0 + 64 * u; if (i4 >= c4) break;
        bool gt[4], cd[4]; int glow = 0, clow = 0, gtot = 0, ctot = 0;
#pragma unroll
        for (int e = 0; e < 4; ++e) { const float x = vb[u][e]; const bool inr = (x >= lo) && (x <= hi);
            if (usebin) { const int bb = tk_bin(x, blo, binv); gt[e] = (x > hi) || (inr && bb > bsel); cd[e] = inr && bb == bsel; }
            else { gt[e] = x > hi; cd[e] = inr; }
            const unsigned long long gm = __ballot(gt[e]), cm = __ballot(cd[e]);
            glow += __builtin_popcountll(gm & ltmask); gtot += __builtin_popcountll(gm); clow += __builtin_popcountll(cm & ltmask); ctot += __builtin_popcountll(cm); }
        int gpos = nout + glow, cpos = ncand + clow;
#pragma unroll
        for (int e = 0; e < 4; ++e) { const int idx = 4 * (i4 + lane) + e;
            if (gt[e]) { if (gpos < 256) sel[gpos] = (unsigned short)idx; ++gpos; }
            if (cd[e]) { if (tie) { if (cpos < kk) sel[base + cpos] = (unsigned short)idx; } else if (cpos < 64) { cval[cpos] = vb[u][e]; cidx[cpos] = idx; } ++cpos; } }
        nout += gtot; ncand += ctot;
      } }
    if (!tie) {
        LDS_WAIT(); asm volatile("" ::: "memory");
        const int nc = ncand < 64 ? ncand : 64;
        const float mv = lane < nc ? cval[lane] : 0.f; const int mi = lane < nc ? cidx[lane] : 0;
        int rank = 0;
        for (int i = 0; i < nc; ++i) { const float v = cval[i]; rank += (v > mv || (v == mv && i < lane)) ? 1 : 0; }
        if (lane < nc && rank < kk) sel[base + rank] = (unsigned short)mi;
    }
    LDS_WAIT(); asm volatile("" ::: "memory");
}

__device__ __forceinline__ void dsa_unit(const bf16* proj, const unsigned char* q8, const unsigned char* k8, const unsigned char* v8, bf16* mix, float* scr, LAS unsigned char* lds, int unit, int tid) {
    constexpr int ldp = NB_PAD;
    const int lane = tid & 63, wave = __builtin_amdgcn_readfirstlane(tid >> 6);
    const int tile = 255 - (unit >> 2), b = unit & 3, t0 = 32 * tile, c = ((t0 >> 6) + 1) << 6;
    const size_t row0 = (size_t)b * SEQ;
    LAS unsigned short* sel = (LAS unsigned short*)(lds + DL_SEL);
#ifdef PROBE_DSA
    unsigned long long td0_ = __builtin_amdgcn_s_memrealtime();
#define DSA_PT(st) do { const unsigned long long n_ = __builtin_amdgcn_s_memrealtime(); if (tid == 0 && (st) == PROBE_DSA) { volatile LAS unsigned long long* pe_ = (volatile LAS unsigned long long*)(lds + MISC_OFF + 64); pe_[0] = pe_[0] + (n_ - td0_); } td0_ = n_; } while (0)
#else
#define DSA_PT(st) do { } while (0)
#endif
#ifndef DSA_NO_A
    if (c > 256) {
        int lane_a = lane; asm volatile("" : "+v"(lane_a));
        const int qg = wave & 1, kpart = wave >> 1, ql = lane_a & 15, kq = lane_a >> 4;
        const bf16* qrow = proj + (row0 + t0 + 16 * qg + ql) * ldp;
#pragma unroll 1
        for (int hp = 0; hp < 2; ++hp) {
            bf16x8 qif[8][2];
#pragma unroll
            for (int hh = 0; hh < 8; ++hh)
#pragma unroll
                for (int kk = 0; kk < 2; ++kk) qif[hh][kk] = *(const bf16x8*)(qrow + B_QI + (8 * hp + hh) * 64 + kk * 32 + kq * 8);
            float wv[8];
            { const u32x4 w0 = *(const u32x4*)(qrow + B_WI + 8 * hp);
              wv[0] = bflo(w0.x); wv[1] = bfhi(w0.x); wv[2] = bflo(w0.y); wv[3] = bfhi(w0.y); wv[4] = bflo(w0.z); wv[5] = bfhi(w0.z); wv[6] = bflo(w0.w); wv[7] = bfhi(w0.w); }
            bf16x8 kring[3][2][2]; f32x4 sring[3][2];
            const bf16* kibase = proj + (row0 + ql) * ldp + B_KI + kq * 8;
            float* sbase = scr + (size_t)(16 * qg + ql) * c + 4 * kq;
#define IDX_LOAD(SL, KB0) do { _Pragma("unroll") for (int u = 0; u < 2; ++u) { const int kb = (KB0) + 64 * u; const int kbc = kb < c ? kb : 16 * kpart; \
                    const bf16* kr = kibase + (size_t)kbc * ldp; \
                    kring[SL][u][0] = *(const bf16x8*)kr; kring[SL][u][1] = *(const bf16x8*)(kr + 32); \
                    sring[SL][u] = (f32x4){0.f, 0.f, 0.f, 0.f}; \
                    if (hp) sring[SL][u] = *(const f32x4*)(sbase + kbc); } } while (0)
#define IDX_COMP(SL, KB0) do { _Pragma("unroll") for (int u = 0; u < 2; ++u) { const int kb = (KB0) + 64 * u; \
                    if (kb < c) { f32x2_t s01 = {sring[SL][u][0], sring[SL][u][1]}, s23 = {sring[SL][u][2], sring[SL][u][3]}; \
                        _Pragma("unroll") for (int hh = 0; hh < 8; ++hh) { f32x4 d = {0.f, 0.f, 0.f, 0.f}; d = MFMA16(kring[SL][u][0], qif[hh][0], d); d = MFMA16(kring[SL][u][1], qif[hh][1], d); \
                            const f32x2_t w2 = {wv[hh], wv[hh]}; \
                            s01 = __builtin_elementwise_fma((f32x2_t){relu_raw(d[0]), relu_raw(d[1])}, w2, s01); s23 = __builtin_elementwise_fma((f32x2_t){relu_raw(d[2]), relu_raw(d[3])}, w2, s23); } \
                        const f32x4 sacc = {s01.x, s01.y, s23.x, s23.y}; \
                        *(f32x4*)(sbase + kb) = sacc; \
                        smin = fminf(smin, fminf(fminf(sacc[0], sacc[1]), fminf(sacc[2], sacc[3]))); smax = fmaxf(smax, fmaxf(fmaxf(sacc[0], sacc[1]), fmaxf(sacc[2], sacc[3]))); } } } while (0)
            float smin = 3e38f, smax = -3e38f;
            const int kbs = 16 * kpart;
            IDX_LOAD(0, kbs); IDX_LOAD(1, kbs + 128);
#pragma unroll 1
            for (int kb0 = kbs; kb0 < c; kb0 += 384) {
                IDX_LOAD(2, kb0 + 256); IDX_COMP(0, kb0);
                IDX_LOAD(0, kb0 + 384); IDX_COMP(1, kb0 + 128);
                IDX_LOAD(1, kb0 + 512); IDX_COMP(2, kb0 + 256);
            }
#undef IDX_COMP
#undef IDX_LOAD
            if (hp) {
                smin = fminf(smin, __shfl_xor(smin, 16)); smin = fminf(smin, __shfl_xor(smin, 32)); smax = fmaxf(smax, __shfl_xor(smax, 16)); smax = fmaxf(smax, __shfl_xor(smax, 32));
                if (lane < 16) { LAS float* mm = (LAS float*)(lds + DL_MM) + (wave * 16 + lane) * 2; mm[0] = smin; mm[1] = smax; }
            }
        }
    }
#endif
    __syncthreads(); DSA_PT(0);
    __builtin_amdgcn_fence(__ATOMIC_ACQUIRE, "agent");
    asm volatile("s_waitcnt vmcnt(0)" ::: "memory");
#ifndef DSA_NO_B
    LAS int* nselp = (LAS int*)(lds + DL_MISC);
    for (int qi = 0; qi < 4; ++qi) { const int ql = 4 * wave + qi;
        LAS unsigned short* s = sel + ql * 256;
        if (c > 256) { const LAS float* mm = (const LAS float*)(lds + DL_MM);
            float lo = 3e38f, hi = -3e38f;
#pragma unroll
            for (int kp = 0; kp < 4; ++kp) { const int w2 = (ql >> 4) + 2 * kp; lo = fminf(lo, mm[(w2 * 16 + (ql & 15)) * 2]); hi = fmaxf(hi, mm[(w2 * 16 + (ql & 15)) * 2 + 1]); }
            topk_row(scr + (size_t)ql * c, c, lo, hi, s, (LAS unsigned*)(lds + DL_HIST + wave * 8192), (LAS float*)(lds + DL_CAND + wave * 512), (LAS int*)(lds + DL_CAND + wave * 512 + 256), lane); }
        else { for (int i = lane; i < c; i += 64) s[i] = (unsigned short)i; }
    }
#endif
    const int nsel = c > 256 ? 256 : c;
    LDS_WAIT(); asm volatile("" ::: "memory"); DSA_PT(1);
#ifndef DSA_NO_C
    LAS unsigned short* Pb = (LAS unsigned short*)(lds + DL_P + wave * 4096);
    LAS unsigned char* vt = lds + DL_HIST + wave * 8192;
    LAS float* invl = (LAS float*)(lds + DL_INVL + wave * 16);
    for (int pi = 0; pi < 16; ++pi) { const int pr = 16 * wave + pi, ql = pr >> 2, g = pr & 3;
        const LAS unsigned short* s = sel + ql * 256;
        const size_t qrow = row0 + t0 + ql;
        int lane_c = lane; asm volatile("" : "+v"(lane_c));
        const int r = lane_c & 15, kq = lane_c >> 4;
        long qf[4];
#pragma unroll
        for (int kk = 0; kk < 4; ++kk) { qf[kk] = 0; if (r < 4) qf[kk] = *(const long*)(q8 + qrow * 2048 + (g * 4 + r) * 128 + kq * 32 + kk * 8); }
        f32x4 lg[16]; float mx = -3e38f;
#pragma unroll
        for (int g8 = 0; g8 < 2; ++g8) {
            if (g8 * 128 < nsel) {
                long kfr[8][4];
#pragma unroll
                for (int u = 0; u < 8; ++u) { const int key = ((g8 * 128 + u * 16) < nsel) ? s[g8 * 128 + u * 16 + r] : 0;
                    const unsigned char* kr = k8 + (row0 + key) * 512 + g * 128 + kq * 32;
                    const u32x4 ka = *(const u32x4*)kr, kb2 = *(const u32x4*)(kr + 16);
                    kfr[u][0] = (long)(((unsigned long long)ka.y << 32) | ka.x); kfr[u][1] = (long)(((unsigned long long)ka.w << 32) | ka.z);
                    kfr[u][2] = (long)(((unsigned long long)kb2.y << 32) | kb2.x); kfr[u][3] = (long)(((unsigned long long)kb2.w << 32) | kb2.z); }
#pragma unroll
                for (int u = 0; u < 8; ++u) { f32x4 d = {0.f, 0.f, 0.f, 0.f};
#pragma unroll
                    for (int kk = 0; kk < 4; ++kk) d = __builtin_amdgcn_mfma_f32_16x16x32_fp8_fp8(kfr[u][kk], qf[kk], d, 0, 0, 0);
                    const bool live = (g8 * 128 + u * 16) < nsel;
                    if (!live) d = (f32x4){-3e38f, -3e38f, -3e38f, -3e38f};
                    lg[g8 * 8 + u] = d; mx = fmaxf(mx, fmaxf(fmaxf(d[0], d[1]), fmaxf(d[2], d[3]))); }
            } else {
#pragma unroll
                for (int u = 0; u < 8; ++u) lg[g8 * 8 + u] = (f32x4){-3e38f, -3e38f, -3e38f, -3e38f};
            }
        }
        mx = fmaxf(mx, __shfl_xor(mx, 16)); mx = fmaxf(mx, __shfl_xor(mx, 32));
        const int ks = lane_c >> 4, dc = lane_c & 15;
        u32x2 vn[16];
#define DSA_LOADV(I0) do { _Pragma("unroll") for (int u = 0; u < 16; ++u) { const int key = s[4 * ((I0) + u) + ks]; vn[u] = *(const u32x2*)(v8 + (row0 + key) * 512 + g * 128 + dc * 8); } } while (0)
        DSA_LOADV(0);
        float ls = 0.f;
#pragma unroll
        for (int blk = 0; blk < 16; ++blk) {
            if (blk * 16 < nsel) {
#pragma unroll
                for (int e = 0; e < 4; ++e) { const float p = fexp2((lg[blk][e] - mx) * 0.125f); ls += p; if (r < 4) Pb[r * 256 + blk * 16 + 4 * kq + e] = (unsigned short)(cvtpk(p, p) & 0xffffu); } }
        }
        ls += __shfl_xor(ls, 16); ls += __shfl_xor(ls, 32);
        if (lane < 4) invl[lane] = 1.f / ls;
        LDS_WAIT(); asm volatile("" ::: "memory");
        f32x4 oacc[8];
#pragma unroll
        for (int cb = 0; cb < 8; ++cb) oacc[cb] = (f32x4){0.f, 0.f, 0.f, 0.f};
        const unsigned tq_ = (unsigned)(lane_c & 15) >> 2, tp_ = (unsigned)lane_c & 3u;
        for (int i0 = 0; i0 < nsel / 4; i0 += 16) {
            u32x2 v[16];
#pragma unroll
            for (int u = 0; u < 16; ++u) v[u] = vn[u];
            if (i0 + 16 < nsel / 4) DSA_LOADV(i0 + 16);
#pragma unroll
            for (int half = 0; half < 2; ++half) {
#pragma unroll
                for (int uu = 0; uu < 8; ++uu) { const int u = 8 * half + uu; const unsigned row = 4u * uu + (unsigned)ks;
                    const f32x2_t a0 = __builtin_amdgcn_cvt_pk_f32_fp8((int)v[u].x, false), a1 = __builtin_amdgcn_cvt_pk_f32_fp8((int)v[u].x, true), a2 = __builtin_amdgcn_cvt_pk_f32_fp8((int)v[u].y, false), a3 = __builtin_amdgcn_cvt_pk_f32_fp8((int)v[u].y, true);
                    u32x4 w; w.x = cvtpk(a0.x, a0.y); w.y = cvtpk(a1.x, a1.y); w.z = cvtpk(a2.x, a2.y); w.w = cvtpk(a3.x, a3.y);
                    *(LAS u32x4*)(vt + 256u * row + 16u * ((unsigned)dc ^ (((row & 3u) << 2) | ((row >> 2) & 3u)))) = w; }
                asm volatile("" ::: "memory");
                bf16x8 af = (bf16x8){0, 0, 0, 0, 0, 0, 0, 0};
                if (r < 4) af = *(const LAS bf16x8*)(Pb + r * 256 + 4 * i0 + 32 * half + 8 * kq);
#pragma unroll
                for (int cb = 0; cb < 8; ++cb) {
                    s16x4_t bq[2];
#pragma unroll
                    for (int t = 0; t < 2; ++t) { const unsigned trow = 8u * (unsigned)ks + 4u * t + tq_, tch = 2u * cb + (tp_ >> 1);
                        const unsigned ta = 256u * trow + 16u * (tch ^ (((trow & 3u) << 2) | ((trow >> 2) & 3u))) + 8u * (tp_ & 1u);
                        bq[t] = __builtin_amdgcn_ds_read_tr16_b64_v4i16((LAS s16x4_t*)(vt + ta)); }
                    const bf16x8 bfrag = {bq[0][0], bq[0][1], bq[0][2], bq[0][3], bq[1][0], bq[1][1], bq[1][2], bq[1][3]};
                    oacc[cb] = MFMA16(af, bfrag, oacc[cb]); }
                asm volatile("" ::: "memory");
            }
        }
        if (ks == 0) {
#pragma unroll
            for (int hd = 0; hd < 4; ++hd) { const float il = invl[hd];
#pragma unroll
                for (int cb = 0; cb < 8; ++cb) mix[qrow * D + (g * 4 + hd) * 128 + 16 * cb + dc] = (unsigned short)(cvtpk(oacc[cb][hd] * il, 0.f) & 0xffffu); }
        }
        LDS_WAIT(); asm volatile("" ::: "memory");
    }
#endif
    __syncthreads(); DSA_PT(2);
}


constexpr int A2_SLOT = 40960, A2_NSLOT = 3, A2_CTRL = A2_SLOT * A2_NSLOT;
static_assert(A2_CTRL + 256 <= RING_BYTES, "attention LDS map");
#define A2_WAIT_V(n) asm volatile("s_waitcnt vmcnt(" #n ")" ::: "memory")
template <int MODE>
__device__ __forceinline__ void attn2_stage(LAS unsigned char* slot, const bf16* kbase  ,
                                            const bf16* vbase  , const float* cbase  , int ldp, int kb, int wave) {
#pragma unroll
    for (int i = 0; i < 2; ++i) { const int f = wave + 8 * i, sb = f >> 3, kk = f & 7;
        __builtin_amdgcn_global_load_lds((const unsigned*)(kbase + (size_t)(kb + 32 * sb) * ldp + kk * 16), (LAS unsigned*)(slot + f * 1024), 16, 0, 0); }
#pragma unroll
    for (int i = 0; i < 2; ++i) { const int f = wave + 8 * i, sb = f >> 3, d = (f >> 1) & 3, s = f & 1;
        __builtin_amdgcn_global_load_lds((const unsigned*)(vbase + (size_t)(d * 32) * SEQ + kb + 32 * sb + 16 * s), (LAS unsigned*)(slot + 16384 + f * 1024), 16, 0, 0); }
    if (MODE == 1) __builtin_amdgcn_global_load_lds((const unsigned*)(cbase + kb), (LAS unsigned*)(slot + 32768 + wave * 1024), 16, 0, 0);
}
template <int MODE>
__device__ __forceinline__ void attn2_unit(const bf16* proj, int ldp, const bf16* VT, const float* cum2, const float* tot, const float* gq, const float* rstdv, bf16* mix, float zb2, int grp, int bh, LAS unsigned char* lds, int tid) {
    const int lane = tid & 63, wave = __builtin_amdgcn_readfirstlane(tid >> 6);
    const int b = bh >> 4, h = bh & 15, n = lane & 31, hi = lane >> 5;
    const int q_base = 256 * grp, q0 = q_base + 32 * wave, tq = q0 + n;
    const size_t row0 = (size_t)b * SEQ;
    const int prow = (n & 0x13) | ((n & 4) << 1) | ((n & 8) >> 1);
    const bf16* kbase = proj + (row0 + prow) * ldp + D + h * 128 + hi * 8;
    const bf16* vbase = VT + ((size_t)bh * 128 + n) * SEQ + 8 * hi;
    const float* cb = cum2 + (size_t)bh * SEQ;
    const float* cbase = cb + 4 * (lane & 15);
    volatile LAS unsigned* flags = (volatile LAS unsigned*)(lds + A2_CTRL + 64);
    bf16x8 qf[8];
    {
      const bf16* qp = proj + (row0 + q0 + n) * ldp + h * 128 + hi * 8;
      u32x4 raw[8];
#pragma unroll
      for (int kk = 0; kk < 8; ++kk) raw[kk] = *(const u32x4*)(qp + kk * 16);
      float ss = 0.f;
#pragma unroll
      for (int kk = 0; kk < 8; ++kk) { const float x0 = bflo(raw[kk].x), x1 = bfhi(raw[kk].x), x2 = bflo(raw[kk].y), x3 = bfhi(raw[kk].y), x4 = bflo(raw[kk].z), x5 = bfhi(raw[kk].z), x6 = bflo(raw[kk].w), x7 = bfhi(raw[kk].w);
          ss += x0 * x0 + x1 * x1 + x2 * x2 + x3 * x3 + x4 * x4 + x5 * x5 + x6 * x6 + x7 * x7; }
      ss += __shfl_xor(ss, 32);
      const float ar = rstdv[row0 + q0 + n];
      const float rstd = ar / sqrtf(ar * ar * ss * (1.f / 128.f) + RMS_EPS);
#pragma unroll
      for (int kk = 0; kk < 8; ++kk) { const f32x4 g0 = *(const f32x4*)(gq + kk * 16 + hi * 8), g1 = *(const f32x4*)(gq + kk * 16 + hi * 8 + 4);
          u32x4 w; w.x = cvtpk(bflo(raw[kk].x) * rstd * g0.x * QSCALE, bfhi(raw[kk].x) * rstd * g0.y * QSCALE); w.y = cvtpk(bflo(raw[kk].y) * rstd * g0.z * QSCALE, bfhi(raw[kk].y) * rstd * g0.w * QSCALE);
          w.z = cvtpk(bflo(raw[kk].z) * rstd * g1.x * QSCALE, bfhi(raw[kk].z) * rstd * g1.y * QSCALE); w.w = cvtpk(bflo(raw[kk].w) * rstd * g1.z * QSCALE, bfhi(raw[kk].w) * rstd * g1.w * QSCALE);
          qf[kk] = __builtin_bit_cast(bf16x8, w); } }
    float cq = 0.f, c_low = 0.f, Pe = 0.f, Po = 0.f, Pq = 0.f, Plow = 0.f;
    if (MODE == 1) { cq = cb[tq]; c_low = cb[q_base];
        const float te = tot[bh * 128 + 2 * lane], to = tot[bh * 128 + 2 * lane + 1]; float sc2 = te + to;
#pragma unroll
        for (int o = 1; o < 64; o <<= 1) { const float u = __shfl_up(sc2, o); if (lane >= o) sc2 += u; }
        Pe = sc2 - (te + to); Po = Pe + te;
        { const int cw = q0 >> 6; Pq = (cw & 1) ? __shfl(Po, cw >> 1) : __shfl(Pe, cw >> 1); }
        { const int cl = q_base >> 6; Plow = (cl & 1) ? __shfl(Po, cl >> 1) : __shfl(Pe, cl >> 1); } }
    f32x16 o[4];
#pragma unroll
    for (int d = 0; d < 4; ++d)
#pragma unroll
        for (int i = 0; i < 16; ++i) o[d][i] = 0.f;
    float R = 0.f, mrun = -1e30f, lrun = 0.f;
    const int nsteps = (q_base + 256) >> 6, kb_top = q_base + 192;
    if (wave < 4) __builtin_amdgcn_s_setprio(2); else __builtin_amdgcn_s_setprio(0);
    if (MODE == 0 && tid < 16) flags[tid] = 0u;
    asm volatile("s_waitcnt vmcnt(0)" ::: "memory");
    attn2_stage<MODE>(lds, kbase, vbase, cbase, ldp, kb_top, wave);
    if (nsteps > 1) attn2_stage<MODE>(lds + A2_SLOT, kbase, vbase, cbase, ldp, kb_top - 64, wave);
    bool mydone = false;
    for (int j = 0; j < nsteps; ++j) {
        const int kb = kb_top - 64 * j;
        if (j + 1 < nsteps) { if (MODE == 1) A2_WAIT_V(5); else A2_WAIT_V(4); } else A2_WAIT_V(0);
        __builtin_amdgcn_s_barrier();
        __builtin_amdgcn_sched_barrier(0); asm volatile("" ::: "memory");
        LAS unsigned char* slot = lds + (j % A2_NSLOT) * A2_SLOT;
        float dq = 0.f;
        if (MODE == 1) { const int ck_ = kb >> 6; const float Pk = (ck_ & 1) ? __shfl(Po, ck_ >> 1) : __shfl(Pe, ck_ >> 1);
            dq = Pq - Pk;
            const float ck63 = *(const LAS float*)(slot + 32768 + wave * 1024 + 63 * 4);
            if ((c_low + (Plow - Pk) - ck63) + 2.f * zb2 < ZERO_LOG2) break; }
        else if (j > 0) { const volatile LAS unsigned* fl = flags + 8 * ((j - 1) & 1); unsigned all = 1u;
#pragma unroll
            for (int w2 = 0; w2 < 8; ++w2) all &= fl[w2];
            if (all) break; }
        if (j + 2 < nsteps) attn2_stage<MODE>(lds + ((j + 2) % A2_NSLOT) * A2_SLOT, kbase, vbase, cbase, ldp, kb - 128, wave);
#pragma unroll
        for (int sbi = 0; sbi < 2; ++sbi) { const int sb = 1 - sbi, kk0 = kb + 32 * sb;
            if (kk0 > q0 || mydone) continue;
            if (MODE == 1) { const float ck31 = *(const LAS float*)(slot + 32768 + wave * 1024 + (32 * sb + 31) * 4);
                const float cq0 = __shfl(cq, 0); if ((cq0 + dq - ck31) + 2.f * zb2 < ZERO_LOG2) { mydone = true; continue; } }
            bf16x8 kf[8];
#pragma unroll
            for (int kk = 0; kk < 8; ++kk) kf[kk] = *(const LAS bf16x8*)(slot + (sb * 8 + kk) * 1024 + lane * 16);
            f32x16 sc;
#pragma unroll
            for (int i = 0; i < 16; ++i) sc[i] = 0.f;
#pragma unroll
            for (int kk = 0; kk < 8; ++kk) sc = MFMA32(kf[kk], qf[kk], sc);
            bf16x8 vf[4][2];
#pragma unroll
            for (int d = 0; d < 4; ++d)
#pragma unroll
                for (int s = 0; s < 2; ++s) vf[d][s] = *(const LAS bf16x8*)(slot + 16384 + (sb * 8 + d * 2 + s) * 1024 + lane * 16);
            const bool diag = (kk0 == q0);
            float w[16];
            if (MODE == 0) {
                float L[16];
#pragma unroll
                for (int i = 0; i < 16; ++i) L[i] = flog2(1.f + fexp2(sc[i]));
                if (diag) {
#pragma unroll
                    for (int i = 0; i < 16; ++i) { const int key = kk0 + 16 * (i >> 3) + 8 * hi + (i & 7); if (key >= tq) { L[i] = 0.f; sc[i] = -3e38f; } }
                }
                const float G0 = -(((L[0] + L[1]) + (L[2] + L[3])) + ((L[4] + L[5]) + (L[6] + L[7]))), G1 = -(((L[8] + L[9]) + (L[10] + L[11])) + ((L[12] + L[13]) + (L[14] + L[15])));
                const float Gp0 = __shfl_xor(G0, 32), Gp1 = __shfl_xor(G1, 32);
                const float pre1 = hi ? R : (R + Gp1);
                const float pre0 = hi ? (R + G1 + Gp1) : (R + Gp1 + G1 + Gp0);
                float c = pre1;
#pragma unroll
                for (int jj = 7; jj >= 0; --jj) { c -= L[8 + jj]; w[8 + jj] = fexp2(sc[8 + jj] + c); }
                c = pre0;
#pragma unroll
                for (int jj = 7; jj >= 0; --jj) { c -= L[jj]; w[jj] = fexp2(sc[jj] + c); }
                R += (G0 + G1) + (Gp0 + Gp1);
                if (__all(R + zb2 < ZERO_LOG2)) mydone = true;
            } else {
                f32x2_t v2[8]; const f32x2_t cq2 = {cq + dq, cq + dq};
#pragma unroll
                for (int s = 0; s < 2; ++s) { const LAS f32x4* cp = (const LAS f32x4*)(slot + 32768 + wave * 1024 + (32 * sb + 16 * s + 8 * hi) * 4);
                    const f32x4 c0 = cp[0], c1 = cp[1];
                    v2[4 * s + 0] = (f32x2_t){sc[8 * s + 0], sc[8 * s + 1]} - (f32x2_t){c0.x, c0.y};
                    v2[4 * s + 1] = (f32x2_t){sc[8 * s + 2], sc[8 * s + 3]} - (f32x2_t){c0.z, c0.w};
                    v2[4 * s + 2] = (f32x2_t){sc[8 * s + 4], sc[8 * s + 5]} - (f32x2_t){c1.x, c1.y};
                    v2[4 * s + 3] = (f32x2_t){sc[8 * s + 6], sc[8 * s + 7]} - (f32x2_t){c1.z, c1.w}; }
                if (diag) {
#pragma unroll
                    for (int p = 0; p < 8; ++p) { const int key = kk0 + 16 * (p >> 2) + 8 * hi + 2 * (p & 3);
                        if (key > tq) v2[p].x = -3e38f; if (key + 1 > tq) v2[p].y = -3e38f; }
                }
#pragma unroll
                for (int p = 0; p < 8; ++p) v2[p] += cq2;
                float bm = fmaxf(fmaxf(v2[0].x, v2[0].y), fmaxf(v2[1].x, v2[1].y));
#pragma unroll
                for (int p = 2; p < 8; p += 2) bm = fmaxf(bm, fmaxf(fmaxf(v2[p].x, v2[p].y), fmaxf(v2[p + 1].x, v2[p + 1].y)));
                bm = fmaxf(bm, __shfl_xor(bm, 32));
                const float mn = fmaxf(mrun, bm), alpha = fexp2(mrun - mn);
                mrun = mn;
                const f32x2_t nmn2 = {-mn, -mn}; f32x2_t ps2 = {0.f, 0.f};
#pragma unroll
                for (int p = 0; p < 8; ++p) { const f32x2_t d2 = v2[p] + nmn2; f32x2_t e2; e2.x = fexp2(d2.x); e2.y = fexp2(d2.y); w[2 * p] = e2.x; w[2 * p + 1] = e2.y; ps2 += e2; }
                lrun = lrun * alpha + (ps2.x + ps2.y);
                if (__any(alpha != 1.f)) {
#pragma unroll
                    for (int d = 0; d < 4; ++d)
#pragma unroll
                        for (int i = 0; i < 16; ++i) o[d][i] *= alpha;
                }
            }
            bf16x8 pf[2];
#pragma unroll
            for (int s = 0; s < 2; ++s) { u32x4 t; t.x = cvtpk(w[8 * s + 0], w[8 * s + 1]); t.y = cvtpk(w[8 * s + 2], w[8 * s + 3]); t.z = cvtpk(w[8 * s + 4], w[8 * s + 5]); t.w = cvtpk(w[8 * s + 6], w[8 * s + 7]);
                pf[s] = __builtin_bit_cast(bf16x8, t); }
#pragma unroll
            for (int d = 0; d < 4; ++d)
#pragma unroll
                for (int s = 0; s < 2; ++s) o[d] = MFMA32(vf[d][s], pf[s], o[d]);
        }
        if (MODE == 0) { if (lane == 0) flags[8 * (j & 1) + wave] = (mydone || kb == 0) ? 1u : 0u; }
    }
    A2_WAIT_V(0);
    __builtin_amdgcn_s_setprio(0);
    float inv = 1.f;
    if (MODE == 1) { const float lt = lrun + __shfl_xor(lrun, 32); inv = 1.f / lt; }
    bf16* op = mix + (row0 + q0 + n) * (size_t)D + h * 128 + 4 * hi;
#pragma unroll
    for (int d = 0; d < 4; ++d)
#pragma unroll
        for (int g = 0; g < 4; ++g) { u32x2 t; t.x = cvtpk(o[d][4 * g] * inv, o[d][4 * g + 1] * inv); t.y = cvtpk(o[d][4 * g + 2] * inv, o[d][4 * g + 3] * inv);
            *(u32x2*)(op + d * 32 + 8 * g) = t; }
    asm volatile("s_waitcnt vmcnt(0) lgkmcnt(0)" ::: "memory");
    __builtin_amdgcn_s_barrier();
}

typedef const __attribute__((address_space(4))) Args* KArgs;
__device__ __forceinline__ KArgs kargs() { auto p = __builtin_amdgcn_kernarg_segment_ptr(); asm volatile("" : "+s"(p)); return (KArgs)p; }
#define TID_VARS int tid_l = threadIdx.x; asm volatile("" : "+v"(tid_l)); const int tid = tid_l, lane = tid & 63, wave = __builtin_amdgcn_readfirstlane(tid >> 6); const int G = gridDim.x, bx = blockIdx.x; const int gw = bx * NWAVES + wave, ngw = G * NWAVES; (void)gw; (void)ngw; (void)lane; (void)G
#ifndef WGM_IN
#define WGM_IN 4
#endif
#ifndef WGM_WO
#define WGM_WO 4
#endif
#ifndef WGM_PP
#define WGM_PP 4
#endif
#ifndef WGM_UP
#define WGM_UP 4
#endif
#ifndef WGM_DN
#define WGM_DN 4
#endif
#ifndef WGM_GT
#define WGM_GT 4
#endif
#ifndef PG_ALIGN
#define PG_ALIGN true
#endif
#ifndef PG_SP2
#define PG_SP2 true
#endif
#ifndef PHMASK
#define PHMASK 0xFFFF
#endif
#define PH(k) ((PHMASK >> (k)) & 1)
#ifndef REP_GEMM
#define REP_GEMM 1
#endif
#ifndef REP_ATTN
#define REP_ATTN 1
#endif
#ifndef REP_LIGHT
#define REP_LIGHT 1
#endif
#ifndef REP_A
#define REP_A REP_ATTN
#endif
#ifndef REP_B
#define REP_B REP_ATTN
#endif
#ifndef REP_C
#define REP_C REP_ATTN
#endif

#ifndef REP_BAR
#define REP_BAR 1
#endif
__device__ __forceinline__ void grid_bar(LAS unsigned char* lds) {
  for (int rb = 0; rb < REP_BAR; ++rb) {
    KArgs A = kargs(); XcdBarrier b; b.bar = (unsigned*)(A->ws + WS_CTL) + CW_BAR; b.x = xb_xcc_id(); b.st = (volatile LAS unsigned*)(lds + MISC_OFF) + 8;
    xcd_barrier(b);
  }
}
struct LayerCfg { int kind, jk, nin, npad; };
__device__ __forceinline__ LayerCfg layer_cfg(int layer) { LayerCfg c; c.kind = layer % 3; c.jk = layer / 3; c.nin = c.kind == 0 ? NA_IN : (c.kind == 1 ? NB_IN : NC_IN); c.npad = c.kind == 0 ? NA_IN : (c.kind == 1 ? NB_PAD : NC_PAD); return c; }

__device__ __forceinline__ void convert_layer(KArgs A, unsigned char* ws, LAS float* scrw, int layer, int which, int gw, int ngw, int lane) {
    const LayerCfg L = layer_cfg(layer);
    if (which & 1) {
        const float* w_in = L.kind == 0 ? A->in[I_A_WIN] + (size_t)L.jk * D * NA_IN : (L.kind == 1 ? A->in[I_B_WIN] : A->in[I_C_WIN]);
        convert_weight(w_in, A->in[I_ATTN_NORM] + layer * D, D, L.nin, L.npad, (bf16*)(ws + WS_WIN), scrw, gw, ngw, lane);
        convert_weight(A->in[I_WO] + (size_t)layer * D * D, nullptr, D, D, D, (bf16*)(ws + WS_WO), scrw, gw, ngw, lane);
        convert_weight(A->in[I_WUP] + (size_t)layer * D * FF, A->in[I_MLP_NORM] + layer * D, D, FF, FF, (bf16*)(ws + WS_WUP), scrw, gw, ngw, lane);
        convert_weight(A->in[I_WDOWN] + (size_t)layer * FF * D, nullptr, FF, D, D, (bf16*)(ws + WS_WDN), scrw, gw, ngw, lane);
    }
    if (which & 2) {
        convert_weight(A->in[I_WGATE] + (size_t)layer * D * D, A->in[I_PLE_NORM] + layer * D, D, D, D, (bf16*)(ws + WS_WG), scrw, gw, ngw, lane);
        convert_weight(A->in[I_WPLE] + (size_t)layer * PLE * D, nullptr, PLE, D, D, (bf16*)(ws + WS_WPL), scrw, gw, ngw, lane);
    }
}
__device__ __forceinline__ void phase_prologue(LAS unsigned char* lds) {
    KArgs A = kargs(); TID_VARS; unsigned char* ws = A->ws;
    float2* rope32 = (float2*)(ws + WS_ROPE32); float2* rope16 = (float2*)(ws + WS_ROPE16);
    const int gt = bx * NTHR + tid, ngt = G * NTHR;
    for (int i = gt; i < SEQ * 16; i += ngt) { const int pos = i >> 4, k = i & 15; const float inv = exp2f(-(float)k * (1.f / 16.f) * 18.931568569324174f);
        const float ang = (float)pos * inv; float s, c; sincosf(ang, &s, &c); rope32[i] = make_float2(c, s); }
    for (int i = gt; i < SEQ * 8; i += ngt) { const int pos = i >> 3, k = i & 7; const float inv = exp2f(-(float)k * (1.f / 8.f) * 18.931568569324174f);
        const float ang = (float)pos * inv; float s, c; sincosf(ang, &s, &c); rope16[i] = make_float2(c, s); }
    const f32x4* p4 = (const f32x4*)A->in[I_P]; u32x2* pb2 = (u32x2*)(ws + WS_PB);
    for (size_t i = gt; i < (size_t)DEPTH * M * PLE / 4; i += ngt) { const f32x4 v = p4[i]; pb2[i] = (u32x2){cvtpk(v.x, v.y), cvtpk(v.z, v.w)}; }
    x_rows(A->in[I_X], (bf16*)(ws + WS_HB0), (float*)(ws + WS_SSP_IN), gw, ngw, lane);
    convert_layer(A, ws, (LAS float*)(lds + RING_OFF + wave * 8448), 0, 1, gw, ngw, lane);
}
__device__ __forceinline__ void phase_inproj(LAS unsigned char* lds, int layer) {
    KArgs A = kargs(); TID_VARS; unsigned char* ws = A->ws; const LayerCfg L = layer_cfg(layer);
    pg8::Gemm g{(const bf16*)(ws + ((layer & 1) ? WS_HB1 : WS_HB0)), (const bf16*)(ws + WS_WIN), M, L.npad, D}; pg8::StaticOrder S; S.init(M, L.npad, G, bx, WGM_IN);
    { const float* ssp = (const float*)(ws + WS_SSP_IN); float* rv = (float*)(ws + WS_RSTD);
      for (int r = gw; r < M; r += ngw) { float v = lane < 32 ? ssp[(size_t)r * 32 + lane] : 0.f; v = wave_sum(v); if (lane == 0) rv[r] = 1.f / sqrtf(v * (1.f / 2048.f) + RMS_EPS); } }
    pg8::EpiStore<0, false> E{(bf16*)(ws + WS_PROJ), L.npad, nullptr};
    pg8::gemm_phase<pg8::EpiStore<0, false>, pg8::StaticOrder, PG_ALIGN, PG_SP2>(lds + RING_OFF, g, S, E);
}
__device__ __forceinline__ float zbound2(const float* gq, const float* gk, int lane) {
    const float a = wave_max(fmaxf(fabsf(gq[lane]), fabsf(gq[lane + 64]))), bq = wave_max(fmaxf(fabsf(gk[lane]), fabsf(gk[lane + 64])));
    return a * bq * 11.313708498984761f * LOG2E * 1.02f;
}
__device__ __forceinline__ void phase_postproj_dense(LAS unsigned char* lds, int layer) {
    KArgs A = kargs(); TID_VARS; unsigned char* ws = A->ws; const LayerCfg L = layer_cfg(layer);
    bf16* PROJ = (bf16*)(ws + WS_PROJ); LAS float* scrw = (LAS float*)(lds + RING_OFF + wave * 8448);
    const float* gq = L.kind == 0 ? A->in[I_A_QN] + L.jk * HD : A->in[I_C_QN]; const float* gk = L.kind == 0 ? A->in[I_A_KN] + L.jk * HD : A->in[I_C_KN];
    const int npad = L.npad;
    const int nscan = L.kind == 2 ? BATCH * 128 : 0, nvt = BATCH * 256 * 16, total = nscan + nvt + M;
    for (int it = gw; it < total; it += ngw) {
        if (it < nscan) { cumchunk_item(PROJ, npad, (const float*)(ws + WS_RSTD), A->in[I_C_BF], (float*)(ws + WS_CUM), (float*)(ws + WS_TOT), it, lane); continue; }
        int r = it - nscan;
        if (r < nvt) { vt_item(PROJ, npad, 2 * D, (const float*)(ws + WS_RSTD), (bf16*)(ws + WS_VT), (LAS unsigned char*)scrw, r, lane); continue; }
        r -= nvt;
        bf16* base = PROJ + (size_t)r * npad + 8 * lane;
        u32x4 raw[4];
#pragma unroll
        for (int j = 0; j < 4; ++j) raw[j] = *(const u32x4*)(base + D + 512 * j);
        const float ar = ((const float*)(ws + WS_RSTD))[r];
#pragma unroll
        for (int j = 0; j < 4; ++j) head128_norm<false>(base + D + 512 * j, raw[j], ar, gk, 1.f, nullptr, lane);
    }
    convert_layer(A, ws, scrw, layer, 2, gw, ngw, lane);
}
__device__ __forceinline__ void phase_postproj_dsa(LAS unsigned char* lds, int layer) {
    KArgs A = kargs(); TID_VARS; unsigned char* ws = A->ws;
    bf16* PROJ = (bf16*)(ws + WS_PROJ); const float2* rope32 = (const float2*)(ws + WS_ROPE32); const float2* rope16 = (const float2*)(ws + WS_ROPE16);
    const float* gq = A->in[I_B_QN]; const float* gk = A->in[I_B_KN]; const float* gi = A->in[I_B_IKN];
    constexpr int npad = NB_PAD;
    for (int r = gw; r < M; r += ngw) { const int pos = r & (SEQ - 1);
        bf16* base = PROJ + (size_t)r * npad;
        const float2* r32 = rope32 + pos * 16; const float2* r16 = rope16 + pos * 8;
        u32x4 raw[8]; u32x4 rawi, raww;
#pragma unroll
        for (int j = 0; j < 5; ++j) raw[j] = *(const u32x4*)(base + 512 * j + 8 * lane);
        raw[5] = *(const u32x4*)(base + B_QI + 8 * lane); raw[6] = *(const u32x4*)(base + B_QI + 512 + 8 * lane);
        rawi = *(const u32x4*)(base + B_KI + 8 * (lane & 7)); raww = *(const u32x4*)(base + B_WI + 8 * (lane & 1));
        const float ar = ((const float*)(ws + WS_RSTD))[r];
        unsigned char* q8 = ws + WS_Q8 + (size_t)r * 2048 + 8 * lane; unsigned char* k8 = ws + WS_K8 + (size_t)r * 512 + 8 * lane; unsigned char* v8 = ws + WS_V8 + (size_t)r * 512 + 8 * lane;
#pragma unroll
        for (int j = 0; j < 4; ++j) head128_norm<true>(base + 512 * j + 8 * lane, raw[j], ar, gq, QSCALE * 8.f, r32, lane, q8 + 512 * j);
        head128_norm<true>(base + B_K + 8 * lane, raw[4], ar, gk, 1.f, r32, lane, k8);
        { const u32x4 rv = *(const u32x4*)(base + B_V + 8 * lane); int w0 = 0, w1 = 0;
          w0 = __builtin_amdgcn_cvt_pk_fp8_f32(bflo(rv.x) * ar, bfhi(rv.x) * ar, w0, false); w0 = __builtin_amdgcn_cvt_pk_fp8_f32(bflo(rv.y) * ar, bfhi(rv.y) * ar, w0, true);
          w1 = __builtin_amdgcn_cvt_pk_fp8_f32(bflo(rv.z) * ar, bfhi(rv.z) * ar, w1, false); w1 = __builtin_amdgcn_cvt_pk_fp8_f32(bflo(rv.w) * ar, bfhi(rv.w) * ar, w1, true);
          *(u32x2*)v8 = (u32x2){(unsigned)w0, (unsigned)w1}; }
#pragma unroll
        for (int j = 0; j < 2; ++j) head64_rope<false>(base + B_QI + 512 * j + 8 * lane, raw[5 + j], ar, nullptr, r16, lane, true);
        head64_rope<true>(base + B_KI + 8 * (lane & 7), rawi, ar, gi, r16, lane, lane < 8);
        if (lane < 2) { bf16* wp = base + B_WI + 8 * lane; const u32x4 raw = raww;
            const float sw = 0.03125f * ar;
            u32x4 w; w.x = cvtpk(bflo(raw.x) * sw, bfhi(raw.x) * sw); w.y = cvtpk(bflo(raw.y) * sw, bfhi(raw.y) * sw);
            w.z = cvtpk(bflo(raw.z) * sw, bfhi(raw.z) * sw); w.w = cvtpk(bflo(raw.w) * sw, bfhi(raw.w) * sw); *(u32x4*)wp = w; }
    }
    convert_layer(A, ws, (LAS float*)(lds + RING_OFF + wave * 8448), layer, 2, gw, ngw, lane);
}
template <int MODE>
__device__ __forceinline__ void phase_attn_dense(LAS unsigned char* lds, int layer, int rep) {
    KArgs A = kargs(); TID_VARS; unsigned char* ws = A->ws; const LayerCfg L = layer_cfg(layer);
    const float* gq = L.kind == 0 ? A->in[I_A_QN] + L.jk * HD : A->in[I_C_QN]; const float* gk = L.kind == 0 ? A->in[I_A_KN] + L.jk * HD : A->in[I_C_KN];
    const float zb2 = zbound2(gq, gk, lane);
    gu32* qhead = (gu32*)(ws + WS_CTL) + CW_QUEUE + 64 * layer + 16 * rep;
    volatile LAS unsigned* uw = (volatile LAS unsigned*)(lds + RING_OFF + A2_CTRL);
    for (;;) { if (tid == 0) uw[0] = __hip_atomic_fetch_add(qhead, 1u, RLX_AGENT); __syncthreads(); const unsigned it = uw[0]; __syncthreads();
        if (it >= 32u * 64u) break;
        const int grp = 31 - (int)(it >> 6), bh = (int)(it & 63u);
        attn2_unit<MODE>((const bf16*)(ws + WS_PROJ), L.npad, (const bf16*)(ws + WS_VT), (const float*)(ws + WS_CUM), (const float*)(ws + WS_TOT), gq, (const float*)(ws + WS_RSTD), (bf16*)(ws + WS_MIX), zb2, grp, bh, lds + RING_OFF, tid); }
}
__device__ __forceinline__ void phase_attn_dsa(LAS unsigned char* lds, int layer, int rep) {
    KArgs A = kargs(); TID_VARS; unsigned char* ws = A->ws;
    gu32* qhead = (gu32*)(ws + WS_CTL) + CW_QUEUE + 64 * layer + 16 * rep;
    float* scr = (float*)(ws + (bx < 128 ? WS_SCR_A + (size_t)bx * MiB : WS_SCR_B + (size_t)(bx - 128) * MiB));
    volatile LAS unsigned* uw = (volatile LAS unsigned*)(lds + RING_OFF + DL_MISC + 128);
    for (;;) { if (tid == 0) uw[0] = __hip_atomic_fetch_add(qhead, 1u, RLX_AGENT); __syncthreads(); const unsigned u = uw[0]; __syncthreads();
        if (u >= 1024u) break; dsa_unit((const bf16*)(ws + WS_PROJ), ws + WS_Q8, ws + WS_K8, ws + WS_V8, (bf16*)(ws + WS_MIX), scr, lds + RING_OFF, (int)u, tid); }
}
__device__ __forceinline__ void phase_wo(LAS unsigned char* lds, int layer) {
    KArgs A = kargs(); TID_VARS; unsigned char* ws = A->ws;
    pg8::Gemm g{(const bf16*)(ws + WS_MIX), (const bf16*)(ws + WS_WO), M, D, D}; pg8::StaticOrder S; S.init(M, D, G, bx, WGM_WO);
    bf16* hb = (bf16*)(ws + ((layer & 1) ? WS_HB1 : WS_HB0));
    pg8::EpiH<false, false> E{hb, hb, (float*)(ws + WS_SSP_WO), nullptr, nullptr, nullptr};
    pg8::gemm_phase<pg8::EpiH<false, false>, pg8::StaticOrder, PG_ALIGN, PG_SP2>(lds + RING_OFF, g, S, E);
}
__device__ __forceinline__ void phase_pp(LAS unsigned char* lds, int layer) {
    KArgs A = kargs(); TID_VARS; unsigned char* ws = A->ws;
    int kpl = PLE; asm volatile("" : "+s"(kpl));
    pg8::Gemm g{(const bf16*)(ws + WS_PB) + (size_t)layer * M * PLE, (const bf16*)(ws + WS_WPL), M, D, kpl}; pg8::StaticOrder S; S.init(M, D, G, bx, WGM_PP);
    pg8::EpiStore<0, false> E{(bf16*)(ws + WS_PP), D, nullptr};
    pg8::gemm_phase<pg8::EpiStore<0, false>, pg8::StaticOrder, PG_ALIGN, PG_SP2>(lds + RING_OFF, g, S, E);
}
__device__ __forceinline__ void phase_up(LAS unsigned char* lds, int layer) {
    KArgs A = kargs(); TID_VARS; unsigned char* ws = A->ws;
    pg8::Gemm g{(const bf16*)(ws + ((layer & 1) ? WS_HB1 : WS_HB0)), (const bf16*)(ws + WS_WUP), M, FF, D}; pg8::StaticOrder S; S.init(M, FF, G, bx, WGM_UP);
    pg8::EpiStore<1, false> E{(bf16*)(ws + WS_HID), FF, nullptr};
    pg8::gemm_phase<pg8::EpiStore<1, false>, pg8::StaticOrder, PG_ALIGN, PG_SP2>(lds + RING_OFF, g, S, E);
}
__device__ __forceinline__ void phase_down(LAS unsigned char* lds, int layer) {
    KArgs A = kargs(); TID_VARS; unsigned char* ws = A->ws;
    pg8::Gemm g{(const bf16*)(ws + WS_HID), (const bf16*)(ws + WS_WDN), M, D, FF}; pg8::StaticOrder S; S.init(M, D, G, bx, WGM_DN);
    bf16* hb = (bf16*)(ws + ((layer & 1) ? WS_HB1 : WS_HB0));
    pg8::EpiH<false, false, true> E{hb, hb, (float*)(ws + WS_SSP_DN), nullptr, (const float*)(ws + WS_SSP_WO), nullptr};
    pg8::gemm_phase<pg8::EpiH<false, false, true>, pg8::StaticOrder, PG_ALIGN, PG_SP2>(lds + RING_OFF, g, S, E);
}
template <bool FINAL>
__device__ __forceinline__ void phase_gate(LAS unsigned char* lds, int layer) {
    KArgs A = kargs(); TID_VARS; unsigned char* ws = A->ws;
    pg8::Gemm g{(const bf16*)(ws + ((layer & 1) ? WS_HB1 : WS_HB0)), (const bf16*)(ws + WS_WG), M, D, D}; pg8::StaticOrder S; S.init(M, D, G, bx, WGM_GT);
    pg8::EpiH<true, FINAL> E{(const bf16*)(ws + ((layer & 1) ? WS_HB1 : WS_HB0)), (bf16*)(ws + ((layer & 1) ? WS_HB0 : WS_HB1)), (float*)(ws + WS_SSP_IN), (const bf16*)(ws + WS_PP), (const float*)(ws + WS_SSP_DN), A->out};
    pg8::gemm_phase<pg8::EpiH<true, FINAL>, pg8::StaticOrder, PG_ALIGN, PG_SP2>(lds + RING_OFF, g, S, E);
}
__device__ __forceinline__ void phase_convert_next(LAS unsigned char* lds, int layer) {
    KArgs A = kargs(); TID_VARS; unsigned char* ws = A->ws;
    convert_layer(A, ws, (LAS float*)(lds + RING_OFF + wave * 8448), layer, 1, gw, ngw, lane);
}

__global__ void __launch_bounds__(NTHR, 2) trunk_fwd(Args args) {
    extern __shared__ __attribute__((aligned(16))) unsigned char lds_raw[];
    LAS unsigned char* lds = (LAS unsigned char*)lds_raw;
    for (int u = threadIdx.x; u < (LDS_BYTES - LDSCTL_OFF) / 4; u += NTHR) ((LAS unsigned*)(lds + LDSCTL_OFF))[u] = 0u;
    __syncthreads();
    { KArgs A = kargs(); (void)xcd_barrier_post((unsigned*)(A->ws + WS_CTL) + CW_BAR, (volatile LAS unsigned*)(lds + MISC_OFF) + 8); }
#ifdef PROBE_MASK
    unsigned long long pt_acc = 0ull, pt_last = __builtin_amdgcn_s_memrealtime();
#define PT(cls) do { const unsigned long long now_ = __builtin_amdgcn_s_memrealtime(); if ((PROBE_MASK >> (cls)) & 1) pt_acc += now_ - pt_last; pt_last = now_; } while (0)
#else
#define PT(cls) do { } while (0)
#endif
    phase_prologue(lds);
    grid_bar(lds); PT(7);
    for (int layer = 0; layer < DEPTH; ++layer) {
        const int kind = layer % 3;
        phase_inproj(lds, layer);
        grid_bar(lds); PT(0);
        if (kind != 1) phase_postproj_dense(lds, layer); else phase_postproj_dsa(lds, layer);
        grid_bar(lds); PT(1);
        if (kind == 0) phase_attn_dense<0>(lds, layer, 0);
        else if (kind == 2) phase_attn_dense<1>(lds, layer, 0);
        else phase_attn_dsa(lds, layer, 0);
        grid_bar(lds); PT(kind == 0 ? 2 : (kind == 1 ? 8 : 9));
        phase_wo(lds, layer);
        phase_pp(lds, layer);
        grid_bar(lds); PT(3);
        phase_up(lds, layer);
        grid_bar(lds); PT(4);
        phase_down(lds, layer);
        grid_bar(lds); PT(5);
        if (layer + 1 < DEPTH) { phase_gate<false>(lds, layer); __syncthreads(); phase_convert_next(lds, layer + 1); }
        else phase_gate<true>(lds, layer);
        grid_bar(lds); PT(6);
    }
#ifdef PROBE_MASK
#if defined(PROBE_EPI) || defined(PROBE_DSA)
    pt_acc = *(volatile LAS unsigned long long*)(lds + MISC_OFF + 64);
#endif
    if (blockIdx.x == 0 && threadIdx.x == 0) { const unsigned long long until = __builtin_amdgcn_s_memrealtime() + (unsigned long long)PROBE_AMP * pt_acc;
        while (__builtin_amdgcn_s_memrealtime() < until) __builtin_amdgcn_s_sleep(32); }
#endif
}

extern "C" void kernel_launch(void* const* d_in, const int* in_sizes, int n_in, void* d_out, int out_size, void* d_ws, size_t ws_size, hipStream_t stream) {
    static int grid = 0;
    if (grid == 0) {
        if (n_in != 21 || out_size != M * D || ws_size < WS_END2) { fprintf(stderr, "kernel_launch: unexpected shapes (n_in %d, out %d, ws %zu)\n", n_in, out_size, ws_size); grid = -1; return; }
        int dev = 0, cus = 0, per_cu = 0;
        if (hipGetDevice(&dev) != hipSuccess || hipDeviceGetAttribute(&cus, hipDeviceAttributeMultiprocessorCount, dev) != hipSuccess) { grid = -1; return; }
        if (hipFuncSetAttribute((const void*)trunk_fwd, hipFuncAttributeMaxDynamicSharedMemorySize, LDS_BYTES) != hipSuccess) { fprintf(stderr, "kernel_launch: hipFuncSetAttribute failed\n"); grid = -1; return; }
        if (hipOccupancyMaxActiveBlocksPerMultiprocessor(&per_cu, (const void*)trunk_fwd, NTHR, LDS_BYTES) != hipSuccess || per_cu < 1) { fprintf(stderr, "kernel_launch: occupancy query says %d\n", per_cu); }
        (void)hipGetLastError();
        grid = cus > 256 ? 256 : cus;
    }
    if (grid < 0) return;
    if (hipMemsetAsync((char*)d_ws + WS_CTL, 0, CTL_ZERO_BYTES, stream) != hipSuccess) return;
    Args a{};
    for (int i = 0; i < 21; ++i) a.in[i] = (const float*)d_in[i];
    a.out = (float*)d_out; a.ws = (unsigned char*)d_ws;
    hipLaunchKernelGGL(trunk_fwd, dim3(grid), dim3(NTHR), LDS_BYTES, stream, a);
}
```
